# Optimizing an MI355X kernel written in HIP

```python
import math
import jax, jax.numpy as jnp
from jax import lax
import numpy as np


D_MODEL = 1024
BATCH = 8
SEQ = 4096
DEPTH = 4

CHUNK = 64
Q_BLOCK = 128
DA_HEADS = D_MODEL // 256
DA_HEAD_DIM = 64
DA_WIDTH = DA_HEADS * 2 * DA_HEAD_DIM
ML_HEADS = D_MODEL // 256
ML_HEAD_DIM = 128
ML_WIDTH = ML_HEADS * ML_HEAD_DIM
ML_CONV = 4
FX_HEADS = D_MODEL // 64
FX_HEAD_DIM = 64
FX_WIDTH = FX_HEADS * FX_HEAD_DIM
FFN_HIDDEN = ((8 * D_MODEL + 3 * 256 - 1) // (3 * 256)) * 256
AB_IN = 3 * DA_WIDTH + 4 * ML_WIDTH + 2 * ML_HEADS
AB_OUT = DA_WIDTH + ML_WIDTH
FX_IN = 3 * FX_WIDTH + FX_HEADS
N_EVEN = (DEPTH + 1) // 2
N_ODD = DEPTH // 2
EPS = 1e-6

kernel_name = "hybrid_diffattn_mlstm_fox_block"


def rms_norm(x, g):
    xf = x.astype(jnp.float32)
    y = xf * lax.rsqrt(jnp.mean(xf * xf, axis=-1, keepdims=True) + EPS)
    return (y * g.astype(jnp.float32)).astype(x.dtype)


def modulate(h, shift, scale):
    return h * (1.0 + scale[:, None, :]) + shift[:, None, :]


def causal_conv(x, w, b):
    K = w.shape[0]
    S = x.shape[1]
    xp = jnp.pad(x, ((0, 0), (K - 1, 0), (0, 0)))
    return sum(xp[:, j:j + S] * w[j] for j in range(K)) + b


def alibi_slopes(n):
    return 2.0 ** (-8.0 * jnp.arange(1, n + 1, dtype=jnp.float32) / n)


def diff_attention(q, k, v, q_g, k_g, lam_p, subln_g, layer_idx):
    B, S, _ = q.shape
    q = rms_norm(q.reshape(B, S, DA_HEADS, 2, DA_HEAD_DIM).transpose(0, 2, 3, 1, 4), q_g)
    k = rms_norm(k.reshape(B, S, DA_HEADS, 2, DA_HEAD_DIM).transpose(0, 2, 3, 1, 4), k_g)
    v = v.reshape(B, S, DA_HEADS, 2 * DA_HEAD_DIM).transpose(0, 2, 1, 3)
    lambda_init = 0.8 - 0.6 * math.exp(-0.3 * layer_idx)
    lp = lam_p.astype(jnp.float32)
    lam = jnp.exp(jnp.sum(lp[0] * lp[1])) - jnp.exp(jnp.sum(lp[2] * lp[3])) + lambda_init
    slopes = alibi_slopes(DA_HEADS)[None, :, None, None, None]
    k_pos = jnp.arange(S)
    scale = DA_HEAD_DIM ** -0.5

    def block(i):
        start = i * Q_BLOCK
        qb = lax.dynamic_slice_in_dim(q, start, Q_BLOCK, axis=3)
        q_pos = start + jnp.arange(Q_BLOCK)
        logits = jnp.einsum('bhmqd,bhmkd->bhmqk', qb, k, preferred_element_type=jnp.float32) * scale
        dist = jnp.abs(q_pos[:, None] - k_pos[None, :]).astype(jnp.float32)
        allowed = (k_pos[None, :] // CHUNK) <= (q_pos[:, None] // CHUNK)
        logits = jnp.where(allowed, logits - slopes * dist, -jnp.inf)
        p = jax.nn.softmax(logits, axis=-1)
        p_diff = p[:, :, 0] - lam * p[:, :, 1]
        return jnp.einsum('bhqk,bhkd->bhqd', p_diff.astype(v.dtype), v)

    out = lax.map(block, jnp.arange(S // Q_BLOCK))
    out = out.transpose(1, 2, 0, 3, 4).reshape(B, DA_HEADS, S, 2 * DA_HEAD_DIM)
    out = rms_norm(out, subln_g) * (1.0 - lambda_init)
    return out.transpose(0, 2, 1, 3).reshape(B, S, DA_WIDTH)


def mlstm(q, k, v, i_pre, f_pre):
    B, S, _ = q.shape
    H, d, L = ML_HEADS, ML_HEAD_DIM, CHUNK
    NC = S // L
    f32 = jnp.float32

    def heads(t):
        return t.astype(f32).reshape(B, NC, L, H, d).transpose(0, 3, 1, 2, 4)

    def gates(t):
        return t.astype(f32).reshape(B, NC, L, H).transpose(0, 3, 1, 2)

    q, k, v = heads(q), heads(k) * (d ** -0.5), heads(v)
    ig = gates(i_pre)
    a = jnp.cumsum(jax.nn.log_sigmoid(gates(f_pre)), axis=-1)
    a_last = a[..., -1]
    causal = jnp.tril(jnp.ones((L, L), dtype=bool))
    log_d = jnp.where(causal, a[..., :, None] - a[..., None, :] + ig[..., None, :], -jnp.inf)
    g = a_last[..., None] - a + ig
    m_loc = jnp.max(g, axis=-1)
    w = jnp.exp(g - m_loc[..., None])
    dC = jnp.einsum('bhcl,bhcld,bhcle->bhcde', w, v, k)
    dn = jnp.einsum('bhcl,bhcle->bhce', w, k)

    def step(carry, inp):
        C, n, m = carry
        dC_c, dn_c, m_loc_c, a_last_c = inp
        m_new = jnp.maximum(a_last_c + m, m_loc_c)
        decay = jnp.exp(a_last_c + m - m_new)
        s_loc = jnp.exp(m_loc_c - m_new)
        C_new = decay[..., None, None] * C + s_loc[..., None, None] * dC_c
        n_new = decay[..., None] * n + s_loc[..., None] * dn_c
        return (C_new, n_new, m_new), (C, n, m)

    init = (jnp.zeros((B, H, d, d), f32), jnp.zeros((B, H, d), f32), jnp.zeros((B, H), f32))
    xs = (jnp.moveaxis(dC, 2, 0), jnp.moveaxis(dn, 2, 0), jnp.moveaxis(m_loc, 2, 0), jnp.moveaxis(a_last, 2, 0))
    _, (C_prev, n_prev, m_prev) = lax.scan(step, init, xs)
    C_prev = jnp.moveaxis(C_prev, 0, 2)
    n_prev = jnp.moveaxis(n_prev, 0, 2)
    m_prev = jnp.moveaxis(m_prev, 0, 2)

    m_t = jnp.maximum(a + m_prev[..., None], jnp.max(log_d, axis=-1))
    inter_w = jnp.exp(a + m_prev[..., None] - m_t)
    qk = jnp.einsum('bhcld,bhcsd->bhcls', q, k) * jnp.exp(log_d - m_t[..., None])
    num = inter_w[..., None] * jnp.einsum('bhcde,bhcle->bhcld', C_prev, q) + jnp.einsum('bhcls,bhcsd->bhcld', qk, v)
    den = inter_w * jnp.einsum('bhce,bhcle->bhcl', n_prev, q) + jnp.sum(qk, axis=-1)
    h = num / jnp.maximum(jnp.abs(den), jnp.exp(-m_t))[..., None]
    return h.transpose(0, 2, 3, 1, 4).reshape(B, S, H * d)


def forgetting_attention(q, k, v, f_pre, q_g, k_g):
    B, S, _ = q.shape

    def heads(t):
        return t.reshape(B, S, FX_HEADS, FX_HEAD_DIM).transpose(0, 2, 1, 3)

    q = rms_norm(heads(q), q_g)
    k = rms_norm(heads(k), k_g)
    v = heads(v)
    cum_logf = jnp.cumsum(jax.nn.log_sigmoid(f_pre.astype(jnp.float32)), axis=1).transpose(0, 2, 1)
    k_pos = jnp.arange(S)
    scale = FX_HEAD_DIM ** -0.5

    def block(i):
        start = i * Q_BLOCK
        qb = lax.dynamic_slice_in_dim(q, start, Q_BLOCK, axis=2)
        fq = lax.dynamic_slice_in_dim(cum_logf, start, Q_BLOCK, axis=2)
        q_pos = start + jnp.arange(Q_BLOCK)
        logits = jnp.einsum('bhqd,bhkd->bhqk', qb, k, preferred_element_type=jnp.float32) * scale
        logits = logits + fq[..., :, None] - cum_logf[..., None, :]
        logits = jnp.where(k_pos[None, :] <= q_pos[:, None], logits, -jnp.inf)
        p = jax.nn.softmax(logits, axis=-1)
        return jnp.einsum('bhqk,bhkd->bhqd', p.astype(v.dtype), v)

    out = lax.map(block, jnp.arange(S // Q_BLOCK))
    return out.transpose(1, 0, 3, 2, 4).reshape(B, S, FX_WIDTH)


def setup_inputs(seed: int = 0) -> dict:
    key = jax.random.key(seed)
    ks = jax.random.split(key, 24)
    f32 = jnp.float32

    def nrm(k, shape, s):
        return jax.random.normal(k, shape, f32) * s

    return {
        'x': nrm(ks[0], (BATCH, SEQ, D_MODEL), 1.0),
        'c': nrm(ks[1], (BATCH, D_MODEL), 1.0),
        'ada_w': nrm(ks[2], (DEPTH, D_MODEL, 6 * D_MODEL), 0.5 * D_MODEL ** -0.5),
        'ada_b': nrm(ks[3], (DEPTH, 6 * D_MODEL), 0.02),
        'norm_mix_g': 1.0 + nrm(ks[4], (DEPTH, D_MODEL), 0.02),
        'norm_ffn_g': 1.0 + nrm(ks[5], (DEPTH, D_MODEL), 0.02),
        'ab_w_in': nrm(ks[6], (N_EVEN, D_MODEL, AB_IN), D_MODEL ** -0.5),
        'ml_b_i': nrm(ks[7], (N_EVEN, ML_HEADS), 0.1),
        'ml_b_f': jnp.linspace(3.0, 6.0, ML_HEADS, dtype=f32)[None, :] + nrm(ks[8], (N_EVEN, ML_HEADS), 0.1),
        'ml_conv_w': nrm(ks[9], (N_EVEN, ML_CONV, 2 * ML_WIDTH), ML_CONV ** -0.5),
        'ml_conv_b': nrm(ks[10], (N_EVEN, 2 * ML_WIDTH), 0.02),
        'da_q_g': 1.0 + nrm(ks[11], (N_EVEN, DA_HEAD_DIM), 0.02),
        'da_k_g': 1.0 + nrm(ks[12], (N_EVEN, DA_HEAD_DIM), 0.02),
        'da_lambda': nrm(ks[13], (N_EVEN, 4, DA_HEAD_DIM), 0.1),
        'da_subln_g': 1.0 + nrm(ks[14], (N_EVEN, 2 * DA_HEAD_DIM), 0.02),
        'ab_w_out': nrm(ks[15], (N_EVEN, AB_OUT, D_MODEL), AB_OUT ** -0.5),
        'fx_w_in': nrm(ks[16], (N_ODD, D_MODEL, FX_IN), D_MODEL ** -0.5),
        'fx_b_f': jnp.linspace(1.0, 6.0, FX_HEADS, dtype=f32)[None, :] + nrm(ks[17], (N_ODD, FX_HEADS), 0.1),
        'fx_q_g': 1.0 + nrm(ks[18], (N_ODD, FX_HEAD_DIM), 0.02),
        'fx_k_g': 1.0 + nrm(ks[19], (N_ODD, FX_HEAD_DIM), 0.02),
        'fx_w_out': nrm(ks[20], (N_ODD, FX_WIDTH, D_MODEL), FX_WIDTH ** -0.5),
        'ffn_w1': nrm(ks[21], (DEPTH, D_MODEL, FFN_HIDDEN), D_MODEL ** -0.5),
        'ffn_w3': nrm(ks[22], (DEPTH, D_MODEL, FFN_HIDDEN), D_MODEL ** -0.5),
        'ffn_w2': nrm(ks[23], (DEPTH, FFN_HIDDEN, D_MODEL), FFN_HIDDEN ** -0.5),
    }


def reference(x, c, ada_w, ada_b, norm_mix_g, norm_ffn_g, ab_w_in, ml_b_i, ml_b_f, ml_conv_w, ml_conv_b,
              da_q_g, da_k_g, da_lambda, da_subln_g, ab_w_out, fx_w_in, fx_b_f, fx_q_g, fx_k_g, fx_w_out,
              ffn_w1, ffn_w3, ffn_w2):
    c_act = jax.nn.silu(c)
    ab_sizes = [DA_WIDTH] * 3 + [ML_WIDTH] * 4 + [ML_HEADS] * 2
    ab_split = np.cumsum(ab_sizes)[:-1].tolist()
    for l in range(DEPTH):
        mod = c_act @ ada_w[l] + ada_b[l]
        sh_m, sc_m, g_m, sh_f, sc_f, g_f = jnp.split(mod, 6, axis=-1)
        h = modulate(rms_norm(x, norm_mix_g[l]), sh_m, sc_m)
        j = l // 2
        if l % 2 == 0:
            z = h @ ab_w_in[j]
            da_q, da_k, da_v, ml_q, ml_k, ml_v, ml_o, ml_i, ml_f = jnp.split(z, ab_split, axis=-1)
            ml_qk = jax.nn.silu(causal_conv(jnp.concatenate([ml_q, ml_k], axis=-1), ml_conv_w[j], ml_conv_b[j]))
            ml_q, ml_k = jnp.split(ml_qk, 2, axis=-1)
            y_da = diff_attention(da_q, da_k, da_v, da_q_g[j], da_k_g[j], da_lambda[j], da_subln_g[j], l)
            y_ml = jax.nn.sigmoid(ml_o) * mlstm(ml_q, ml_k, ml_v, ml_i + ml_b_i[j], ml_f + ml_b_f[j])
            y = jnp.concatenate([y_da, y_ml.astype(h.dtype)], axis=-1) @ ab_w_out[j]
        else:
            z = h @ fx_w_in[j]
            fq, fk, fv, ff = jnp.split(z, [FX_WIDTH, 2 * FX_WIDTH, 3 * FX_WIDTH], axis=-1)
            y = forgetting_attention(fq, fk, fv, ff + fx_b_f[j], fx_q_g[j], fx_k_g[j]) @ fx_w_out[j]
        x = x + g_m[:, None, :] * y
        h = modulate(rms_norm(x, norm_ffn_g[l]), sh_f, sc_f)
        ffn = (jax.nn.silu(h @ ffn_w1[l]) * (h @ ffn_w3[l])) @ ffn_w2[l]
        x = x + g_f[:, None, :] * ffn
    return x
```

```cpp
#include <hip/hip_runtime.h>
#include <cstdio>
#include <cstdint>
#include <cmath>
#ifndef MK_SINGLE
#define MK_SINGLE 1
#endif
namespace pg8 {
#define PG8_LAS __attribute__((address_space(3)))
typedef unsigned short bf16_t;
typedef short bf16x8 __attribute__((ext_vector_type(8)));
typedef float f32x4 __attribute__((ext_vector_type(4)));
typedef unsigned u32x4 __attribute__((ext_vector_type(4)));
constexpr int BM = 256, BK = 64, HALF = 128, HTB = HALF * BK * 2  , STAGE_BYTES = 8 * HTB, NXCD = 8, WGM = 8;

__host__ __device__ __forceinline__ int lds_byte(int r, int c) { const int st = (r >> 4) * 2 + (c >> 5), rr = r & 15, cc = c & 31, ob = rr * 64 + cc * 2; return st * 1024 + (ob ^ (((ob >> 9) & 1) << 5)); }
__host__ __device__ __forceinline__ void stage_rc(int b, int& R, int& C) { const int st = b / 1024, sb = b % 1024, swz = sb ^ (((sb >> 9) & 1) << 5); R = (st >> 1) * 16 + swz / 64; C = (st & 1) * 32 + (swz % 64) / 2; }
__host__ __device__ __forceinline__ int perm32(int rho) { const int n = rho >> 4, i = rho & 15; return 8 * (i >> 2) + 4 * n + (i & 3); }

struct Unit { int pm, pn; };
struct Gemm { const bf16_t* A; const bf16_t* Bt; int M, N, K; };

struct StaticOrder {
    int nM, nN, nwg, G, c;
    __host__ __device__ void init(int M, int N, int G_, int c_) { nM = M / BM; nN = N / BM; nwg = nM * nN; G = G_; c = c_; }
    __host__ __device__ bool next(int i, Unit& u) const {
        const long L = (long)i * G + c; if (L >= nwg) return false;
        int wgid = (int)L; { const int q = nwg / NXCD, r = nwg % NXCD, xcd = wgid % NXCD, off = wgid / NXCD; wgid = (xcd < r ? xcd * (q + 1) : r * (q + 1) + (xcd - r) * q) + off; }
        const int nig = WGM * nN, gid = wgid / nig, fm = gid * WGM, gsz = (nM - fm) < WGM ? (nM - fm) : WGM;
        u.pm = fm + ((wgid % nig) % gsz); u.pn = (wgid % nig) / gsz; return true;
    }
    __device__ __forceinline__ void a_ready(const Unit&) const {}
    __device__ __forceinline__ void done(const Unit&) const {}
};

__device__ __forceinline__ unsigned cvt_pk_bf16(float lo, float hi) { unsigned r; asm volatile("v_cvt_pk_bf16_f32 %0, %1, %2" : "=v"(r) : "v"(lo), "v"(hi)); return r; }
typedef float f32x2 __attribute__((ext_vector_type(2)));
constexpr int SEQ_ROWS = 4096;
__device__ __forceinline__ float fast_sigmoid(float x) { return __builtin_amdgcn_rcpf(1.0f + __builtin_amdgcn_exp2f(-1.4426950408889634f * x)); }
struct EpiIn {
    static constexpr bool PERM = true, AFTER_DRAIN = false;
    bf16_t* Z; int ldz; int nq_end, nk_end; const float* gq; const float* gk; float qscale;
    __device__ __forceinline__ void operator()(const f32x4 (&acc)[2][2][4][2], const Unit& u, int wr, int wc, int fr, int fq) const {
        const int c0 = u.pn * BM + 64 * wc;
        const int mode = c0 < nq_end ? 1 : (c0 < nk_end ? 2 : 0);
        const int row0 = u.pm * BM + wr * 64 + fr;
        if (mode != 0) {
            const float* gp = (mode == 1 ? gq : gk) + 8 * fq;
            const float sc = (mode == 1) ? qscale : 1.0f;
            f32x4 gv[2][2];
#pragma unroll
            for (int bj = 0; bj < 2; ++bj)
#pragma unroll
                for (int n = 0; n < 2; ++n) gv[bj][n] = *(const f32x4*)(gp + 32 * bj + 4 * n);
#pragma unroll
            for (int ai = 0; ai < 2; ++ai)
#pragma unroll
                for (int m = 0; m < 4; ++m) {
                    float ss = 0.f;
#pragma unroll
                    for (int bj = 0; bj < 2; ++bj)
#pragma unroll
                        for (int n = 0; n < 2; ++n) { const f32x4 x = acc[ai][bj][m][n]; ss += (x[0] * x[0] + x[1] * x[1]) + (x[2] * x[2] + x[3] * x[3]); }
                    ss += __shfl_xor(ss, 16); ss += __shfl_xor(ss, 32);
                    const float r = sc / sqrtf(ss * (1.0f / 64.0f) + 1e-6f);
                    bf16_t* rowp = Z + (size_t)(row0 + ai * HALF + m * 16) * ldz + c0 + 8 * fq;
#pragma unroll
                    for (int bj = 0; bj < 2; ++bj) { const f32x4 v0 = acc[ai][bj][m][0] * r * gv[bj][0], v1 = acc[ai][bj][m][1] * r * gv[bj][1];
                        u32x4 w; w.x = cvt_pk_bf16(v0[0], v0[1]); w.y = cvt_pk_bf16(v0[2], v0[3]); w.z = cvt_pk_bf16(v1[0], v1[1]); w.w = cvt_pk_bf16(v1[2], v1[3]);
                        *(u32x4*)(rowp + 32 * bj) = w; }
                }
        } else {
#pragma unroll
            for (int ai = 0; ai < 2; ++ai)
#pragma unroll
                for (int m = 0; m < 4; ++m) {
                    bf16_t* rowp = Z + (size_t)(row0 + ai * HALF + m * 16) * ldz + c0 + 8 * fq;
#pragma unroll
                    for (int bj = 0; bj < 2; ++bj) { const f32x4 v0 = acc[ai][bj][m][0], v1 = acc[ai][bj][m][1];
                        u32x4 w; w.x = cvt_pk_bf16(v0[0], v0[1]); w.y = cvt_pk_bf16(v0[2], v0[3]); w.z = cvt_pk_bf16(v1[0], v1[1]); w.w = cvt_pk_bf16(v1[2], v1[3]);
                        *(u32x4*)(rowp + 32 * bj) = w; }
                }
        }
    }
};
struct EpiRes {
    static constexpr bool PERM = true, AFTER_DRAIN = false;
    const float* xin; float* out; const float* gate; int gstride;
    __device__ __forceinline__ void operator()(const f32x4 (&acc)[2][2][4][2], const Unit& u, int wr, int wc, int fr, int fq) const {
        const int b = (u.pm * BM) / SEQ_ROWS;
        const int col0 = u.pn * BM + wc * 32 + 8 * fq;
        const float* gb = gate + (size_t)b * gstride + col0;
        f32x4 gv[2][2];
#pragma unroll
        for (int bj = 0; bj < 2; ++bj)
#pragma unroll
            for (int n = 0; n < 2; ++n) gv[bj][n] = *(const f32x4*)(gb + bj * HALF + 4 * n);
        const int row0 = u.pm * BM + wr * 64 + fr;
#pragma unroll
        for (int ai = 0; ai < 2; ++ai)
#pragma unroll
            for (int m = 0; m < 4; ++m) { const size_t off = (size_t)(row0 + ai * HALF + m * 16) * 1024 + col0;
#pragma unroll
                for (int bj = 0; bj < 2; ++bj)
#pragma unroll
                    for (int n = 0; n < 2; ++n) { const f32x4 xv = *(const f32x4*)(xin + off + bj * HALF + 4 * n);
                        *(f32x4*)(out + off + bj * HALF + 4 * n) = xv + gv[bj][n] * acc[ai][bj][m][n]; }
                if (m & 1) asm volatile("" ::: "memory"); }
    }
};
struct EpiSwiglu {
    static constexpr bool PERM = true, AFTER_DRAIN = false;
    bf16_t* H; int ldh;
    __device__ __forceinline__ void operator()(const f32x4 (&acc)[2][2][4][2], const Unit& u, int wr, int wc, int fr, int fq) const {
        const int row0 = u.pm * BM + wr * 64 + fr, col0 = u.pn * HALF + wc * 32 + 8 * fq;
#pragma unroll
        for (int ai = 0; ai < 2; ++ai)
#pragma unroll
            for (int m = 0; m < 4; ++m) {
                f32x4 v[2];
#pragma unroll
                for (int n = 0; n < 2; ++n) { const f32x4 a = acc[ai][0][m][n], g = acc[ai][1][m][n];
#pragma unroll
                    for (int i = 0; i < 4; ++i) v[n][i] = a[i] * fast_sigmoid(a[i]) * g[i]; }
                u32x4 w; w.x = cvt_pk_bf16(v[0][0], v[0][1]); w.y = cvt_pk_bf16(v[0][2], v[0][3]); w.z = cvt_pk_bf16(v[1][0], v[1][1]); w.w = cvt_pk_bf16(v[1][2], v[1][3]);
                *(u32x4*)(H + (size_t)(row0 + ai * HALF + m * 16) * ldh + col0) = w;
            }
    }
};
template <class Epi, class Sched, bool ALIGN_EPI = false, bool SP2 = false>
__device__ __forceinline__ void gemm_phase(PG8_LAS unsigned char* lds, const Gemm g, const Sched& S, const Epi& E) {
    int tid = threadIdx.x; asm volatile("" : "+v"(tid));
    const int wid = __builtin_amdgcn_readfirstlane(tid >> 6), lane = tid & 63, wr = wid >> 2, wc = wid & 3, fr = lane & 15, fq = lane >> 4;
    const int K = g.K, nt = K / BK;
    unsigned voffA[2], voffB[2];
#pragma unroll
    for (int i = 0; i < 2; ++i) { int R, C; stage_rc(tid * 16 + i * 8192, R, C); const int Rb = Epi::PERM ? ((R & ~31) + perm32(R & 31)) : R;
        voffA[i] = (unsigned)(R * K + C) * 2u; voffB[i] = (unsigned)(Rb * K + C) * 2u; }
    const size_t kstep = (size_t)(BK * 2);
    const size_t hstep = (size_t)HALF * K * 2;
    const size_t tstep = 2 * hstep;
    const unsigned ldsw = (unsigned)wid * 1024u;
    const int aoff = lds_byte(wr * 64 + fr, fq * 8), boff = lds_byte(wc * 32 + fr, fq * 8);
#define PG8_SA(b, h) (((b) * 2 + (h)) * HTB)
#define PG8_SB(b, h) ((4 + (b) * 2 + (h)) * HTB)
#define PG8_STAGE(bufoff, gbase, voff) do { _Pragma("unroll") for (int _i = 0; _i < 2; ++_i) \
        __builtin_amdgcn_global_load_lds((const unsigned*)((const char*)(gbase) + (voff)[_i]), (PG8_LAS unsigned*)(lds + (bufoff) + ldsw + _i * 8192), 16, 0, 0); } while (0)
#define PG8_LDA(dst, b, h) do { _Pragma("unroll") for (int m = 0; m < 4; ++m) _Pragma("unroll") for (int k = 0; k < 2; ++k) dst[m][k] = *(const PG8_LAS bf16x8*)(lds + PG8_SA(b, h) + aoff + m * 2048 + k * 1024); } while (0)
#define PG8_LDB(dst, b, h) do { _Pragma("unroll") for (int n = 0; n < 2; ++n) _Pragma("unroll") for (int k = 0; k < 2; ++k) dst[n][k] = *(const PG8_LAS bf16x8*)(lds + PG8_SB(b, h) + boff + n * 2048 + k * 1024); } while (0)
#define PG8_MMA(ai, bj, At, Bt) do { __builtin_amdgcn_s_setprio(1); _Pragma("unroll") for (int m = 0; m < 4; ++m) _Pragma("unroll") for (int n = 0; n < 2; ++n) _Pragma("unroll") for (int k = 0; k < 2; ++k) \
        acc[ai][bj][m][n] = __builtin_amdgcn_mfma_f32_16x16x32_bf16(Bt[n][k], At[m][k], acc[ai][bj][m][n], 0, 0, 0); __builtin_amdgcn_s_setprio(0); } while (0)
#define PG8_WAIT_V(n) asm volatile("s_waitcnt vmcnt(" #n ")" ::: "memory")
#define PG8_WAIT_L(n) asm volatile("s_waitcnt lgkmcnt(" #n ")" ::: "memory")
#define PG8_BAR __builtin_amdgcn_s_barrier()
#define PG8_SCHED __builtin_amdgcn_sched_barrier(0)
    Unit cur, nxt; int ui = 0;
    if (!S.next(0, cur)) return;
    f32x4 acc[2][2][4][2];
#pragma unroll
    for (int a = 0; a < 2; ++a)
#pragma unroll
        for (int b = 0; b < 2; ++b)
#pragma unroll
            for (int m = 0; m < 4; ++m)
#pragma unroll
                for (int n = 0; n < 2; ++n) acc[a][b][m][n] = (f32x4){0.f, 0.f, 0.f, 0.f};
    bf16x8 At[4][2], B0[2][2], B1[2][2];
    const char* cA = (const char*)g.A + (size_t)cur.pm * tstep; const char* cB = (const char*)g.Bt + (size_t)cur.pn * tstep;
    S.a_ready(cur);
    if constexpr (SP2) {
        PG8_STAGE(PG8_SB(0, 0), cB, voffB); PG8_STAGE(PG8_SB(0, 1), cB + hstep, voffB); PG8_STAGE(PG8_SA(0, 0), cA, voffA); PG8_STAGE(PG8_SA(0, 1), cA + hstep, voffA);
        if (wr == 1) PG8_BAR;
        PG8_WAIT_V(2); PG8_BAR;
        PG8_STAGE(PG8_SB(1, 0), cB + kstep, voffB); PG8_STAGE(PG8_SA(1, 0), cA + kstep, voffA); PG8_STAGE(PG8_SB(1, 1), cB + hstep + kstep, voffB);
        PG8_WAIT_V(6); PG8_BAR;
    } else {
        PG8_STAGE(PG8_SB(0, 0), cB, voffB); PG8_STAGE(PG8_SA(0, 0), cA, voffA); PG8_STAGE(PG8_SB(0, 1), cB + hstep, voffB); PG8_STAGE(PG8_SA(0, 1), cA + hstep, voffA);
        if (wr == 1) PG8_BAR;
        PG8_WAIT_V(4); PG8_BAR;
        PG8_STAGE(PG8_SB(1, 0), cB + kstep, voffB); PG8_STAGE(PG8_SA(1, 0), cA + kstep, voffA); PG8_STAGE(PG8_SB(1, 1), cB + hstep + kstep, voffB);
        PG8_WAIT_V(6); PG8_BAR;
    }
    for (;;) {
        const bool has_next = S.next(ui + 1, nxt);
        const char* nA = has_next ? (const char*)g.A + (size_t)nxt.pm * tstep : cA; const char* nB = has_next ? (const char*)g.Bt + (size_t)nxt.pn * tstep : cB;
        for (int t = 0; t < nt; t += 2) {
            const bool last = (t == nt - 2);
            const char* a1 = cA + (size_t)(t + 1) * kstep;
            const char* a2 = last ? nA : cA + (size_t)(t + 2) * kstep; const char* b2 = last ? nB : cB + (size_t)(t + 2) * kstep;
            const char* a3 = a2 + kstep; const char* b3 = b2 + kstep;
            if (last && has_next) S.a_ready(nxt);
            if constexpr (SP2) {
            PG8_LDB(B0, 0, 0); PG8_LDB(B1, 0, 1); PG8_SCHED; PG8_LDA(At, 0, 0); PG8_STAGE(PG8_SA(1, 1), a1 + hstep, voffA);
            PG8_WAIT_V(8); PG8_WAIT_L(0); PG8_BAR; PG8_MMA(0, 0, At, B0); PG8_MMA(0, 1, At, B1); PG8_BAR; PG8_SCHED;
            PG8_LDA(At, 0, 1); PG8_STAGE(PG8_SB(0, 0), b2, voffB); PG8_STAGE(PG8_SB(0, 1), b2 + hstep, voffB); PG8_STAGE(PG8_SA(0, 0), a2, voffA);
            PG8_WAIT_V(8); PG8_WAIT_L(0); PG8_BAR; PG8_MMA(1, 0, At, B0); PG8_MMA(1, 1, At, B1); PG8_BAR; PG8_SCHED;
            PG8_LDB(B0, 1, 0); PG8_LDB(B1, 1, 1); PG8_SCHED; PG8_LDA(At, 1, 0); PG8_STAGE(PG8_SA(0, 1), a2 + hstep, voffA);
            PG8_WAIT_V(8); PG8_WAIT_L(0); PG8_BAR; PG8_MMA(0, 0, At, B0); PG8_MMA(0, 1, At, B1); PG8_BAR; PG8_SCHED;
            PG8_LDA(At, 1, 1); PG8_STAGE(PG8_SB(1, 0), b3, voffB); PG8_STAGE(PG8_SB(1, 1), b3 + hstep, voffB); PG8_STAGE(PG8_SA(1, 0), a3, voffA);
            PG8_WAIT_V(8); PG8_WAIT_L(0); PG8_BAR; PG8_MMA(1, 0, At, B0); PG8_MMA(1, 1, At, B1); PG8_BAR; PG8_SCHED;
            } else {
            PG8_LDB(B0, 0, 0); PG8_SCHED; PG8_LDA(At, 0, 0); PG8_STAGE(PG8_SA(1, 1), a1 + hstep, voffA);
            PG8_WAIT_L(8); PG8_BAR; PG8_WAIT_L(0); PG8_MMA(0, 0, At, B0); PG8_BAR; PG8_SCHED;
            PG8_LDB(B1, 0, 1); PG8_STAGE(PG8_SB(0, 0), b2, voffB);
            PG8_BAR; PG8_WAIT_L(0); PG8_MMA(0, 1, At, B1); PG8_BAR;
            PG8_LDA(At, 0, 1); PG8_STAGE(PG8_SA(0, 0), a2, voffA);
            PG8_BAR; PG8_WAIT_L(0); PG8_MMA(1, 0, At, B0); PG8_BAR; PG8_SCHED;
            PG8_STAGE(PG8_SB(0, 1), b2 + hstep, voffB);
            PG8_WAIT_V(6); PG8_BAR; PG8_MMA(1, 1, At, B1); PG8_BAR;
            PG8_LDB(B0, 1, 0); PG8_SCHED; PG8_LDA(At, 1, 0); PG8_STAGE(PG8_SA(0, 1), a2 + hstep, voffA);
            PG8_WAIT_L(8); PG8_BAR; PG8_WAIT_L(0); PG8_MMA(0, 0, At, B0); PG8_BAR; PG8_SCHED;
            PG8_LDB(B1, 1, 1); PG8_STAGE(PG8_SB(1, 0), b3, voffB);
            PG8_BAR; PG8_WAIT_L(0); PG8_MMA(0, 1, At, B1); PG8_BAR;
            PG8_LDA(At, 1, 1); PG8_STAGE(PG8_SA(1, 0), a3, voffA);
            PG8_BAR; PG8_WAIT_L(0); PG8_MMA(1, 0, At, B0); PG8_BAR; PG8_SCHED;
            PG8_STAGE(PG8_SB(1, 1), b3 + hstep, voffB);
            PG8_WAIT_V(6); PG8_BAR; PG8_MMA(1, 1, At, B1); PG8_BAR;
            }
        }
        if constexpr (ALIGN_EPI) { if (wr == 0) PG8_BAR; }
        if constexpr (!Epi::AFTER_DRAIN) { E(acc, cur, wr, wc, fr, fq); S.done(cur); }
        if (!has_next) break;
#pragma unroll
        for (int a = 0; a < 2; ++a)
#pragma unroll
            for (int b = 0; b < 2; ++b)
#pragma unroll
                for (int m = 0; m < 4; ++m)
#pragma unroll
                    for (int n = 0; n < 2; ++n) acc[a][b][m][n] = (f32x4){0.f, 0.f, 0.f, 0.f};
        cur = nxt; cA = nA; cB = nB; ++ui;
        if constexpr (ALIGN_EPI) { if (wr == 1) PG8_BAR; }
    }
    PG8_WAIT_V(0);
    if constexpr (!ALIGN_EPI) { if (wr == 0) PG8_BAR; }
    PG8_BAR;
    if constexpr (Epi::AFTER_DRAIN) { E.fused(acc, cur, wr, wc, fr, fq, lds, wid, lane); S.done(cur); }
#undef PG8_SA
#undef PG8_SB
#undef PG8_STAGE
#undef PG8_LDA
#undef PG8_LDB
#undef PG8_MMA
#undef PG8_WAIT_V
#undef PG8_WAIT_L
#undef PG8_BAR
#undef PG8_SCHED
}
}
constexpr int NWAVES = 8, NTHREADS = NWAVES * 64;
constexpr int D = 1024, BATCH = 8, SEQ = 4096, DEPTH = 4, M = BATCH * SEQ;
constexpr int FFH = 2816, NUP = 2 * FFH;
constexpr int AB_LD = 3592, AB_N = 3584;
constexpr int FX_LD = 3088, FX_N = 3072;
constexpr int MODW = 6 * D;
constexpr float EPS = 1e-6f, LOG2E = 1.4426950408889634f;
static_assert(pg8::SEQ_ROWS == SEQ, "row -> batch");

constexpr size_t MiB = 1u << 20;
constexpr size_t WS_CTL = 0, CTL_ZERO_BYTES = 1 * MiB;
constexpr size_t WS_MOD = 1 * MiB;
constexpr size_t WS_GATE = 2 * MiB;
constexpr size_t WS_WIN_E = 4 * MiB;
constexpr size_t WS_WIN_O = 18 * MiB;
constexpr size_t WS_WOUT = 30 * MiB;
constexpr size_t WS_WUP = 38 * MiB;
constexpr size_t WS_WDN = 82 * MiB;
constexpr size_t WS_A1 = 104 * MiB;
constexpr size_t WS_Z = 168 * MiB;
constexpr size_t WS_END = 392 * MiB;
constexpr int CW_BAR = 4096;
constexpr int CW_QUEUE = 16384;

constexpr int RING_OFF = 0, RING_BYTES = 131072;
constexpr int LDSCTL_OFF = RING_BYTES, MISC_OFF = LDSCTL_OFF + 320;
constexpr int LDS_BYTES = 147456;

#define GAS __attribute__((address_space(1)))
#define LAS __attribute__((address_space(3)))
typedef unsigned short bf16;
typedef unsigned v4u __attribute__((ext_vector_type(4)));
typedef float f32x4 __attribute__((ext_vector_type(4)));
typedef short bf16x8 __attribute__((ext_vector_type(8)));
typedef GAS unsigned gu32;
typedef GAS unsigned long long gu64;
#define RLX_AGENT __ATOMIC_RELAXED, __HIP_MEMORY_SCOPE_AGENT
#define LDS_WAIT() asm volatile("s_waitcnt lgkmcnt(0)" ::: "memory")
#define VM_WAIT() asm volatile("s_waitcnt vmcnt(0)" ::: "memory")
__device__ __forceinline__ unsigned long long rt() { return __builtin_amdgcn_s_memrealtime(); }
__device__ __forceinline__ unsigned f2bf(float f) { unsigned u = __builtin_bit_cast(unsigned, f); return (u + 0x7fffu + ((u >> 16) & 1u)) >> 16; }
__device__ __forceinline__ unsigned pk2(float lo, float hi) { return f2bf(lo) | (f2bf(hi) << 16); }

#define XB_TMO      128
#define XB_XCNT(j)  (256  + 64 * (j))
#define XB_XSUB(j)  (1280 + 64 * (j))
#define XB_XGEN(j)  (2304 + 64 * (j))
#define XB_TOP      3328
#define XB_TOPGEN   3392
#define XCD_BAR_WORDS 3456
#define XB_SPIN_CAP (1u << 18)

__device__ __forceinline__ unsigned xb_ld(unsigned* p)              { return __hip_atomic_load(p, __ATOMIC_RELAXED, __HIP_MEMORY_SCOPE_AGENT); }
__device__ __forceinline__ unsigned xb_add(unsigned* p, unsigned v) { return __hip_atomic_fetch_add(p, v, __ATOMIC_RELAXED, __HIP_MEMORY_SCOPE_AGENT); }
__device__ __forceinline__ unsigned xb_xcc_id() { return (unsigned)__builtin_amdgcn_s_getreg((3 << 11) | 20) & 0xFu; }
#define XB_SPIN(cond, bar) do { unsigned _sp = 0; while (cond) { __builtin_amdgcn_s_sleep(1); \
    if ((++_sp & 255u) == 0u) { if (xb_ld(&(bar)[XB_TMO])) break; if (_sp > XB_SPIN_CAP) { atomicAdd(&(bar)[XB_TMO], 1u); break; } } } } while (0)

struct XcdBarrier {
    unsigned* bar; unsigned x;
    volatile LAS unsigned* st;
};

__device__ __forceinline__ XcdBarrier xcd_barrier_post(unsigned* bar, volatile LAS unsigned* st) {
    XcdBarrier b; b.bar = bar; b.x = xb_xcc_id(); b.st = st;
    if (threadIdx.x == 0) (void)xb_add(&bar[XB_XCNT(b.x)], 1u);
    return b;
}
__device__ __forceinline__ void xcd_barrier_complete(unsigned* bar, unsigned x, unsigned& nloc, unsigned& nx) {
    const unsigned G = gridDim.x * gridDim.y * gridDim.z;
    unsigned sum, cnt, mine, sp = 0u;
    for (;;) {
        sum = 0u; cnt = 0u; mine = 0u;
#pragma unroll
        for (unsigned j = 0; j < 16; ++j) { const unsigned c = xb_ld(&bar[XB_XCNT(j)]); sum += c; cnt += (c > 0u) ? 1u : 0u; mine = (j == x) ? c : mine; }
        if (sum == G) break;
        __builtin_amdgcn_s_sleep(1);
        if ((++sp & 255u) == 0u) { if (xb_ld(&bar[XB_TMO])) break; if (sp > XB_SPIN_CAP) { atomicAdd(&bar[XB_TMO], 1u); break; } }
    }
    nloc = mine > 0u ? mine : 1u; nx = cnt > 0u ? cnt : 1u;
}

__device__ __forceinline__ void xcd_barrier(const XcdBarrier& b) {
    asm volatile("s_waitcnt vmcnt(0)" ::: "memory");
    __syncthreads();
    if (threadIdx.x == 0) {
        unsigned* bar = b.bar;
        __builtin_amdgcn_s_waitcnt(0);
        unsigned nloc = b.st[0], nx = b.st[1];
        if (nloc == 0u) { xcd_barrier_complete(bar, b.x, nloc, nx); b.st[0] = nloc; b.st[1] = nx; }
        const unsigned old = xb_add(&bar[XB_XSUB(b.x)], 1u);
        const unsigned gen = old / nloc;
        if (old + 1u == (gen + 1u) * nloc) {
            __builtin_amdgcn_fence(__ATOMIC_RELEASE, "agent");
            asm volatile("s_waitcnt vmcnt(0)" ::: "memory");
            const unsigned og = xb_add(&bar[XB_TOP], 1u);
            const unsigned tg = og / nx;
            if (og + 1u == (tg + 1u) * nx) xb_add(&bar[XB_TOPGEN], 1u);
            else XB_SPIN(xb_ld(&bar[XB_TOPGEN]) == tg, bar);
            __builtin_amdgcn_fence(__ATOMIC_ACQUIRE, "agent");
            xb_add(&bar[XB_XGEN(b.x)], 1u);
            asm volatile("s_waitcnt vmcnt(0)" ::: "memory");
        } else {
            XB_SPIN(xb_ld(&bar[XB_XGEN(b.x)]) == gen, bar);
            __builtin_amdgcn_fence(__ATOMIC_ACQUIRE, "agent");
            asm volatile("s_waitcnt vmcnt(0)" ::: "memory");
        }
    }
    __syncthreads();
}

__device__ __forceinline__ float bf_lo(unsigned u) { return __builtin_bit_cast(float, u << 16); }
__device__ __forceinline__ float bf_hi(unsigned u) { return __builtin_bit_cast(float, u & 0xffff0000u); }
__device__ __forceinline__ float bf1(bf16 u) { return __builtin_bit_cast(float, (unsigned)u << 16); }
__device__ __forceinline__ float ex2(float x) { return __builtin_amdgcn_exp2f(x); }
__device__ __forceinline__ float wave_sum(float v) {
#pragma unroll
    for (int o = 1; o < 64; o <<= 1) v += __shfl_xor(v, o);
    return v;
}
__device__ __forceinline__ float log_sigmoid(float x) { return fminf(x, 0.f) - log1pf(__expf(-fabsf(x))); }

struct Args { const float* in[24]; float* out; unsigned char* ws; int ph_lo, ph_hi; };

__device__ __forceinline__ void transpose_item(const float* W, int ld, int K, bf16* WT, int k0, int n0, int row0, LAS float* scr, int lane) {
#pragma unroll 8
    for (int i = 0; i < 32; ++i) { const int kk = 2 * i + (lane >> 5); scr[kk * 33 + (lane & 31)] = W[(size_t)(k0 + kk) * ld + n0 + (lane & 31)]; }
    LDS_WAIT(); asm volatile("" ::: "memory");
    const int c = lane & 7;
#pragma unroll
    for (int j = 0; j < 4; ++j) { const int n = (lane >> 3) + 8 * j; const LAS float* s = scr + (8 * c) * 33 + n;
        v4u o; o.x = pk2(s[0 * 33], s[1 * 33]); o.y = pk2(s[2 * 33], s[3 * 33]); o.z = pk2(s[4 * 33], s[5 * 33]); o.w = pk2(s[6 * 33], s[7 * 33]);
        *(GAS v4u*)(WT + (size_t)(row0 + n) * K + k0 + 8 * c) = o; }
    LDS_WAIT(); asm volatile("" ::: "memory");
}
__device__ __forceinline__ int inproj_row0(int n0) { const int blk = n0 >> 8, q = (n0 >> 5) & 7; return blk * 256 + ((q & 1) * 4 + (q >> 1)) * 32; }

__device__ __forceinline__ void phase_prologue(const Args& a, LAS unsigned char* lds, int tid, int lane, int wave, int G) {
    unsigned char* ws = a.ws;
    {
        LAS float* scr = (LAS float*)(lds + wave * 16384);
        const int gw = blockIdx.x * NWAVES + wave, NGW = G * NWAVES;
        constexpr int I_E = 16 * (AB_N / 32), I_O = 16 * (FX_N / 32), I_OUT = 16 * 32, I_UP = 16 * (FFH / 32), I_DN = (FFH / 64) * 32;
        constexpr int NITEMS = 2 * I_E + 2 * I_O + 4 * I_OUT + 8 * I_UP + 4 * I_DN;
        for (int it = gw; it < NITEMS; it += NGW) {
            int r = it;
            if (r < 2 * I_E) { const int j = r / I_E; r -= j * I_E; const int nb = AB_N / 32, kb = r / nb, n0 = 32 * (r % nb);
                transpose_item(a.in[6] + (size_t)j * D * AB_LD, AB_LD, D, (bf16*)(ws + WS_WIN_E) + (size_t)j * AB_N * D, 64 * kb, n0, inproj_row0(n0), scr, lane); continue; }
            r -= 2 * I_E;
            if (r < 2 * I_O) { const int j = r / I_O; r -= j * I_O; const int nb = FX_N / 32, kb = r / nb, n0 = 32 * (r % nb);
                transpose_item(a.in[16] + (size_t)j * D * FX_LD, FX_LD, D, (bf16*)(ws + WS_WIN_O) + (size_t)j * FX_N * D, 64 * kb, n0, inproj_row0(n0), scr, lane); continue; }
            r -= 2 * I_O;
            if (r < 4 * I_OUT) { const int l = r / I_OUT; r -= l * I_OUT; const int kb = r / 32, n0 = 32 * (r % 32);
                const float* src = (l & 1) ? a.in[20] + (size_t)(l >> 1) * D * D : a.in[15] + (size_t)(l >> 1) * D * D;
                transpose_item(src, D, D, (bf16*)(ws + WS_WOUT) + (size_t)l * D * D, 64 * kb, n0, n0, scr, lane); continue; }
            r -= 4 * I_OUT;
            if (r < 8 * I_UP) { const int lw = r / I_UP; r -= lw * I_UP; const int l = lw >> 1, w3 = lw & 1; const int nb = FFH / 32, kb = r / nb, n0 = 32 * (r % nb);
                const float* src = (w3 ? a.in[22] : a.in[21]) + (size_t)l * D * FFH;
                const int row0 = (n0 >> 7) * 256 + w3 * 128 + (n0 & 127);
                transpose_item(src, FFH, D, (bf16*)(ws + WS_WUP) + (size_t)l * NUP * D, 64 * kb, n0, row0, scr, lane); continue; }
            r -= 8 * I_UP;
            { const int l = r / I_DN; r -= l * I_DN; const int kb = r / 32, n0 = 32 * (r % 32);
                transpose_item(a.in[23] + (size_t)l * FFH * D, D, FFH, (bf16*)(ws + WS_WDN) + (size_t)l * D * FFH, 64 * kb, n0, n0, scr, lane); }
        }
    }
    __syncthreads();
    {
        LAS float* cact = (LAS float*)lds;
        LAS float* red = (LAS float*)(lds + 32768);
        const float* c = a.in[1];
        for (int i = tid; i < BATCH * D; i += NTHREADS) { const float v = c[i]; cact[i] = v / (1.0f + __expf(-v)); }
        __syncthreads();
        float* mod = (float*)(ws + WS_MOD);
        for (int it = blockIdx.x; it < DEPTH * (MODW / 64); it += G) {
            const int l = it / (MODW / 64), cg = it % (MODW / 64);
            const float* wp = a.in[2] + ((size_t)l * D + 128 * wave) * MODW + 64 * cg + lane;
            float acc[BATCH];
#pragma unroll
            for (int b = 0; b < BATCH; ++b) acc[b] = 0.f;
#pragma unroll 8
            for (int kk = 0; kk < 128; ++kk) { const float wv = wp[(size_t)kk * MODW];
#pragma unroll
                for (int b = 0; b < BATCH; ++b) acc[b] += cact[b * D + 128 * wave + kk] * wv; }
#pragma unroll
            for (int b = 0; b < BATCH; ++b) red[(wave * BATCH + b) * 64 + lane] = acc[b];
            __syncthreads();
            { const int b = tid >> 6; float s = 0.f;
#pragma unroll
                for (int w = 0; w < NWAVES; ++w) s += red[(w * BATCH + b) * 64 + lane];
                mod[((size_t)l * BATCH + b) * MODW + 64 * cg + lane] = s + a.in[3][(size_t)l * MODW + 64 * cg + lane]; }
            __syncthreads();
        }
    }
}

template <int NG>
__device__ __forceinline__ void phase_norm(const float* xin, const float* gain, const float* shift, const float* scale  , bf16* hout,
                                           const float* Wg, int ldw, int gcol0, const float* bias_a, const float* bias_b, float* gate_out,
                                           LAS unsigned char* lds, int tid, int lane, int wave, int G) {
    LAS float* wgt = (LAS float*)lds;
    if constexpr (NG > 0) {
        for (int i = tid; i < NG * D; i += NTHREADS) { const int k = i / NG, g = i % NG; wgt[g * D + k] = Wg[(size_t)k * ldw + gcol0 + g]; }
        __syncthreads();
    }
    const int gw = blockIdx.x * NWAVES + wave, NGW = G * NWAVES;
    for (int item = gw; item < M / 16; item += NGW) {
        const int row0 = item * 16, b = row0 / SEQ;
        f32x4 A[4], S[4];
#pragma unroll
        for (int j = 0; j < 4; ++j) { const int c = 4 * lane + 256 * j;
            const f32x4 g4 = *(const f32x4*)(gain + c), sc4 = *(const f32x4*)(scale + (size_t)b * MODW + c);
            A[j] = g4 * (sc4 + 1.0f); S[j] = *(const f32x4*)(shift + (size_t)b * MODW + c); }
        for (int r = 0; r < 16; ++r) {
            asm volatile("" ::: "memory");
            const int row = row0 + r;
            const GAS f32x4* xr = (const GAS f32x4*)(xin + (size_t)row * D) + lane;
            f32x4 v[4]; float ss = 0.f;
#pragma unroll
            for (int j = 0; j < 4; ++j) { v[j] = xr[64 * j]; ss += (v[j].x * v[j].x + v[j].y * v[j].y) + (v[j].z * v[j].z + v[j].w * v[j].w); }
            const float rinv = 1.0f / sqrtf(wave_sum(ss) * (1.0f / D) + EPS);
#pragma unroll
            for (int j = 0; j < 4; ++j) v[j] = v[j] * rinv * A[j] + S[j];
            GAS unsigned long long* o8 = (GAS unsigned long long*)(hout + (size_t)row * D) + lane;
#pragma unroll
            for (int j = 0; j < 4; ++j) o8[64 * j] = (unsigned long long)pk2(v[j].x, v[j].y) | ((unsigned long long)pk2(v[j].z, v[j].w) << 32);
            if constexpr (NG > 0) {
                float p[NG];
#pragma unroll
                for (int g = 0; g < NG; ++g) { float s = 0.f;
#pragma unroll
                    for (int j = 0; j < 4; ++j) { const f32x4 w4 = *(const LAS f32x4*)(wgt + g * D + 4 * lane + 256 * j); s += (v[j].x * w4.x + v[j].y * w4.y) + (v[j].z * w4.z + v[j].w * w4.w); }
                    p[g] = s; }
#define HALVE(NV, OFF) do { const bool up = (lane & (OFF)) != 0; _Pragma("unroll") for (int i = 0; i < (NV); ++i) { const float keep = up ? p[i + (NV)] : p[i], send = up ? p[i] : p[i + (NV)]; p[i] = keep + __shfl_xor(send, (OFF)); } } while (0)
                if constexpr (NG == 16) { HALVE(8, 32); HALVE(4, 16); HALVE(2, 8); HALVE(1, 4); } else { HALVE(4, 32); HALVE(2, 16); HALVE(1, 8); }
#undef HALVE
                float val = p[0];
                constexpr int REM = (NG == 16) ? 2 : 4;
#pragma unroll
                for (int off = REM; off >= 1; off >>= 1) val += __shfl_xor(val, off);
                const int t = row % SEQ;
                if constexpr (NG == 16) { if ((lane & 3) == 0) { const int g = lane >> 2; gate_out[((size_t)b * 16 + g) * SEQ + t] = log_sigmoid(val + bias_b[g]); } }
                else { if ((lane & 7) == 0) { const int g = lane >> 3;
                        if (g < 4) gate_out[((size_t)b * 4 + g) * SEQ + t] = val + bias_a[g];
                        else gate_out[(size_t)BATCH * 4 * SEQ + ((size_t)b * 4 + (g - 4)) * SEQ + t] = log_sigmoid(val + bias_b[g - 4]); } }
            }
        }
    }
}

__device__ __forceinline__ int queue_next(gu32* head, volatile LAS unsigned* MISC, int tid) {
    __syncthreads();
    if (tid == 0) MISC[0] = __hip_atomic_fetch_add(head, 1u, RLX_AGENT);
    __syncthreads();
    return (int)MISC[0];
}

__device__ __forceinline__ void fox_naive_unit(int b, int h, int qb, const bf16* z, const float* lf, bf16* y, LAS unsigned char* lds, int tid, int lane, int wave) {
    LAS float* F = (LAS float*)lds;
    if (wave == 0) { const int seg = 8 * (qb + 1); const float* p = lf + ((size_t)b * 16 + h) * SEQ + lane * seg; float s = 0.f;
        for (int i = 0; i < seg; ++i) s += p[i];
        float inc = s;
#pragma unroll
        for (int off = 1; off < 64; off <<= 1) { const float t = __shfl_up(inc, off); if (lane >= off) inc += t; }
        float run = inc - s;
        for (int i = 0; i < seg; ++i) { run += p[i]; F[lane * seg + i] = run * LOG2E; } }
    __syncthreads();
    const int t = qb * 512 + tid; const size_t rowbase = (size_t)b * SEQ;
    float q[64];
    { const v4u* qp = (const v4u*)(z + (rowbase + t) * FX_N + h * 64);
#pragma unroll
        for (int c = 0; c < 8; ++c) { const v4u u = qp[c]; q[8 * c] = bf_lo(u.x); q[8 * c + 1] = bf_hi(u.x); q[8 * c + 2] = bf_lo(u.y); q[8 * c + 3] = bf_hi(u.y); q[8 * c + 4] = bf_lo(u.z); q[8 * c + 5] = bf_hi(u.z); q[8 * c + 6] = bf_lo(u.w); q[8 * c + 7] = bf_hi(u.w); } }
    float o[64];
#pragma unroll
    for (int d = 0; d < 64; ++d) o[d] = 0.f;
    float m = -INFINITY, l = 0.f; const float Ft = F[t];
    const int smax = qb * 512 + wave * 64 + 63;
    for (int s = 0; s <= smax; ++s) {
        const v4u* kp = (const v4u*)(z + (rowbase + s) * FX_N + 1024 + h * 64);
        float dot = 0.f;
#pragma unroll
        for (int c = 0; c < 8; ++c) { const v4u u = kp[c];
            dot += q[8 * c] * bf_lo(u.x) + q[8 * c + 1] * bf_hi(u.x) + q[8 * c + 2] * bf_lo(u.y) + q[8 * c + 3] * bf_hi(u.y) + q[8 * c + 4] * bf_lo(u.z) + q[8 * c + 5] * bf_hi(u.z) + q[8 * c + 6] * bf_lo(u.w) + q[8 * c + 7] * bf_hi(u.w); }
        float lg = dot + (Ft - F[s]);
        lg = (s <= t) ? lg : -INFINITY;
        const float mn = fmaxf(m, lg), alpha = ex2(m - mn), p = ex2(lg - mn);
        l = l * alpha + p; m = mn;
        const v4u* vp = (const v4u*)(z + (rowbase + s) * FX_N + 2048 + h * 64);
#pragma unroll
        for (int c = 0; c < 8; ++c) { const v4u u = vp[c];
            o[8 * c] = o[8 * c] * alpha + p * bf_lo(u.x); o[8 * c + 1] = o[8 * c + 1] * alpha + p * bf_hi(u.x); o[8 * c + 2] = o[8 * c + 2] * alpha + p * bf_lo(u.y); o[8 * c + 3] = o[8 * c + 3] * alpha + p * bf_hi(u.y);
            o[8 * c + 4] = o[8 * c + 4] * alpha + p * bf_lo(u.z); o[8 * c + 5] = o[8 * c + 5] * alpha + p * bf_hi(u.z); o[8 * c + 6] = o[8 * c + 6] * alpha + p * bf_lo(u.w); o[8 * c + 7] = o[8 * c + 7] * alpha + p * bf_hi(u.w); }
    }
    const float il = 1.0f / l;
    v4u* yp = (v4u*)(y + (rowbase + t) * D + h * 64);
#pragma unroll
    for (int c = 0; c < 8; ++c) { v4u w; w.x = pk2(o[8 * c] * il, o[8 * c + 1] * il); w.y = pk2(o[8 * c + 2] * il, o[8 * c + 3] * il); w.z = pk2(o[8 * c + 4] * il, o[8 * c + 5] * il); w.w = pk2(o[8 * c + 6] * il, o[8 * c + 7] * il); yp[c] = w; }
}

__device__ __forceinline__ void da_naive_unit(int b, int h, int qb, const bf16* z, bf16* y, const float* lam_p, const float* subln_g, int layer, int lane, int wave) {
    const int r = lane & 15, mm = (lane >> 4) & 1, vh = lane >> 5;
    const int t = qb * 128 + wave * 16 + r; const size_t rowbase = (size_t)b * SEQ;
    const float lambda_init = 0.8f - 0.6f * expf(-0.3f * (float)layer);
    float lam;
    { float s0 = 0.f, s1 = 0.f; for (int d = 0; d < 64; ++d) { s0 += lam_p[d] * lam_p[64 + d]; s1 += lam_p[128 + d] * lam_p[192 + d]; } lam = expf(s0) - expf(s1) + lambda_init; }
    const float slope2 = exp2f(-2.0f * (float)(h + 1)) * LOG2E;
    float q[64];
    { const v4u* qp = (const v4u*)(z + (rowbase + t) * AB_N + h * 128 + mm * 64);
#pragma unroll
        for (int c = 0; c < 8; ++c) { const v4u u = qp[c]; q[8 * c] = bf_lo(u.x); q[8 * c + 1] = bf_hi(u.x); q[8 * c + 2] = bf_lo(u.y); q[8 * c + 3] = bf_hi(u.y); q[8 * c + 4] = bf_lo(u.z); q[8 * c + 5] = bf_hi(u.z); q[8 * c + 6] = bf_lo(u.w); q[8 * c + 7] = bf_hi(u.w); } }
    float o[64];
#pragma unroll
    for (int d = 0; d < 64; ++d) o[d] = 0.f;
    float m = -INFINITY, l = 0.f;
    const int smax = (qb * 128 + wave * 16) / 64 * 64 + 63;
    for (int s = 0; s <= smax; ++s) {
        const v4u* kp = (const v4u*)(z + (rowbase + s) * AB_N + 512 + h * 128 + mm * 64);
        float dot = 0.f;
#pragma unroll
        for (int c = 0; c < 8; ++c) { const v4u u = kp[c];
            dot += q[8 * c] * bf_lo(u.x) + q[8 * c + 1] * bf_hi(u.x) + q[8 * c + 2] * bf_lo(u.y) + q[8 * c + 3] * bf_hi(u.y) + q[8 * c + 4] * bf_lo(u.z) + q[8 * c + 5] * bf_hi(u.z) + q[8 * c + 6] * bf_lo(u.w) + q[8 * c + 7] * bf_hi(u.w); }
        const float lg = dot - slope2 * fabsf((float)(t - s));
        const float mn = fmaxf(m, lg), alpha = ex2(m - mn), p = ex2(lg - mn);
        l = l * alpha + p; m = mn;
        const v4u* vp = (const v4u*)(z + (rowbase + s) * AB_N + 1024 + h * 128 + vh * 64);
#pragma unroll
        for (int c = 0; c < 8; ++c) { const v4u u = vp[c];
            o[8 * c] = o[8 * c] * alpha + p * bf_lo(u.x); o[8 * c + 1] = o[8 * c + 1] * alpha + p * bf_hi(u.x); o[8 * c + 2] = o[8 * c + 2] * alpha + p * bf_lo(u.y); o[8 * c + 3] = o[8 * c + 3] * alpha + p * bf_hi(u.y);
            o[8 * c + 4] = o[8 * c + 4] * alpha + p * bf_lo(u.z); o[8 * c + 5] = o[8 * c + 5] * alpha + p * bf_hi(u.z); o[8 * c + 6] = o[8 * c + 6] * alpha + p * bf_lo(u.w); o[8 * c + 7] = o[8 * c + 7] * alpha + p * bf_hi(u.w); }
    }
    const float il = 1.0f / l; float ss = 0.f;
#pragma unroll
    for (int d = 0; d < 64; ++d) { const float mine = o[d] * il, other = __shfl_xor(mine, 16); o[d] = mine - lam * other; ss += o[d] * o[d]; }
    ss += __shfl_xor(ss, 32);
    const float rn = (1.0f - lambda_init) / sqrtf(ss * (1.0f / 128.0f) + EPS);
    if (mm == 0) {
        v4u* yp = (v4u*)(y + (rowbase + t) * D + h * 128 + vh * 64);
#pragma unroll
        for (int c = 0; c < 8; ++c) { float e[8];
#pragma unroll
            for (int i = 0; i < 8; ++i) e[i] = o[8 * c + i] * rn * subln_g[vh * 64 + 8 * c + i];
            v4u w; w.x = pk2(e[0], e[1]); w.y = pk2(e[2], e[3]); w.z = pk2(e[4], e[5]); w.w = pk2(e[6], e[7]); yp[c] = w; }
    }
}

__device__ __forceinline__ void mlstm_naive_unit(int b, int h, const bf16* z, const float* gates, const float* conv_w, const float* conv_b, bf16* y, LAS unsigned char* lds, int tid) {
    LAS float* qs = (LAS float*)lds;
    LAS float* ks = (LAS float*)(lds + 32768);
    LAS float* pn = (LAS float*)(lds + 65536);
    LAS float* pd = (LAS float*)(lds + 65536 + 4096);
    const int dv = tid & 127, eq = tid >> 7; const size_t rowbase = (size_t)b * SEQ;
    const float* gi = gates + ((size_t)b * 4 + h) * SEQ; const float* glf = gates + (size_t)BATCH * 4 * SEQ + ((size_t)b * 4 + h) * SEQ;
    float C[32], n[32];
#pragma unroll
    for (int i = 0; i < 32; ++i) { C[i] = 0.f; n[i] = 0.f; }
    float m = 0.f;
    for (int c = 0; c < SEQ / 64; ++c) {
        for (int it = tid; it < 2048; it += NTHREADS) {
            const int isk = it >> 10, r = (it >> 4) & 63, g = it & 15; const int t = 64 * c + r;
            const int ch = isk * 512 + h * 128 + 8 * g;
            float acc[8];
#pragma unroll
            for (int i = 0; i < 8; ++i) acc[i] = conv_b[ch + i];
#pragma unroll
            for (int j = 0; j < 4; ++j) { const int tt = t - 3 + j;
                if (tt >= 0) { const v4u u = *(const v4u*)(z + (rowbase + tt) * AB_N + 1536 + ch); const float* w = conv_w + j * 1024 + ch;
                    acc[0] += bf_lo(u.x) * w[0]; acc[1] += bf_hi(u.x) * w[1]; acc[2] += bf_lo(u.y) * w[2]; acc[3] += bf_hi(u.y) * w[3];
                    acc[4] += bf_lo(u.z) * w[4]; acc[5] += bf_hi(u.z) * w[5]; acc[6] += bf_lo(u.w) * w[6]; acc[7] += bf_hi(u.w) * w[7]; } }
            LAS float* dst = (isk ? ks : qs) + r * 128 + 8 * g; const float scl = isk ? 0.08838834764831845f : 1.0f;
#pragma unroll
            for (int i = 0; i < 8; ++i) dst[i] = acc[i] / (1.0f + __expf(-acc[i])) * scl;
        }
        __syncthreads();
        for (int r = 0; r < 64; ++r) {
            const int t = 64 * c + r;
            const float lf = glf[t], ig = gi[t];
            const float mn = fmaxf(lf + m, ig), fd = __expf(lf + m - mn), ii = __expf(ig - mn); m = mn;
            const float vv = bf1(z[(rowbase + t) * AB_N + 2560 + h * 128 + dv]) * ii;
            float pnum = 0.f, pden = 0.f;
#pragma unroll
            for (int i = 0; i < 32; ++i) { const float kk = ks[r * 128 + 32 * eq + i], qq = qs[r * 128 + 32 * eq + i];
                C[i] = fd * C[i] + vv * kk; n[i] = fd * n[i] + ii * kk; pnum += C[i] * qq; pden += n[i] * qq; }
            pn[((r & 1) * 4 + eq) * 128 + dv] = pnum; if (dv == 0) pd[(r & 1) * 4 + eq] = pden;
            __syncthreads();
            if (eq == 0) {
                const float num = (pn[((r & 1) * 4 + 0) * 128 + dv] + pn[((r & 1) * 4 + 1) * 128 + dv]) + (pn[((r & 1) * 4 + 2) * 128 + dv] + pn[((r & 1) * 4 + 3) * 128 + dv]);
                const float den = (pd[(r & 1) * 4 + 0] + pd[(r & 1) * 4 + 1]) + (pd[(r & 1) * 4 + 2] + pd[(r & 1) * 4 + 3]);
                const float hh = num / fmaxf(fabsf(den), __expf(-m));
                const float og = bf1(z[(rowbase + t) * AB_N + 3072 + h * 128 + dv]);
                y[(rowbase + t) * D + 512 + h * 128 + dv] = (bf16)f2bf(hh / (1.0f + __expf(-og)));
            }
        }
        __syncthreads();
    }
}

constexpr int N_PHASES = 1 + 7 * DEPTH;
__global__ void __launch_bounds__(NTHREADS, 2) fwd_kernel(Args args) {
    extern __shared__ __attribute__((aligned(16))) unsigned char lds_raw[];
    LAS unsigned char* lds = (LAS unsigned char*)lds_raw;
    volatile LAS unsigned* MISC = (volatile LAS unsigned*)(lds + MISC_OFF);
    const int tid0 = threadIdx.x;
    const int G = gridDim.x;
    unsigned char* ws = args.ws;
    gu32* ctl = (gu32*)(ws + WS_CTL);
    for (int u = tid0; u < (LDS_BYTES - LDSCTL_OFF) / 4; u += NTHREADS) ((LAS unsigned*)(lds + LDSCTL_OFF))[u] = 0u;
    __syncthreads();
    XcdBarrier bar; bar.bar = (unsigned*)(ctl + CW_BAR); bar.x = 0; bar.st = nullptr;
    const int lo = args.ph_lo, hi = args.ph_hi;
    if (hi - lo > 1) bar = xcd_barrier_post((unsigned*)(ctl + CW_BAR), MISC + 8);
#define IN(k) (lo <= (k) && (k) < hi)
#define FRESH_TID() int tid = tid0; asm volatile("" : "+v"(tid)); const int lane = tid & 63, wave = __builtin_amdgcn_readfirstlane(tid >> 6); (void)lane; (void)wave
#define SEAM(k) do { if (IN(k) && IN((k) + 1)) xcd_barrier(bar); } while (0)

    float* mod = (float*)(ws + WS_MOD);
    float* gates = (float*)(ws + WS_GATE);
    bf16* A1 = (bf16*)(ws + WS_A1);
    bf16* Z = (bf16*)(ws + WS_Z);

    if (IN(0)) { const int tid = tid0, lane = tid & 63, wave = __builtin_amdgcn_readfirstlane(tid >> 6); phase_prologue(args, lds, tid, lane, wave, G); }
    SEAM(0);

    for (int l = 0; l < DEPTH; ++l) {
        const int base = 1 + 7 * l, j = l >> 1; const bool odd = (l & 1) != 0;
        const float* xin = (l == 0) ? args.in[0] : args.out;
        const float* modl = mod + (size_t)l * BATCH * MODW;
        if (IN(base + 0)) { FRESH_TID();
            if (!odd) phase_norm<8>(xin, args.in[4] + l * D, modl + 0 * D, modl + 1 * D, A1, args.in[6] + (size_t)j * D * AB_LD, AB_LD, AB_N, args.in[7] + j * 4, args.in[8] + j * 4, gates, lds, tid, lane, wave, G);
            else phase_norm<16>(xin, args.in[4] + l * D, modl + 0 * D, modl + 1 * D, A1, args.in[16] + (size_t)j * D * FX_LD, FX_LD, FX_N, nullptr, args.in[17] + j * 16, gates, lds, tid, lane, wave, G);
        }
        SEAM(base + 0);
        if (IN(base + 1)) {
            const int N = odd ? FX_N : AB_N;
            pg8::Gemm g{A1, odd ? (const bf16*)(ws + WS_WIN_O) + (size_t)j * FX_N * D : (const bf16*)(ws + WS_WIN_E) + (size_t)j * AB_N * D, M, N, D};
            pg8::StaticOrder S; S.init(M, N, G, (int)blockIdx.x);
            pg8::EpiIn E{Z, N, odd ? 1024 : 512, odd ? 2048 : 1024, odd ? args.in[18] + j * 64 : args.in[11] + j * 64, odd ? args.in[19] + j * 64 : args.in[12] + j * 64, 0.125f * LOG2E};
            pg8::gemm_phase<pg8::EpiIn, pg8::StaticOrder, true, true>(lds + RING_OFF, g, S, E);
        }
        SEAM(base + 1);
        if (IN(base + 2)) { FRESH_TID();
            gu32* head = ctl + CW_QUEUE + 64 * l;
            if (!odd) {
                for (;;) { const int idx = queue_next(head, MISC, tid); if (idx >= 32 + 1024) break;
                    if (idx < 32) mlstm_naive_unit(idx >> 2, idx & 3, Z, gates, args.in[9] + (size_t)j * 4 * 1024, args.in[10] + (size_t)j * 1024, A1, lds, tid);
                    else { const int u = idx - 32, qb = 31 - u / 32, bh = u % 32; da_naive_unit(bh >> 2, bh & 3, qb, Z, A1, args.in[13] + j * 256, args.in[14] + j * 128, l, lane, wave); } }
            } else {
                for (;;) { const int idx = queue_next(head, MISC, tid); if (idx >= 1024) break;
                    const int qb = 7 - idx / 128, bh = idx % 128; fox_naive_unit(bh >> 4, bh & 15, qb, Z, gates, A1, lds, tid, lane, wave); }
            }
        }
        SEAM(base + 2);
        if (IN(base + 3)) {
            pg8::Gemm g{A1, (const bf16*)(ws + WS_WOUT) + (size_t)l * D * D, M, D, D};
            pg8::StaticOrder S; S.init(M, D, G, (int)blockIdx.x);
            pg8::EpiRes E{xin, args.out, modl + 2 * D, MODW};
            pg8::gemm_phase<pg8::EpiRes, pg8::StaticOrder, true, true>(lds + RING_OFF, g, S, E);
        }
        SEAM(base + 3);
        if (IN(base + 4)) { FRESH_TID(); phase_norm<0>(args.out, args.in[5] + l * D, modl + 3 * D, modl + 4 * D, A1, nullptr, 0, 0, nullptr, nullptr, nullptr, lds, tid, lane, wave, G); }
        SEAM(base + 4);
        if (IN(base + 5)) {
            pg8::Gemm g{A1, (const bf16*)(ws + WS_WUP) + (size_t)l * NUP * D, M, NUP, D};
            pg8::StaticOrder S; S.init(M, NUP, G, (int)blockIdx.x);
            pg8::EpiSwiglu E{Z, FFH};
            pg8::gemm_phase<pg8::EpiSwiglu, pg8::StaticOrder, true, true>(lds + RING_OFF, g, S, E);
        }
        SEAM(base + 5);
        if (IN(base + 6)) {
            pg8::Gemm g{Z, (const bf16*)(ws + WS_WDN) + (size_t)l * D * FFH, M, D, FFH};
            pg8::StaticOrder S; S.init(M, D, G, (int)blockIdx.x);
            pg8::EpiRes E{args.out, args.out, modl + 5 * D, MODW};
            pg8::gemm_phase<pg8::EpiRes, pg8::StaticOrder, true, true>(lds + RING_OFF, g, S, E);
        }
        SEAM(base + 6);
    }
#undef IN
#undef SEAM
}

extern "C" void kernel_launch(void* const* d_in, const int* in_sizes, int n_in, void* d_out, int out_size, void* d_ws, size_t ws_size, hipStream_t stream) {
    static int grid = 0;
    if (grid == 0) {
        if (n_in != 24 || out_size != M * D || ws_size < WS_END) { fprintf(stderr, "kernel_launch: unexpected shapes (n_in %d, out %d, ws %zu); nothing launched\n", n_in, out_size, ws_size); grid = -1; return; }
        int dev = 0, cus = 0, per_cu = 0;
        if (hipGetDevice(&dev) != hipSuccess || hipDeviceGetAttribute(&cus, hipDeviceAttributeMultiprocessorCount, dev) != hipSuccess) { grid = -1; return; }
        if (hipFuncSetAttribute((const void*)fwd_kernel, hipFuncAttributeMaxDynamicSharedMemorySize, LDS_BYTES) != hipSuccess) { fprintf(stderr, "kernel_launch: hipFuncSetAttribute failed\n"); grid = -1; return; }
        if (hipOccupancyMaxActiveBlocksPerMultiprocessor(&per_cu, (const void*)fwd_kernel, NTHREADS, LDS_BYTES) != hipSuccess || per_cu < 1) { fprintf(stderr, "kernel_launch: occupancy query reports %d blocks per CU\n", per_cu); }
        (void)hipGetLastError();
        grid = cus;
    }
    if (grid < 0) return;
    if (hipMemsetAsync((char*)d_ws + WS_CTL, 0, CTL_ZERO_BYTES, stream) != hipSuccess) return;
    Args a{};
    for (int i = 0; i < 24; ++i) a.in[i] = (const float*)d_in[i];
    a.out = (float*)d_out; a.ws = (unsigned char*)d_ws;
#if MK_SINGLE
    a.ph_lo = 0; a.ph_hi = N_PHASES;
    hipLaunchKernelGGL(fwd_kernel, dim3(grid), dim3(NTHREADS), LDS_BYTES, stream, a);
#else
    for (int p = 0; p < N_PHASES; ++p) { a.ph_lo = p; a.ph_hi = p + 1; hipLaunchKernelGGL(fwd_kernel, dim3(grid), dim3(NTHREADS), LDS_BYTES, stream, a); }
#endif
}
```

```cpp
#include <hip/hip_runtime.h>
#include <cstdio>
#include <cstdint>
#include <cmath>
#ifndef MK_SINGLE
#define MK_SINGLE 1
#endif
#ifndef USE_FOX_MFMA
#define USE_FOX_MFMA 1
#endif
#ifndef USE_DA_MFMA
#define USE_DA_MFMA 1
#endif
#ifndef USE_ML_MFMA
#define USE_ML_MFMA 1
#endif
#ifndef REP_NORM
#define REP_NORM 1
#endif
#ifndef REP_GIN
#define REP_GIN 1
#endif
#ifndef REP_MIX_E
#define REP_MIX_E 1
#endif
#ifndef REP_MIX_O
#define REP_MIX_O 1
#endif
#ifndef REP_GOUT
#define REP_GOUT 1
#endif
#ifndef REP_GUP
#define REP_GUP 1
#endif
#ifndef REP_GDN
#define REP_GDN 1
#endif
#ifndef REP_ML
#define REP_ML 1
#endif
#ifndef REP_DA
#define REP_DA 1
#endif
#ifndef REP_PRO
#define REP_PRO 1
#endif
#ifndef REP_BAR
#define REP_BAR 0
#endif
namespace pg8 {
#define PG8_LAS __attribute__((address_space(3)))
typedef unsigned short bf16_t;
typedef short bf16x8 __attribute__((ext_vector_type(8)));
typedef float f32x4 __attribute__((ext_vector_type(4)));
typedef unsigned u32x4 __attribute__((ext_vector_type(4)));
constexpr int BM = 256, BK = 64, HALF = 128, HTB = HALF * BK * 2  , STAGE_BYTES = 8 * HTB, NXCD = 8, WGM = 8;

__host__ __device__ __forceinline__ int lds_byte(int r, int c) { const int st = (r >> 4) * 2 + (c >> 5), rr = r & 15, cc = c & 31, ob = rr * 64 + cc * 2; return st * 1024 + (ob ^ (((ob >> 9) & 1) << 5)); }
__host__ __device__ __forceinline__ void stage_rc(int b, int& R, int& C) { const int st = b / 1024, sb = b % 1024, swz = sb ^ (((sb >> 9) & 1) << 5); R = (st >> 1) * 16 + swz / 64; C = (st & 1) * 32 + (swz % 64) / 2; }
__host__ __device__ __forceinline__ int perm32(int rho) { const int n = rho >> 4, i = rho & 15; return 8 * (i >> 2) + 4 * n + (i & 3); }

struct Unit { int pm, pn; };
struct Gemm { const bf16_t* A; const bf16_t* Bt; int M, N, K; };

struct StaticOrder {
    int nM, nN, nwg, G, c;
    __host__ __device__ void init(int M, int N, int G_, int c_) { nM = M / BM; nN = N / BM; nwg = nM * nN; G = G_; c = c_; }
    __host__ __device__ bool next(int i, Unit& u) const {
        const long L = (long)i * G + c; if (L >= nwg) return false;
        int wgid = (int)L; { const int q = nwg / NXCD, r = nwg % NXCD, xcd = wgid % NXCD, off = wgid / NXCD; wgid = (xcd < r ? xcd * (q + 1) : r * (q + 1) + (xcd - r) * q) + off; }
        const int nig = WGM * nN, gid = wgid / nig, fm = gid * WGM, gsz = (nM - fm) < WGM ? (nM - fm) : WGM;
        u.pm = fm + ((wgid % nig) % gsz); u.pn = (wgid % nig) / gsz; return true;
    }
    __device__ __forceinline__ void a_ready(const Unit&) const {}
    __device__ __forceinline__ void done(const Unit&) const {}
};

__device__ __forceinline__ unsigned cvt_pk_bf16(float lo, float hi) { unsigned r; asm volatile("v_cvt_pk_bf16_f32 %0, %1, %2" : "=v"(r) : "v"(lo), "v"(hi)); return r; }
typedef float f32x2 __attribute__((ext_vector_type(2)));
constexpr int SEQ_ROWS = 4096;
__device__ __forceinline__ float fast_sigmoid(float x) { return __builtin_amdgcn_rcpf(1.0f + __builtin_amdgcn_exp2f(-1.4426950408889634f * x)); }
struct EpiIn {
    static constexpr bool PERM = true, AFTER_DRAIN = false;
    bf16_t* Z; int ldz; int nq_end, nk_end; const float* gq; const float* gk; float qscale;
    __device__ __forceinline__ void operator()(const f32x4 (&acc)[2][2][4][2], const Unit& u, int wr, int wc, int fr, int fq) const {
        const int c0 = u.pn * BM + 64 * wc;
        const int mode = c0 < nq_end ? 1 : (c0 < nk_end ? 2 : 0);
        const int row0 = u.pm * BM + wr * 64 + fr;
        if (mode != 0) {
            const float* gp = (mode == 1 ? gq : gk) + 8 * fq;
            const float sc = (mode == 1) ? qscale : 1.0f;
            f32x4 gv[2][2];
#pragma unroll
            for (int bj = 0; bj < 2; ++bj)
#pragma unroll
                for (int n = 0; n < 2; ++n) gv[bj][n] = *(const f32x4*)(gp + 32 * bj + 4 * n);
#pragma unroll
            for (int ai = 0; ai < 2; ++ai)
#pragma unroll
                for (int m = 0; m < 4; ++m) {
                    float ss = 0.f;
#pragma unroll
                    for (int bj = 0; bj < 2; ++bj)
#pragma unroll
                        for (int n = 0; n < 2; ++n) { const f32x4 x = acc[ai][bj][m][n]; ss += (x[0] * x[0] + x[1] * x[1]) + (x[2] * x[2] + x[3] * x[3]); }
                    ss += __shfl_xor(ss, 16); ss += __shfl_xor(ss, 32);
                    const float r = sc / sqrtf(ss * (1.0f / 64.0f) + 1e-6f);
                    bf16_t* rowp = Z + (size_t)(row0 + ai * HALF + m * 16) * ldz + c0 + 8 * fq;
#pragma unroll
                    for (int bj = 0; bj < 2; ++bj) { const f32x4 v0 = acc[ai][bj][m][0] * r * gv[bj][0], v1 = acc[ai][bj][m][1] * r * gv[bj][1];
                        u32x4 w; w.x = cvt_pk_bf16(v0[0], v0[1]); w.y = cvt_pk_bf16(v0[2], v0[3]); w.z = cvt_pk_bf16(v1[0], v1[1]); w.w = cvt_pk_bf16(v1[2], v1[3]);
                        *(u32x4*)(rowp + 32 * bj) = w; }
                }
        } else {
#pragma unroll
            for (int ai = 0; ai < 2; ++ai)
#pragma unroll
                for (int m = 0; m < 4; ++m) {
                    bf16_t* rowp = Z + (size_t)(row0 + ai * HALF + m * 16) * ldz + c0 + 8 * fq;
#pragma unroll
                    for (int bj = 0; bj < 2; ++bj) { const f32x4 v0 = acc[ai][bj][m][0], v1 = acc[ai][bj][m][1];
                        u32x4 w; w.x = cvt_pk_bf16(v0[0], v0[1]); w.y = cvt_pk_bf16(v0[2], v0[3]); w.z = cvt_pk_bf16(v1[0], v1[1]); w.w = cvt_pk_bf16(v1[2], v1[3]);
                        *(u32x4*)(rowp + 32 * bj) = w; }
                }
        }
    }
};
struct EpiRes {
    static constexpr bool PERM = true, AFTER_DRAIN = false;
    const float* xin; const bf16_t* xin_bf; float* out; bf16_t* out_bf; const float* gate; int gstride;
    __device__ __forceinline__ void operator()(const f32x4 (&acc)[2][2][4][2], const Unit& u, int wr, int wc, int fr, int fq) const {
        const int b = (u.pm * BM) / SEQ_ROWS;
        const int col0 = u.pn * BM + wc * 32 + 8 * fq;
        const float* gb = gate + (size_t)b * gstride + col0;
        f32x4 gv[2][2];
#pragma unroll
        for (int bj = 0; bj < 2; ++bj)
#pragma unroll
            for (int n = 0; n < 2; ++n) gv[bj][n] = *(const f32x4*)(gb + bj * HALF + 4 * n);
        const int row0 = u.pm * BM + wr * 64 + fr;
#pragma unroll
        for (int ai = 0; ai < 2; ++ai)
#pragma unroll
            for (int m = 0; m < 4; ++m) { const size_t off = (size_t)(row0 + ai * HALF + m * 16) * 1024 + col0;
#pragma unroll
                for (int bj = 0; bj < 2; ++bj) {
                    f32x4 x0, x1;
                    if (xin_bf) { const u32x4 w = *(const u32x4*)(xin_bf + off + bj * HALF);
                        x0 = (f32x4){__builtin_bit_cast(float, w.x << 16), __builtin_bit_cast(float, w.x & 0xffff0000u), __builtin_bit_cast(float, w.y << 16), __builtin_bit_cast(float, w.y & 0xffff0000u)};
                        x1 = (f32x4){__builtin_bit_cast(float, w.z << 16), __builtin_bit_cast(float, w.z & 0xffff0000u), __builtin_bit_cast(float, w.w << 16), __builtin_bit_cast(float, w.w & 0xffff0000u)}; }
                    else { x0 = *(const f32x4*)(xin + off + bj * HALF); x1 = *(const f32x4*)(xin + off + bj * HALF + 4); }
                    const f32x4 v0 = x0 + gv[bj][0] * acc[ai][bj][m][0], v1 = x1 + gv[bj][1] * acc[ai][bj][m][1];
                    if (out_bf) { u32x4 w; w.x = cvt_pk_bf16(v0[0], v0[1]); w.y = cvt_pk_bf16(v0[2], v0[3]); w.z = cvt_pk_bf16(v1[0], v1[1]); w.w = cvt_pk_bf16(v1[2], v1[3]); *(u32x4*)(out_bf + off + bj * HALF) = w; }
                    else { *(f32x4*)(out + off + bj * HALF) = v0; *(f32x4*)(out + off + bj * HALF + 4) = v1; }
                }
                if (m & 1) asm volatile("" ::: "memory"); }
    }
};
struct EpiSwiglu {
    static constexpr bool PERM = true, AFTER_DRAIN = false;
    bf16_t* H; int ldh;
    __device__ __forceinline__ void operator()(const f32x4 (&acc)[2][2][4][2], const Unit& u, int wr, int wc, int fr, int fq) const {
        const int row0 = u.pm * BM + wr * 64 + fr, col0 = u.pn * HALF + wc * 32 + 8 * fq;
#pragma unroll
        for (int ai = 0; ai < 2; ++ai)
#pragma unroll
            for (int m = 0; m < 4; ++m) {
                f32x4 v[2];
#pragma unroll
                for (int n = 0; n < 2; ++n) { const f32x4 a = acc[ai][0][m][n], g = acc[ai][1][m][n];
#pragma unroll
                    for (int i = 0; i < 4; ++i) v[n][i] = a[i] * fast_sigmoid(a[i]) * g[i]; }
                u32x4 w; w.x = cvt_pk_bf16(v[0][0], v[0][1]); w.y = cvt_pk_bf16(v[0][2], v[0][3]); w.z = cvt_pk_bf16(v[1][0], v[1][1]); w.w = cvt_pk_bf16(v[1][2], v[1][3]);
                *(u32x4*)(H + (size_t)(row0 + ai * HALF + m * 16) * ldh + col0) = w;
            }
    }
};
template <class Epi, class Sched, bool ALIGN_EPI = false, bool SP2 = false>
__device__ __forceinline__ void gemm_phase(PG8_LAS unsigned char* lds, const Gemm g, const Sched& S, const Epi& E) {
    int tid = threadIdx.x; asm volatile("" : "+v"(tid));
    const int wid = __builtin_amdgcn_readfirstlane(tid >> 6), lane = tid & 63, wr = wid >> 2, wc = wid & 3, fr = lane & 15, fq = lane >> 4;
    const int K = g.K, nt = K / BK;
    unsigned voffA[2], voffB[2];
#pragma unroll
    for (int i = 0; i < 2; ++i) { int R, C; stage_rc(tid * 16 + i * 8192, R, C); const int Rb = Epi::PERM ? ((R & ~31) + perm32(R & 31)) : R;
        voffA[i] = (unsigned)(R * K + C) * 2u; voffB[i] = (unsigned)(Rb * K + C) * 2u; }
    const size_t kstep = (size_t)(BK * 2);
    const size_t hstep = (size_t)HALF * K * 2;
    const size_t tstep = 2 * hstep;
    const unsigned ldsw = (unsigned)wid * 1024u;
    const int aoff = lds_byte(wr * 64 + fr, fq * 8), boff = lds_byte(wc * 32 + fr, fq * 8);
#define PG8_SA(b, h) (((b) * 2 + (h)) * HTB)
#define PG8_SB(b, h) ((4 + (b) * 2 + (h)) * HTB)
#define PG8_STAGE(bufoff, gbase, voff) do { _Pragma("unroll") for (int _i = 0; _i < 2; ++_i) \
        __builtin_amdgcn_global_load_lds((const unsigned*)((const char*)(gbase) + (voff)[_i]), (PG8_LAS unsigned*)(lds + (bufoff) + ldsw + _i * 8192), 16, 0, 0); } while (0)
#define PG8_LDA(dst, b, h) do { _Pragma("unroll") for (int m = 0; m < 4; ++m) _Pragma("unroll") for (int k = 0; k < 2; ++k) dst[m][k] = *(const PG8_LAS bf16x8*)(lds + PG8_SA(b, h) + aoff + m * 2048 + k * 1024); } while (0)
#define PG8_LDB(dst, b, h) do { _Pragma("unroll") for (int n = 0; n < 2; ++n) _Pragma("unroll") for (int k = 0; k < 2; ++k) dst[n][k] = *(const PG8_LAS bf16x8*)(lds + PG8_SB(b, h) + boff + n * 2048 + k * 1024); } while (0)
#define PG8_MMA(ai, bj, At, Bt) do { __builtin_amdgcn_s_setprio(1); _Pragma("unroll") for (int m = 0; m < 4; ++m) _Pragma("unroll") for (int n = 0; n < 2; ++n) _Pragma("unroll") for (int k = 0; k < 2; ++k) \
        acc[ai][bj][m][n] = __builtin_amdgcn_mfma_f32_16x16x32_bf16(Bt[n][k], At[m][k], acc[ai][bj][m][n], 0, 0, 0); __builtin_amdgcn_s_setprio(0); } while (0)
#define PG8_WAIT_V(n) asm volatile("s_waitcnt vmcnt(" #n ")" ::: "memory")
#define PG8_WAIT_L(n) asm volatile("s_waitcnt lgkmcnt(" #n ")" ::: "memory")
#define PG8_BAR __builtin_amdgcn_s_barrier()
#define PG8_SCHED __builtin_amdgcn_sched_barrier(0)
    Unit cur, nxt; int ui = 0;
    if (!S.next(0, cur)) return;
    f32x4 acc[2][2][4][2];
#pragma unroll
    for (int a = 0; a < 2; ++a)
#pragma unroll
        for (int b = 0; b < 2; ++b)
#pragma unroll
            for (int m = 0; m < 4; ++m)
#pragma unroll
                for (int n = 0; n < 2; ++n) acc[a][b][m][n] = (f32x4){0.f, 0.f, 0.f, 0.f};
    bf16x8 At[4][2], B0[2][2], B1[2][2];
    const char* cA = (const char*)g.A + (size_t)cur.pm * tstep; const char* cB = (const char*)g.Bt + (size_t)cur.pn * tstep;
    S.a_ready(cur);
    if constexpr (SP2) {
        PG8_STAGE(PG8_SB(0, 0), cB, voffB); PG8_STAGE(PG8_SB(0, 1), cB + hstep, voffB); PG8_STAGE(PG8_SA(0, 0), cA, voffA); PG8_STAGE(PG8_SA(0, 1), cA + hstep, voffA);
        if (wr == 1) PG8_BAR;
        PG8_WAIT_V(2); PG8_BAR;
        PG8_STAGE(PG8_SB(1, 0), cB + kstep, voffB); PG8_STAGE(PG8_SA(1, 0), cA + kstep, voffA); PG8_STAGE(PG8_SB(1, 1), cB + hstep + kstep, voffB);
        PG8_WAIT_V(6); PG8_BAR;
    } else {
        PG8_STAGE(PG8_SB(0, 0), cB, voffB); PG8_STAGE(PG8_SA(0, 0), cA, voffA); PG8_STAGE(PG8_SB(0, 1), cB + hstep, voffB); PG8_STAGE(PG8_SA(0, 1), cA + hstep, voffA);
        if (wr == 1) PG8_BAR;
        PG8_WAIT_V(4); PG8_BAR;
        PG8_STAGE(PG8_SB(1, 0), cB + kstep, voffB); PG8_STAGE(PG8_SA(1, 0), cA + kstep, voffA); PG8_STAGE(PG8_SB(1, 1), cB + hstep + kstep, voffB);
        PG8_WAIT_V(6); PG8_BAR;
    }
    for (;;) {
        const bool has_next = S.next(ui + 1, nxt);
        const char* nA = has_next ? (const char*)g.A + (size_t)nxt.pm * tstep : cA; const char* nB = has_next ? (const char*)g.Bt + (size_t)nxt.pn * tstep : cB;
        for (int t = 0; t < nt; t += 2) {
            const bool last = (t == nt - 2);
            const char* a1 = cA + (size_t)(t + 1) * kstep;
            const char* a2 = last ? nA : cA + (size_t)(t + 2) * kstep; const char* b2 = last ? nB : cB + (size_t)(t + 2) * kstep;
            const char* a3 = a2 + kstep; const char* b3 = b2 + kstep;
            if (last && has_next) S.a_ready(nxt);
            if constexpr (SP2) {
            PG8_LDB(B0, 0, 0); PG8_LDB(B1, 0, 1); PG8_SCHED; PG8_LDA(At, 0, 0); PG8_STAGE(PG8_SA(1, 1), a1 + hstep, voffA);
            PG8_WAIT_V(8); PG8_WAIT_L(0); PG8_BAR; PG8_MMA(0, 0, At, B0); PG8_MMA(0, 1, At, B1); PG8_BAR; PG8_SCHED;
            PG8_LDA(At, 0, 1); PG8_STAGE(PG8_SB(0, 0), b2, voffB); PG8_STAGE(PG8_SB(0, 1), b2 + hstep, voffB); PG8_STAGE(PG8_SA(0, 0), a2, voffA);
            PG8_WAIT_V(8); PG8_WAIT_L(0); PG8_BAR; PG8_MMA(1, 0, At, B0); PG8_MMA(1, 1, At, B1); PG8_BAR; PG8_SCHED;
            PG8_LDB(B0, 1, 0); PG8_LDB(B1, 1, 1); PG8_SCHED; PG8_LDA(At, 1, 0); PG8_STAGE(PG8_SA(0, 1), a2 + hstep, voffA);
            PG8_WAIT_V(8); PG8_WAIT_L(0); PG8_BAR; PG8_MMA(0, 0, At, B0); PG8_MMA(0, 1, At, B1); PG8_BAR; PG8_SCHED;
            PG8_LDA(At, 1, 1); PG8_STAGE(PG8_SB(1, 0), b3, voffB); PG8_STAGE(PG8_SB(1, 1), b3 + hstep, voffB); PG8_STAGE(PG8_SA(1, 0), a3, voffA);
            PG8_WAIT_V(8); PG8_WAIT_L(0); PG8_BAR; PG8_MMA(1, 0, At, B0); PG8_MMA(1, 1, At, B1); PG8_BAR; PG8_SCHED;
            } else {
            PG8_LDB(B0, 0, 0); PG8_SCHED; PG8_LDA(At, 0, 0); PG8_STAGE(PG8_SA(1, 1), a1 + hstep, voffA);
            PG8_WAIT_L(8); PG8_BAR; PG8_WAIT_L(0); PG8_MMA(0, 0, At, B0); PG8_BAR; PG8_SCHED;
            PG8_LDB(B1, 0, 1); PG8_STAGE(PG8_SB(0, 0), b2, voffB);
            PG8_BAR; PG8_WAIT_L(0); PG8_MMA(0, 1, At, B1); PG8_BAR;
            PG8_LDA(At, 0, 1); PG8_STAGE(PG8_SA(0, 0), a2, voffA);
            PG8_BAR; PG8_WAIT_L(0); PG8_MMA(1, 0, At, B0); PG8_BAR; PG8_SCHED;
            PG8_STAGE(PG8_SB(0, 1), b2 + hstep, voffB);
            PG8_WAIT_V(6); PG8_BAR; PG8_MMA(1, 1, At, B1); PG8_BAR;
            PG8_LDB(B0, 1, 0); PG8_SCHED; PG8_LDA(At, 1, 0); PG8_STAGE(PG8_SA(0, 1), a2 + hstep, voffA);
            PG8_WAIT_L(8); PG8_BAR; PG8_WAIT_L(0); PG8_MMA(0, 0, At, B0); PG8_BAR; PG8_SCHED;
            PG8_LDB(B1, 1, 1); PG8_STAGE(PG8_SB(1, 0), b3, voffB);
            PG8_BAR; PG8_WAIT_L(0); PG8_MMA(0, 1, At, B1); PG8_BAR;
            PG8_LDA(At, 1, 1); PG8_STAGE(PG8_SA(1, 0), a3, voffA);
            PG8_BAR; PG8_WAIT_L(0); PG8_MMA(1, 0, At, B0); PG8_BAR; PG8_SCHED;
            PG8_STAGE(PG8_SB(1, 1), b3 + hstep, voffB);
            PG8_WAIT_V(6); PG8_BAR; PG8_MMA(1, 1, At, B1); PG8_BAR;
            }
        }
        if constexpr (ALIGN_EPI) { if (wr == 0) PG8_BAR; }
        if constexpr (!Epi::AFTER_DRAIN) { E(acc, cur, wr, wc, fr, fq); S.done(cur); }
        if (!has_next) break;
#pragma unroll
        for (int a = 0; a < 2; ++a)
#pragma unroll
            for (int b = 0; b < 2; ++b)
#pragma unroll
                for (int m = 0; m < 4; ++m)
#pragma unroll
                    for (int n = 0; n < 2; ++n) acc[a][b][m][n] = (f32x4){0.f, 0.f, 0.f, 0.f};
        cur = nxt; cA = nA; cB = nB; ++ui;
        if constexpr (ALIGN_EPI) { if (wr == 1) PG8_BAR; }
    }
    PG8_WAIT_V(0);
    if constexpr (!ALIGN_EPI) { if (wr == 0) PG8_BAR; }
    PG8_BAR;
    if constexpr (Epi::AFTER_DRAIN) { E.fused(acc, cur, wr, wc, fr, fq, lds, wid, lane); S.done(cur); }
#undef PG8_SA
#undef PG8_SB
#undef PG8_STAGE
#undef PG8_LDA
#undef PG8_LDB
#undef PG8_MMA
#undef PG8_WAIT_V
#undef PG8_WAIT_L
#undef PG8_BAR
#undef PG8_SCHED
}
}
#include <type_traits>
constexpr int NWAVES = 8, NTHREADS = NWAVES * 64;
constexpr int D = 1024, BATCH = 8, SEQ = 4096, DEPTH = 4, M = BATCH * SEQ;
constexpr int FFH = 2816, NUP = 2 * FFH;
constexpr int AB_LD = 3592, AB_N = 3584;
constexpr int FX_LD = 3088, FX_N = 3072;
constexpr int MODW = 6 * D;
constexpr float EPS = 1e-6f, LOG2E = 1.4426950408889634f;
static_assert(pg8::SEQ_ROWS == SEQ, "row -> batch");

constexpr size_t MiB = 1u << 20;
constexpr size_t WS_CTL = 0, CTL_ZERO_BYTES = 1 * MiB;
constexpr size_t WS_MOD = 1 * MiB;
constexpr size_t WS_GATE = 2 * MiB;
constexpr size_t WS_WIN_E = 4 * MiB;
constexpr size_t WS_WIN_O = 18 * MiB;
constexpr size_t WS_WOUT = 30 * MiB;
constexpr size_t WS_WUP = 38 * MiB;
constexpr size_t WS_WDN = 82 * MiB;
constexpr size_t WS_A1 = 104 * MiB;
constexpr size_t WS_Z = 168 * MiB;
constexpr size_t WS_XB2 = 344 * MiB;
constexpr size_t WS_QKC = 392 * MiB;
constexpr size_t WS_END = 456 * MiB;
constexpr int CW_BAR = 4096;
constexpr int CW_QUEUE = 16384;

constexpr int RING_OFF = 0, RING_BYTES = 131072;
constexpr int LDSCTL_OFF = RING_BYTES, MISC_OFF = LDSCTL_OFF + 320;
constexpr int LDS_BYTES = 147456;

#define GAS __attribute__((address_space(1)))
#define LAS __attribute__((address_space(3)))
typedef unsigned short bf16;
typedef unsigned v4u __attribute__((ext_vector_type(4)));
typedef float f32x4 __attribute__((ext_vector_type(4)));
typedef short bf16x8 __attribute__((ext_vector_type(8)));
typedef GAS unsigned gu32;
typedef GAS unsigned long long gu64;
#define RLX_AGENT __ATOMIC_RELAXED, __HIP_MEMORY_SCOPE_AGENT
#define LDS_WAIT() asm volatile("s_waitcnt lgkmcnt(0)" ::: "memory")
#define VM_WAIT() asm volatile("s_waitcnt vmcnt(0)" ::: "memory")
__device__ __forceinline__ unsigned long long rt() { return __builtin_amdgcn_s_memrealtime(); }
__device__ __forceinline__ unsigned f2bf(float f) { unsigned u = __builtin_bit_cast(unsigned, f); return (u + 0x7fffu + ((u >> 16) & 1u)) >> 16; }
__device__ __forceinline__ unsigned pk2(float lo, float hi) { return f2bf(lo) | (f2bf(hi) << 16); }

#define XB_TMO      128
#define XB_XCNT(j)  (256  + 64 * (j))
#define XB_XSUB(j)  (1280 + 64 * (j))
#define XB_XGEN(j)  (2304 + 64 * (j))
#define XB_TOP      3328
#define XB_TOPGEN   3392
#define XCD_BAR_WORDS 3456
#define XB_SPIN_CAP (1u << 24)

__device__ __forceinline__ unsigned xb_ld(unsigned* p)              { return __hip_atomic_load(p, __ATOMIC_RELAXED, __HIP_MEMORY_SCOPE_AGENT); }
__device__ __forceinline__ unsigned xb_add(unsigned* p, unsigned v) { return __hip_atomic_fetch_add(p, v, __ATOMIC_RELAXED, __HIP_MEMORY_SCOPE_AGENT); }
__device__ __forceinline__ unsigned xb_xcc_id() { return (unsigned)__builtin_amdgcn_s_getreg((3 << 11) | 20) & 0xFu; }
#define XB_SPIN(cond, bar) do { unsigned _sp = 0; while (cond) { __builtin_amdgcn_s_sleep(1); \
    if ((++_sp & 255u) == 0u) { if (xb_ld(&(bar)[XB_TMO])) break; if (_sp > XB_SPIN_CAP) { atomicAdd(&(bar)[XB_TMO], 1u); break; } } } } while (0)

struct XcdBarrier {
    unsigned* bar; unsigned x;
    volatile LAS unsigned* st;
};

__device__ __forceinline__ XcdBarrier xcd_barrier_post(unsigned* bar, volatile LAS unsigned* st) {
    XcdBarrier b; b.bar = bar; b.x = xb_xcc_id(); b.st = st;
    if (threadIdx.x == 0) (void)xb_add(&bar[XB_XCNT(b.x)], 1u);
    return b;
}
__device__ __forceinline__ void xcd_barrier_complete(unsigned* bar, unsigned x, unsigned& nloc, unsigned& nx) {
    const unsigned G = gridDim.x * gridDim.y * gridDim.z;
    unsigned sum, cnt, mine, sp = 0u;
    for (;;) {
        sum = 0u; cnt = 0u; mine = 0u;
#pragma unroll
        for (unsigned j = 0; j < 16; ++j) { const unsigned c = xb_ld(&bar[XB_XCNT(j)]); sum += c; cnt += (c > 0u) ? 1u : 0u; mine = (j == x) ? c : mine; }
        if (sum == G) break;
        __builtin_amdgcn_s_sleep(1);
        if ((++sp & 255u) == 0u) { if (xb_ld(&bar[XB_TMO])) break; if (sp > XB_SPIN_CAP) { atomicAdd(&bar[XB_TMO], 1u); break; } }
    }
    nloc = mine > 0u ? mine : 1u; nx = cnt > 0u ? cnt : 1u;
}

__device__ __forceinline__ void xcd_barrier(const XcdBarrier& b) {
    asm volatile("s_waitcnt vmcnt(0)" ::: "memory");
    __syncthreads();
    if (threadIdx.x == 0) {
        unsigned* bar = b.bar;
        __builtin_amdgcn_s_waitcnt(0);
        unsigned nloc = b.st[0], nx = b.st[1];
        if (nloc == 0u) { xcd_barrier_complete(bar, b.x, nloc, nx); b.st[0] = nloc; b.st[1] = nx; }
        const unsigned old = xb_add(&bar[XB_XSUB(b.x)], 1u);
        const unsigned gen = old / nloc;
        if (old + 1u == (gen + 1u) * nloc) {
            __builtin_amdgcn_fence(__ATOMIC_RELEASE, "agent");
            asm volatile("s_waitcnt vmcnt(0)" ::: "memory");
            const unsigned og = xb_add(&bar[XB_TOP], 1u);
            const unsigned tg = og / nx;
            if (og + 1u == (tg + 1u) * nx) xb_add(&bar[XB_TOPGEN], 1u);
            else XB_SPIN(xb_ld(&bar[XB_TOPGEN]) == tg, bar);
            __builtin_amdgcn_fence(__ATOMIC_ACQUIRE, "agent");
            xb_add(&bar[XB_XGEN(b.x)], 1u);
            asm volatile("s_waitcnt vmcnt(0)" ::: "memory");
        } else {
            XB_SPIN(xb_ld(&bar[XB_XGEN(b.x)]) == gen, bar);
            __builtin_amdgcn_fence(__ATOMIC_ACQUIRE, "agent");
            asm volatile("s_waitcnt vmcnt(0)" ::: "memory");
        }
    }
    __syncthreads();
}

__device__ __forceinline__ float bf_lo(unsigned u) { return __builtin_bit_cast(float, u << 16); }
__device__ __forceinline__ float bf_hi(unsigned u) { return __builtin_bit_cast(float, u & 0xffff0000u); }
__device__ __forceinline__ float bf1(bf16 u) { return __builtin_bit_cast(float, (unsigned)u << 16); }
__device__ __forceinline__ float ex2(float x) { return __builtin_amdgcn_exp2f(x); }
__device__ __forceinline__ float wave_sum(float v) {
#pragma unroll
    for (int o = 1; o < 64; o <<= 1) v += __shfl_xor(v, o);
    return v;
}
__device__ __forceinline__ float fast_sig(float x) { return __builtin_amdgcn_rcpf(1.0f + __builtin_amdgcn_exp2f(-1.4426950408889634f * x)); }
__device__ __forceinline__ float log_sigmoid(float x) { return fminf(x, 0.f) - log1pf(__expf(-fabsf(x))); }

struct Args { const float* in[24]; float* out; unsigned char* ws; int ph_lo, ph_hi; };

typedef short s16x4 __attribute__((ext_vector_type(4)));
__device__ __forceinline__ s16x4 ds_tr16(unsigned addr) { return __builtin_bit_cast(s16x4, __builtin_amdgcn_ds_read_tr16_b64_v4i16((LAS s16x4*)(uintptr_t)addr)); }
typedef float f32x2_t __attribute__((ext_vector_type(2))); typedef __bf16 bf16x2_t __attribute__((ext_vector_type(2)));
__device__ __forceinline__ unsigned cvtpk(float lo, float hi) { const f32x2_t v = {lo, hi}; return __builtin_bit_cast(unsigned, __builtin_convertvector(v, bf16x2_t)); }

constexpr int CV_TS = 528;
__device__ __forceinline__ int cv_dst_row(int map, int n) {
    if (map == 1) { const int q = (n >> 5) & 7; return (n & ~255) + ((q & 1) * 4 + (q >> 1)) * 32 + (n & 31); }
    if (map >= 2) return (n >> 7) * 256 + (map - 2) * 128 + (n & 127);
    return n; }
struct CvTile { const float* W; bf16* WT; int ld, Kd, k0, n0, map; };
__device__ __forceinline__ CvTile cv_decode(const Args& a, unsigned char* ws, int t) {
    constexpr int T_E = 16 * (AB_N / 256), T_O = 16 * (FX_N / 256), T_OUT = 16 * 4, T_UP = 16 * (FFH / 256), T_DN = (FFH / 64) * 4;
    CvTile c;
    if (t < 2 * T_E) { const int j = t / T_E, r = t % T_E, nb = AB_N / 256; c = {a.in[6] + (size_t)j * D * AB_LD, (bf16*)(ws + WS_WIN_E) + (size_t)j * AB_N * D, AB_LD, D, 64 * (r / nb), 256 * (r % nb), 1}; return c; }
    t -= 2 * T_E;
    if (t < 2 * T_O) { const int j = t / T_O, r = t % T_O, nb = FX_N / 256; c = {a.in[16] + (size_t)j * D * FX_LD, (bf16*)(ws + WS_WIN_O) + (size_t)j * FX_N * D, FX_LD, D, 64 * (r / nb), 256 * (r % nb), 1}; return c; }
    t -= 2 * T_O;
    if (t < 4 * T_OUT) { const int l = t / T_OUT, r = t % T_OUT; c = {((l & 1) ? a.in[20] : a.in[15]) + (size_t)(l >> 1) * D * D, (bf16*)(ws + WS_WOUT) + (size_t)l * D * D, D, D, 64 * (r / 4), 256 * (r % 4), 0}; return c; }
    t -= 4 * T_OUT;
    if (t < 8 * T_UP) { const int lw = t / T_UP, r = t % T_UP, l = lw >> 1, w3 = lw & 1, nb = FFH / 256; c = {(w3 ? a.in[22] : a.in[21]) + (size_t)l * D * FFH, (bf16*)(ws + WS_WUP) + (size_t)l * NUP * D, FFH, D, 64 * (r / nb), 256 * (r % nb), 2 + w3}; return c; }
    t -= 8 * T_UP;
    { const int l = t / T_DN, r = t % T_DN; c = {a.in[23] + (size_t)l * FFH * D, (bf16*)(ws + WS_WDN) + (size_t)l * D * FFH, D, FFH, 64 * (r / 4), 256 * (r % 4), 0}; return c; }
}
constexpr int CV_TILES = 2 * 16 * (AB_N / 256) + 2 * 16 * (FX_N / 256) + 4 * 64 + 8 * 16 * (FFH / 256) + 4 * (FFH / 64) * 4;

__device__ __forceinline__ void phase_prologue(const Args& a, LAS unsigned char* lds, int tid, int lane, int wave, int G) {
    unsigned char* ws = a.ws;
    {
        const unsigned lds0 = (unsigned)(uintptr_t)lds;
        const int lr = tid >> 6, lc = tid & 63;
        const int c15 = lane & 15, kq = lane >> 4;
        f32x4 v[8];
        int t = blockIdx.x;
        CvTile cur = cv_decode(a, ws, t < CV_TILES ? t : 0);
        if (t < CV_TILES) {
#pragma unroll
            for (int i = 0; i < 8; ++i) v[i] = *(const f32x4*)(cur.W + (size_t)(cur.k0 + lr + 8 * i) * cur.ld + cur.n0 + 4 * lc); }
        for (; t < CV_TILES; t += G) {
#pragma unroll
            for (int i = 0; i < 8; ++i) *(LAS unsigned long long*)(uintptr_t)(lds0 + (lr + 8 * i) * CV_TS + 8 * lc) = (unsigned long long)cvtpk(v[i].x, v[i].y) | ((unsigned long long)cvtpk(v[i].z, v[i].w) << 32);
            const CvTile nxt = cv_decode(a, ws, t + G < CV_TILES ? t + G : 0);
            if (t + G < CV_TILES) {
#pragma unroll
                for (int i = 0; i < 8; ++i) v[i] = *(const f32x4*)(nxt.W + (size_t)(nxt.k0 + lr + 8 * i) * nxt.ld + nxt.n0 + 4 * lc); }
            __syncthreads();
#pragma unroll
            for (int j = 0; j < 2; ++j) { const int nb = 2 * wave + j, n = cur.n0 + 16 * nb + c15;
                bf16* drow = cur.WT + (size_t)cv_dst_row(cur.map, n) * cur.Kd + cur.k0 + 8 * kq;
#pragma unroll
                for (int ks = 0; ks < 2; ++ks) { const unsigned ad = lds0 + (32 * ks + 8 * kq + ((lane & 15) >> 2)) * CV_TS + (16 * nb + 4 * (lane & 3)) * 2;
                    const s16x4 lo = ds_tr16(ad), hh = ds_tr16(ad + 4 * CV_TS);
                    v4u w; w.x = (unsigned)(unsigned short)lo[0] | ((unsigned)(unsigned short)lo[1] << 16); w.y = (unsigned)(unsigned short)lo[2] | ((unsigned)(unsigned short)lo[3] << 16);
                    w.z = (unsigned)(unsigned short)hh[0] | ((unsigned)(unsigned short)hh[1] << 16); w.w = (unsigned)(unsigned short)hh[2] | ((unsigned)(unsigned short)hh[3] << 16);
                    *(GAS v4u*)(drow + 32 * ks) = w; } }
            __syncthreads();
            cur = nxt;
        }
    }
    __syncthreads();
    {
        LAS float* cact = (LAS float*)lds;
        LAS float* red = (LAS float*)(lds + 32768);
        const float* c = a.in[1];
        for (int i = tid; i < BATCH * D; i += NTHREADS) { const float v = c[i]; cact[i] = v / (1.0f + __expf(-v)); }
        __syncthreads();
        float* mod = (float*)(ws + WS_MOD);
        for (int it = blockIdx.x; it < DEPTH * (MODW / 64); it += G) {
            const int l = it / (MODW / 64), cg = it % (MODW / 64);
            const float* wp = a.in[2] + ((size_t)l * D + 128 * wave) * MODW + 64 * cg + lane;
            float acc[BATCH];
#pragma unroll
            for (int b = 0; b < BATCH; ++b) acc[b] = 0.f;
#pragma unroll 8
            for (int kk = 0; kk < 128; ++kk) { const float wv = wp[(size_t)kk * MODW];
#pragma unroll
                for (int b = 0; b < BATCH; ++b) acc[b] += cact[b * D + 128 * wave + kk] * wv; }
#pragma unroll
            for (int b = 0; b < BATCH; ++b) red[(wave * BATCH + b) * 64 + lane] = acc[b];
            __syncthreads();
            { const int b = tid >> 6; float s = 0.f;
#pragma unroll
                for (int w = 0; w < NWAVES; ++w) s += red[(w * BATCH + b) * 64 + lane];
                mod[((size_t)l * BATCH + b) * MODW + 64 * cg + lane] = s + a.in[3][(size_t)l * MODW + 64 * cg + lane]; }
            __syncthreads();
        }
    }
}

template <int NG, bool XBF>
__device__ __forceinline__ void phase_norm(const void* xin_v, const float* gain, const float* shift, const float* scale  , bf16* hout,
                                           const float* Wg, int ldw, int gcol0, const float* bias_a, const float* bias_b, float* gate_out,
                                           LAS unsigned char* lds, int tid, int lane, int wave, int G) {
    LAS float* wgt = (LAS float*)lds;
    if constexpr (NG > 0) {
        for (int i = tid; i < NG * D; i += NTHREADS) { const int k = i / NG, g = i % NG; wgt[g * D + k] = Wg[(size_t)k * ldw + gcol0 + g]; }
        __syncthreads();
    }
    const int gw = blockIdx.x * NWAVES + wave, NGW = G * NWAVES;
    for (int item = gw; item < M / 16; item += NGW) {
        const int row0 = item * 16, b = row0 / SEQ;
        f32x4 A[4], S[4];
#pragma unroll
        for (int j = 0; j < 4; ++j) { const int c = 4 * lane + 256 * j;
            const f32x4 g4 = *(const f32x4*)(gain + c), sc4 = *(const f32x4*)(scale + (size_t)b * MODW + c);
            A[j] = g4 * (sc4 + 1.0f); S[j] = *(const f32x4*)(shift + (size_t)b * MODW + c); }
        for (int r = 0; r < 16; ++r) {
            asm volatile("" ::: "memory");
            const int row = row0 + r;
            f32x4 v[4]; float ss = 0.f;
            if constexpr (XBF) { const GAS unsigned long long* xr = (const GAS unsigned long long*)((const bf16*)xin_v + (size_t)row * D) + lane;
#pragma unroll
                for (int j = 0; j < 4; ++j) { const unsigned long long w = xr[64 * j]; const unsigned lo = (unsigned)w, hh = (unsigned)(w >> 32); v[j] = (f32x4){bf_lo(lo), bf_hi(lo), bf_lo(hh), bf_hi(hh)}; } }
            else { const GAS f32x4* xr = (const GAS f32x4*)((const float*)xin_v + (size_t)row * D) + lane;
#pragma unroll
                for (int j = 0; j < 4; ++j) v[j] = xr[64 * j]; }
#pragma unroll
            for (int j = 0; j < 4; ++j) ss += (v[j].x * v[j].x + v[j].y * v[j].y) + (v[j].z * v[j].z + v[j].w * v[j].w);
            const float rinv = 1.0f / sqrtf(wave_sum(ss) * (1.0f / D) + EPS);
#pragma unroll
            for (int j = 0; j < 4; ++j) v[j] = v[j] * rinv * A[j] + S[j];
            GAS unsigned long long* o8 = (GAS unsigned long long*)(hout + (size_t)row * D) + lane;
#pragma unroll
            for (int j = 0; j < 4; ++j) o8[64 * j] = (unsigned long long)pk2(v[j].x, v[j].y) | ((unsigned long long)pk2(v[j].z, v[j].w) << 32);
            if constexpr (NG > 0) {
                float p[NG];
#pragma unroll
                for (int g = 0; g < NG; ++g) { float s = 0.f;
#pragma unroll
                    for (int j = 0; j < 4; ++j) { const f32x4 w4 = *(const LAS f32x4*)(wgt + g * D + 4 * lane + 256 * j); s += (v[j].x * w4.x + v[j].y * w4.y) + (v[j].z * w4.z + v[j].w * w4.w); }
                    p[g] = s; }
#define HALVE(NV, OFF) do { const bool up = (lane & (OFF)) != 0; _Pragma("unroll") for (int i = 0; i < (NV); ++i) { const float keep = up ? p[i + (NV)] : p[i], send = up ? p[i] : p[i + (NV)]; p[i] = keep + __shfl_xor(send, (OFF)); } } while (0)
                if constexpr (NG == 16) { HALVE(8, 32); HALVE(4, 16); HALVE(2, 8); HALVE(1, 4); } else { HALVE(4, 32); HALVE(2, 16); HALVE(1, 8); }
#undef HALVE
                float val = p[0];
                constexpr int REM = (NG == 16) ? 2 : 4;
#pragma unroll
                for (int off = REM; off >= 1; off >>= 1) val += __shfl_xor(val, off);
                const int t = row % SEQ;
                if constexpr (NG == 16) { if ((lane & 3) == 0) { const int g = lane >> 2; gate_out[((size_t)b * 16 + g) * SEQ + t] = log_sigmoid(val + bias_b[g]); } }
                else { if ((lane & 7) == 0) { const int g = lane >> 3;
                        if (g < 4) gate_out[((size_t)b * 4 + g) * SEQ + t] = val + bias_a[g];
                        else gate_out[(size_t)BATCH * 4 * SEQ + ((size_t)b * 4 + (g - 4)) * SEQ + t] = log_sigmoid(val + bias_b[g - 4]); } }
            }
        }
    }
}

__device__ __forceinline__ int queue_next(gu32* head, volatile LAS unsigned* MISC, int tid) {
    __syncthreads();
    if (tid == 0) MISC[0] = __hip_atomic_fetch_add(head, 1u, RLX_AGENT);
    __syncthreads();
    return (int)MISC[0];
}

__device__ __forceinline__ void fox_naive_unit(int b, int h, int qb, const bf16* z, const float* lf, bf16* y, LAS unsigned char* lds, int tid, int lane, int wave) {
    LAS float* F = (LAS float*)lds;
    if (wave == 0) { const int seg = 8 * (qb + 1); const float* p = lf + ((size_t)b * 16 + h) * SEQ + lane * seg; float s = 0.f;
        for (int i = 0; i < seg; ++i) s += p[i];
        float inc = s;
#pragma unroll
        for (int off = 1; off < 64; off <<= 1) { const float t = __shfl_up(inc, off); if (lane >= off) inc += t; }
        float run = inc - s;
        for (int i = 0; i < seg; ++i) { run += p[i]; F[lane * seg + i] = run * LOG2E; } }
    __syncthreads();
    const int t = qb * 512 + tid; const size_t rowbase = (size_t)b * SEQ;
    float q[64];
    { const v4u* qp = (const v4u*)(z + (rowbase + t) * FX_N + h * 64);
#pragma unroll
        for (int c = 0; c < 8; ++c) { const v4u u = qp[c]; q[8 * c] = bf_lo(u.x); q[8 * c + 1] = bf_hi(u.x); q[8 * c + 2] = bf_lo(u.y); q[8 * c + 3] = bf_hi(u.y); q[8 * c + 4] = bf_lo(u.z); q[8 * c + 5] = bf_hi(u.z); q[8 * c + 6] = bf_lo(u.w); q[8 * c + 7] = bf_hi(u.w); } }
    float o[64];
#pragma unroll
    for (int d = 0; d < 64; ++d) o[d] = 0.f;
    float m = -INFINITY, l = 0.f; const float Ft = F[t];
    const int smax = qb * 512 + wave * 64 + 63;
    for (int s = 0; s <= smax; ++s) {
        const v4u* kp = (const v4u*)(z + (rowbase + s) * FX_N + 1024 + h * 64);
        float dot = 0.f;
#pragma unroll
        for (int c = 0; c < 8; ++c) { const v4u u = kp[c];
            dot += q[8 * c] * bf_lo(u.x) + q[8 * c + 1] * bf_hi(u.x) + q[8 * c + 2] * bf_lo(u.y) + q[8 * c + 3] * bf_hi(u.y) + q[8 * c + 4] * bf_lo(u.z) + q[8 * c + 5] * bf_hi(u.z) + q[8 * c + 6] * bf_lo(u.w) + q[8 * c + 7] * bf_hi(u.w); }
        float lg = dot + (Ft - F[s]);
        lg = (s <= t) ? lg : -INFINITY;
        const float mn = fmaxf(m, lg), alpha = ex2(m - mn), p = ex2(lg - mn);
        l = l * alpha + p; m = mn;
        const v4u* vp = (const v4u*)(z + (rowbase + s) * FX_N + 2048 + h * 64);
#pragma unroll
        for (int c = 0; c < 8; ++c) { const v4u u = vp[c];
            o[8 * c] = o[8 * c] * alpha + p * bf_lo(u.x); o[8 * c + 1] = o[8 * c + 1] * alpha + p * bf_hi(u.x); o[8 * c + 2] = o[8 * c + 2] * alpha + p * bf_lo(u.y); o[8 * c + 3] = o[8 * c + 3] * alpha + p * bf_hi(u.y);
            o[8 * c + 4] = o[8 * c + 4] * alpha + p * bf_lo(u.z); o[8 * c + 5] = o[8 * c + 5] * alpha + p * bf_hi(u.z); o[8 * c + 6] = o[8 * c + 6] * alpha + p * bf_lo(u.w); o[8 * c + 7] = o[8 * c + 7] * alpha + p * bf_hi(u.w); }
    }
    const float il = 1.0f / l;
    v4u* yp = (v4u*)(y + (rowbase + t) * D + h * 64);
#pragma unroll
    for (int c = 0; c < 8; ++c) { v4u w; w.x = pk2(o[8 * c] * il, o[8 * c + 1] * il); w.y = pk2(o[8 * c + 2] * il, o[8 * c + 3] * il); w.z = pk2(o[8 * c + 4] * il, o[8 * c + 5] * il); w.w = pk2(o[8 * c + 6] * il, o[8 * c + 7] * il); yp[c] = w; }
}

__device__ __forceinline__ void da_naive_unit(int b, int h, int qb, const bf16* z, bf16* y, const float* lam_p, const float* subln_g, int layer, int lane, int wave) {
    const int r = lane & 15, mm = (lane >> 4) & 1, vh = lane >> 5;
    const int t = qb * 128 + wave * 16 + r; const size_t rowbase = (size_t)b * SEQ;
    const float lambda_init = 0.8f - 0.6f * expf(-0.3f * (float)layer);
    float lam;
    { float s0 = 0.f, s1 = 0.f; for (int d = 0; d < 64; ++d) { s0 += lam_p[d] * lam_p[64 + d]; s1 += lam_p[128 + d] * lam_p[192 + d]; } lam = expf(s0) - expf(s1) + lambda_init; }
    const float slope2 = exp2f(-2.0f * (float)(h + 1)) * LOG2E;
    float q[64];
    { const v4u* qp = (const v4u*)(z + (rowbase + t) * AB_N + h * 128 + mm * 64);
#pragma unroll
        for (int c = 0; c < 8; ++c) { const v4u u = qp[c]; q[8 * c] = bf_lo(u.x); q[8 * c + 1] = bf_hi(u.x); q[8 * c + 2] = bf_lo(u.y); q[8 * c + 3] = bf_hi(u.y); q[8 * c + 4] = bf_lo(u.z); q[8 * c + 5] = bf_hi(u.z); q[8 * c + 6] = bf_lo(u.w); q[8 * c + 7] = bf_hi(u.w); } }
    float o[64];
#pragma unroll
    for (int d = 0; d < 64; ++d) o[d] = 0.f;
    float m = -INFINITY, l = 0.f;
    const int smax = (qb * 128 + wave * 16) / 64 * 64 + 63;
    for (int s = 0; s <= smax; ++s) {
        const v4u* kp = (const v4u*)(z + (rowbase + s) * AB_N + 512 + h * 128 + mm * 64);
        float dot = 0.f;
#pragma unroll
        for (int c = 0; c < 8; ++c) { const v4u u = kp[c];
            dot += q[8 * c] * bf_lo(u.x) + q[8 * c + 1] * bf_hi(u.x) + q[8 * c + 2] * bf_lo(u.y) + q[8 * c + 3] * bf_hi(u.y) + q[8 * c + 4] * bf_lo(u.z) + q[8 * c + 5] * bf_hi(u.z) + q[8 * c + 6] * bf_lo(u.w) + q[8 * c + 7] * bf_hi(u.w); }
        const float lg = dot - slope2 * fabsf((float)(t - s));
        const float mn = fmaxf(m, lg), alpha = ex2(m - mn), p = ex2(lg - mn);
        l = l * alpha + p; m = mn;
        const v4u* vp = (const v4u*)(z + (rowbase + s) * AB_N + 1024 + h * 128 + vh * 64);
#pragma unroll
        for (int c = 0; c < 8; ++c) { const v4u u = vp[c];
            o[8 * c] = o[8 * c] * alpha + p * bf_lo(u.x); o[8 * c + 1] = o[8 * c + 1] * alpha + p * bf_hi(u.x); o[8 * c + 2] = o[8 * c + 2] * alpha + p * bf_lo(u.y); o[8 * c + 3] = o[8 * c + 3] * alpha + p * bf_hi(u.y);
            o[8 * c + 4] = o[8 * c + 4] * alpha + p * bf_lo(u.z); o[8 * c + 5] = o[8 * c + 5] * alpha + p * bf_hi(u.z); o[8 * c + 6] = o[8 * c + 6] * alpha + p * bf_lo(u.w); o[8 * c + 7] = o[8 * c + 7] * alpha + p * bf_hi(u.w); }
    }
    const float il = 1.0f / l; float ss = 0.f;
#pragma unroll
    for (int d = 0; d < 64; ++d) { const float mine = o[d] * il, other = __shfl_xor(mine, 16); o[d] = mine - lam * other; ss += o[d] * o[d]; }
    ss += __shfl_xor(ss, 32);
    const float rn = (1.0f - lambda_init) / sqrtf(ss * (1.0f / 128.0f) + EPS);
    if (mm == 0) {
        v4u* yp = (v4u*)(y + (rowbase + t) * D + h * 128 + vh * 64);
#pragma unroll
        for (int c = 0; c < 8; ++c) { float e[8];
#pragma unroll
            for (int i = 0; i < 8; ++i) e[i] = o[8 * c + i] * rn * subln_g[vh * 64 + 8 * c + i];
            v4u w; w.x = pk2(e[0], e[1]); w.y = pk2(e[2], e[3]); w.z = pk2(e[4], e[5]); w.w = pk2(e[6], e[7]); yp[c] = w; }
    }
}

__device__ __forceinline__ void mlstm_naive_unit(int b, int h, const bf16* z, const float* gates, const float* conv_w, const float* conv_b, bf16* y, LAS unsigned char* lds, int tid) {
    LAS float* qs = (LAS float*)lds;
    LAS float* ks = (LAS float*)(lds + 32768);
    LAS float* pn = (LAS float*)(lds + 65536);
    LAS float* pd = (LAS float*)(lds + 65536 + 4096);
    const int dv = tid & 127, eq = tid >> 7; const size_t rowbase = (size_t)b * SEQ;
    const float* gi = gates + ((size_t)b * 4 + h) * SEQ; const float* glf = gates + (size_t)BATCH * 4 * SEQ + ((size_t)b * 4 + h) * SEQ;
    float C[32], n[32];
#pragma unroll
    for (int i = 0; i < 32; ++i) { C[i] = 0.f; n[i] = 0.f; }
    float m = 0.f;
    for (int c = 0; c < SEQ / 64; ++c) {
        for (int it = tid; it < 2048; it += NTHREADS) {
            const int isk = it >> 10, r = (it >> 4) & 63, g = it & 15; const int t = 64 * c + r;
            const int ch = isk * 512 + h * 128 + 8 * g;
            float acc[8];
#pragma unroll
            for (int i = 0; i < 8; ++i) acc[i] = conv_b[ch + i];
#pragma unroll
            for (int j = 0; j < 4; ++j) { const int tt = t - 3 + j;
                if (tt >= 0) { const v4u u = *(const v4u*)(z + (rowbase + tt) * AB_N + 1536 + ch); const float* w = conv_w + j * 1024 + ch;
                    acc[0] += bf_lo(u.x) * w[0]; acc[1] += bf_hi(u.x) * w[1]; acc[2] += bf_lo(u.y) * w[2]; acc[3] += bf_hi(u.y) * w[3];
                    acc[4] += bf_lo(u.z) * w[4]; acc[5] += bf_hi(u.z) * w[5]; acc[6] += bf_lo(u.w) * w[6]; acc[7] += bf_hi(u.w) * w[7]; } }
            LAS float* dst = (isk ? ks : qs) + r * 128 + 8 * g; const float scl = isk ? 0.08838834764831845f : 1.0f;
#pragma unroll
            for (int i = 0; i < 8; ++i) dst[i] = acc[i] / (1.0f + __expf(-acc[i])) * scl;
        }
        __syncthreads();
        for (int r = 0; r < 64; ++r) {
            const int t = 64 * c + r;
            const float lf = glf[t], ig = gi[t];
            const float mn = fmaxf(lf + m, ig), fd = __expf(lf + m - mn), ii = __expf(ig - mn); m = mn;
            const float vv = bf1(z[(rowbase + t) * AB_N + 2560 + h * 128 + dv]) * ii;
            float pnum = 0.f, pden = 0.f;
#pragma unroll
            for (int i = 0; i < 32; ++i) { const float kk = ks[r * 128 + 32 * eq + i], qq = qs[r * 128 + 32 * eq + i];
                C[i] = fd * C[i] + vv * kk; n[i] = fd * n[i] + ii * kk; pnum += C[i] * qq; pden += n[i] * qq; }
            pn[((r & 1) * 4 + eq) * 128 + dv] = pnum; if (dv == 0) pd[(r & 1) * 4 + eq] = pden;
            __syncthreads();
            if (eq == 0) {
                const float num = (pn[((r & 1) * 4 + 0) * 128 + dv] + pn[((r & 1) * 4 + 1) * 128 + dv]) + (pn[((r & 1) * 4 + 2) * 128 + dv] + pn[((r & 1) * 4 + 3) * 128 + dv]);
                const float den = (pd[(r & 1) * 4 + 0] + pd[(r & 1) * 4 + 1]) + (pd[(r & 1) * 4 + 2] + pd[(r & 1) * 4 + 3]);
                const float hh = num / fmaxf(fabsf(den), __expf(-m));
                const float og = bf1(z[(rowbase + t) * AB_N + 3072 + h * 128 + dv]);
                y[(rowbase + t) * D + 512 + h * 128 + dv] = (bf16)f2bf(hh / (1.0f + __expf(-og)));
            }
        }
        __syncthreads();
    }
}

typedef float f32x16 __attribute__((ext_vector_type(16)));
__device__ __forceinline__ int crow(int r, int hi) { return (r & 3) + 8 * (r >> 2) + 4 * hi; }
#define MFMA32(a, b, c) __builtin_amdgcn_mfma_f32_32x32x16_bf16((a), (b), (c), 0, 0, 0)
template <int CTRL, int ROWMASK> __device__ __forceinline__ float dpp_f(float oldv, float x) {
    return __builtin_bit_cast(float, __builtin_amdgcn_update_dpp(__builtin_bit_cast(int, oldv), __builtin_bit_cast(int, x), CTRL, ROWMASK, 0xf, false)); }
__device__ __forceinline__ float scan_add(float v, int) {
    v += dpp_f<0x111, 0xf>(0.f, v); v += dpp_f<0x112, 0xf>(0.f, v); v += dpp_f<0x114, 0xf>(0.f, v); v += dpp_f<0x118, 0xf>(0.f, v);
    v += dpp_f<0x142, 0xa>(0.f, v); v += dpp_f<0x143, 0xc>(0.f, v); return v; }
__device__ __forceinline__ float scan_max(float v, int) {
    const float ninf = -INFINITY;
    v = fmaxf(v, dpp_f<0x111, 0xf>(ninf, v)); v = fmaxf(v, dpp_f<0x112, 0xf>(ninf, v)); v = fmaxf(v, dpp_f<0x114, 0xf>(ninf, v)); v = fmaxf(v, dpp_f<0x118, 0xf>(ninf, v));
    v = fmaxf(v, dpp_f<0x142, 0xa>(ninf, v)); v = fmaxf(v, dpp_f<0x143, 0xc>(ninf, v)); return v; }
__device__ __forceinline__ void swap32(unsigned& a, unsigned& b) { asm volatile("s_nop 1\n\tv_permlane32_swap_b32 %0, %1\n\ts_nop 1" : "+v"(a), "+v"(b)); }
__device__ __forceinline__ void swap16(unsigned& a, unsigned& b) { asm volatile("s_nop 1\n\tv_permlane16_swap_b32 %0, %1\n\ts_nop 1" : "+v"(a), "+v"(b)); }
__device__ __forceinline__ float xsum32(float v) { unsigned a = __builtin_bit_cast(unsigned, v), b = a; swap32(a, b); return __builtin_bit_cast(float, a) + __builtin_bit_cast(float, b); }
__device__ __forceinline__ float xsum16(float v) { unsigned a = __builtin_bit_cast(unsigned, v), b = a; swap16(a, b); return __builtin_bit_cast(float, a) + __builtin_bit_cast(float, b); }
__device__ __forceinline__ float xmax32(float v) { unsigned a = __builtin_bit_cast(unsigned, v), b = a; swap32(a, b); return fmaxf(__builtin_bit_cast(float, a), __builtin_bit_cast(float, b)); }

constexpr int FX_KSTR = 144, FX_F_OFF = 0, FX_K_OFF = 16384, FX_KBUF = 64 * FX_KSTR, FX_V_OFF = FX_K_OFF + 2 * FX_KBUF, FX_VBUF = 8192, FX_WT_OFF = FX_V_OFF + 3 * FX_VBUF;
__device__ __forceinline__ void fox_unit(int b, int h, int qb, const bf16* z, const float* lf, bf16* y, bool bounded, LAS unsigned char* lds, int tid, int lane, int wave) {
    const int q0 = qb * 256; const size_t rowbase = (size_t)b * SEQ;
    const int r32 = lane & 31, hi = lane >> 5;
    LAS float* F2 = (LAS float*)(lds + FX_F_OFF);
    const unsigned lds0 = (unsigned)(uintptr_t)lds;
    const int qrow = q0 + 32 * wave + r32;
    bf16x8 qf[4];
    { const bf16* qp = z + (rowbase + qrow) * FX_N + h * 64 + 8 * hi;
#pragma unroll
        for (int ks = 0; ks < 4; ++ks) qf[ks] = *(const bf16x8*)(qp + 16 * ks); }
    const int srow = tid >> 3, sch = tid & 7;
    const bf16* kg = z + (rowbase + srow) * FX_N + 1024 + h * 64 + 8 * sch;
    const bf16* vg = kg + 1024;
    const unsigned kdst = lds0 + FX_K_OFF + srow * FX_KSTR + sch * 16;
    const unsigned vdst = lds0 + FX_V_OFF + (sch >> 2) * 4096 + srow * 64 + (sch & 3) * 16;
    const int NT = 4 * (qb + 1), tmax = 4 * qb + (wave >> 1);
    v4u kA, vA, kB, vB;
    {
        const int n = q0 + 256; float v[8];
        if (tid * 8 < n) { const float* p = lf + ((size_t)b * 16 + h) * SEQ + tid * 8; const f32x4 a = *(const f32x4*)p, c = *(const f32x4*)(p + 4);
            v[0] = a.x; v[1] = v[0] + a.y; v[2] = v[1] + a.z; v[3] = v[2] + a.w; v[4] = v[3] + c.x; v[5] = v[4] + c.y; v[6] = v[5] + c.z; v[7] = v[6] + c.w; }
        else {
#pragma unroll
            for (int i = 0; i < 8; ++i) v[i] = 0.f; }
        const float inc = scan_add(v[7], lane);
        LAS float* wt = (LAS float*)(lds + FX_WT_OFF);
        if (lane == 63) wt[wave] = inc;
        __syncthreads();
        float base = inc - v[7];
        for (int w = 0; w < wave; ++w) base += wt[w];
        if (tid * 8 < n) { f32x4 a, c; a.x = (base + v[0]) * LOG2E; a.y = (base + v[1]) * LOG2E; a.z = (base + v[2]) * LOG2E; a.w = (base + v[3]) * LOG2E;
            c.x = (base + v[4]) * LOG2E; c.y = (base + v[5]) * LOG2E; c.z = (base + v[6]) * LOG2E; c.w = (base + v[7]) * LOG2E;
            *(LAS f32x4*)(F2 + tid * 8) = a; *(LAS f32x4*)(F2 + tid * 8 + 4) = c; }
    }
    __syncthreads();
    int t0 = 0, tw = 0;
    if (bounded) { constexpr float FX_SKIP = 80.0f;
        { const float lim = F2[q0] + FX_SKIP; int lo = 0, hi2 = NT - 1;
            while (lo < hi2) { const int mid = (lo + hi2) >> 1; if (F2[64 * mid + 63] <= lim) hi2 = mid; else lo = mid + 1; }
            t0 = lo & ~1; }
        { const float lim = F2[q0 + 32 * wave] + FX_SKIP; int lo = t0, hi2 = tmax;
            while (lo < hi2) { const int mid = (lo + hi2) >> 1; if (F2[64 * mid + 63] <= lim) hi2 = mid; else lo = mid + 1; }
            tw = lo; } }
    { const v4u k0 = *(const v4u*)(kg + (size_t)t0 * 64 * FX_N), v0 = *(const v4u*)(vg + (size_t)t0 * 64 * FX_N);
        kB = *(const v4u*)(kg + (size_t)(t0 + 1) * 64 * FX_N); vB = *(const v4u*)(vg + (size_t)(t0 + 1) * 64 * FX_N);
        *(LAS v4u*)(uintptr_t)kdst = k0; *(LAS v4u*)(uintptr_t)(vdst + (unsigned)(t0 % 3) * FX_VBUF) = v0; }
    __syncthreads();
    const float Fq = F2[qrow];
    f32x16 o[2];
#pragma unroll
    for (int i = 0; i < 16; ++i) { o[0][i] = 0.f; o[1][i] = 0.f; }
    float lsum = 0.f, mref = 0.f;
    const unsigned ka = lds0 + FX_K_OFF + r32 * FX_KSTR + hi * 16;
    const unsigned va = lds0 + FX_V_OFF + (4 * hi + ((lane & 15) >> 2)) * 64 + (16 * ((lane >> 4) & 1) + 4 * (lane & 3)) * 2;
#define FX_QK(P, tt) do { const LAS float* fk_ = F2 + 64 * (tt) + 4 * hi; const float bq_ = Fq - mref; const unsigned kb_ = ka + ((tt) & 1) * FX_KBUF; \
        _Pragma("unroll") for (int hf = 0; hf < 2; ++hf) _Pragma("unroll") for (int g = 0; g < 4; ++g) { const f32x4 f_ = *(const LAS f32x4*)(fk_ + 32 * hf + 8 * g); \
            P[hf][4 * g] = bq_ - f_.x; P[hf][4 * g + 1] = bq_ - f_.y; P[hf][4 * g + 2] = bq_ - f_.z; P[hf][4 * g + 3] = bq_ - f_.w; } \
        _Pragma("unroll") for (int ks = 0; ks < 4; ++ks) _Pragma("unroll") for (int hf = 0; hf < 2; ++hf) { const bf16x8 a_ = *(const LAS bf16x8*)(uintptr_t)(kb_ + hf * 32 * FX_KSTR + ks * 32); P[hf] = MFMA32(a_, qf[ks], P[hf]); } } while (0)
#define FX_SM(P, NOMAX, tt) do { \
        if (64 * (tt) + 63 > q0 + 32 * wave) { _Pragma("unroll") for (int hf = 0; hf < 2; ++hf) _Pragma("unroll") for (int r = 0; r < 16; ++r) { const int kv_ = 64 * (tt) + 32 * hf + crow(r, hi); if (kv_ > qrow) P[hf][r] = -INFINITY; } } \
        if (!(NOMAX)) { float mx_ = fmaxf(P[0][0], P[1][0]); \
            _Pragma("unroll") for (int r = 1; r < 16; ++r) mx_ = fmaxf(mx_, fmaxf(P[0][r], P[1][r])); \
            mx_ = xmax32(mx_); \
            if (__any(mx_ > 8.0f)) { const float dl_ = fmaxf(mx_, 0.f), alpha_ = ex2(-dl_); mref += dl_; lsum *= alpha_; \
                _Pragma("unroll") for (int r = 0; r < 16; ++r) { P[0][r] -= dl_; P[1][r] -= dl_; o[0][r] *= alpha_; o[1][r] *= alpha_; } } } \
        _Pragma("unroll") for (int hf = 0; hf < 2; ++hf) { \
            _Pragma("unroll") for (int r = 0; r < 16; ++r) { P[hf][r] = ex2(P[hf][r]); lsum += P[hf][r]; } \
            _Pragma("unroll") for (int k2 = 0; k2 < 2; ++k2) { v4u w_; w_.x = cvtpk(P[hf][8 * k2], P[hf][8 * k2 + 1]); w_.y = cvtpk(P[hf][8 * k2 + 2], P[hf][8 * k2 + 3]); w_.z = cvtpk(P[hf][8 * k2 + 4], P[hf][8 * k2 + 5]); w_.w = cvtpk(P[hf][8 * k2 + 6], P[hf][8 * k2 + 7]); \
                pf[hf][k2] = __builtin_bit_cast(bf16x8, w_); } } } while (0)
#define FX_PV(tt) do { const unsigned vs_ = va + (unsigned)((tt) % 3) * FX_VBUF; \
        _Pragma("unroll") for (int hf = 0; hf < 2; ++hf) _Pragma("unroll") for (int k2 = 0; k2 < 2; ++k2) _Pragma("unroll") for (int db = 0; db < 2; ++db) { const unsigned ad_ = vs_ + db * 4096 + (32 * hf + 16 * k2) * 64; \
            const s16x4 lo_ = ds_tr16(ad_), hh_ = ds_tr16(ad_ + 8 * 64); const bf16x8 a_ = {lo_[0], lo_[1], lo_[2], lo_[3], hh_[0], hh_[1], hh_[2], hh_[3]}; \
            o[db] = MFMA32(a_, pf[hf][k2], o[db]); } } while (0)
#define FX_ITER(t, KL, VL, KS, VS, NOMAX, LAG) do { \
        if ((t) + 2 < NT) { KL = *(const v4u*)(kg + (size_t)((t) + 2) * 64 * FX_N); VL = *(const v4u*)(vg + (size_t)((t) + 2) * 64 * FX_N); } \
        if (LAG) { if ((t) - 1 >= tw && (t) - 1 <= tmax) FX_PV((t) - 1); if ((t) >= tw && (t) <= tmax) { FX_QK(pc, (t)); FX_SM(pc, NOMAX, (t)); } } \
        else { if ((t) >= tw && (t) <= tmax) { FX_QK(pc, (t)); FX_SM(pc, NOMAX, (t)); FX_PV((t)); } } \
        if ((t) + 1 < NT) { *(LAS v4u*)(uintptr_t)(kdst + (((t) + 1) & 1) * FX_KBUF) = KS; *(LAS v4u*)(uintptr_t)(vdst + (unsigned)(((t) + 1) % 3) * FX_VBUF) = VS; } \
        __syncthreads(); } while (0)
    f32x16 pc[2]; bf16x8 pf[2][2];
    if (wave < 4) {
        if (bounded) { for (int t = t0; t < NT; t += 2) { FX_ITER(t, kA, vA, kB, vB, true, false); FX_ITER(t + 1, kB, vB, kA, vA, true, false); } }
        else { for (int t = t0; t < NT; t += 2) { FX_ITER(t, kA, vA, kB, vB, false, false); FX_ITER(t + 1, kB, vB, kA, vA, false, false); } }
    } else {
        if (bounded) { for (int t = t0; t < NT; t += 2) { FX_ITER(t, kA, vA, kB, vB, true, true); FX_ITER(t + 1, kB, vB, kA, vA, true, true); } }
        else { for (int t = t0; t < NT; t += 2) { FX_ITER(t, kA, vA, kB, vB, false, true); FX_ITER(t + 1, kB, vB, kA, vA, false, true); } }
        if (tmax == NT - 1) FX_PV(NT - 1);
    }
#undef FX_ITER
#undef FX_QK
#undef FX_SM
#undef FX_PV
    lsum = xsum32(lsum);
    const float il = 1.0f / lsum;
    bf16* yp = y + (rowbase + qrow) * D + h * 64 + 4 * hi;
#pragma unroll
    for (int db = 0; db < 2; ++db)
#pragma unroll
        for (int g = 0; g < 4; ++g) { const unsigned long long w = (unsigned long long)cvtpk(o[db][4 * g] * il, o[db][4 * g + 1] * il) | ((unsigned long long)cvtpk(o[db][4 * g + 2] * il, o[db][4 * g + 3] * il) << 32);
            *(unsigned long long*)(yp + 32 * db + 8 * g) = w; }
}

constexpr int DA_KSTR = 272, DA_K_OFF = 0, DA_KBUF = 64 * DA_KSTR, DA_V_OFF = 2 * DA_KBUF, DA_VBUF = 16384;
static_assert(DA_V_OFF + 2 * DA_VBUF >= 65536 && DA_V_OFF + 2 * DA_VBUF <= RING_BYTES, "DA LDS map (the exchange reuses the K/V region)");
__device__ __forceinline__ void da_unit(int b, int h, int qb, const bf16* z, bf16* y, volatile LAS unsigned* MISC, bool bounded, const float* subln_g, LAS unsigned char* lds, int tid, int lane, int wave) {
    const int q0 = qb * 128, qs = wave & 3, mm = wave >> 2; const size_t rowbase = (size_t)b * SEQ;
    const int r32 = lane & 31, hi = lane >> 5;
    const unsigned lds0 = (unsigned)(uintptr_t)lds;
    const float slope2 = exp2f(-2.0f * (float)(h + 1)) * LOG2E;
    const int qrow = q0 + 32 * qs + r32;
    float cr[16];
#pragma unroll
    for (int r = 0; r < 16; ++r) cr[r] = slope2 * (float)crow(r, hi);
#ifdef DBG_DA_SYNC
    for (int i = tid; i < 69632 / 4; i += NTHREADS) ((LAS unsigned*)lds)[i] = 0u;
    __syncthreads();
#endif
    bf16x8 qf[4];
    { const bf16* qp = z + (rowbase + qrow) * AB_N + h * 128 + mm * 64 + 8 * hi;
#pragma unroll
        for (int ks = 0; ks < 4; ++ks) qf[ks] = *(const bf16x8*)(qp + 16 * ks); }
    const bf16* kg[2]; unsigned kdst[2], vdst[2];
#pragma unroll
    for (int i = 0; i < 2; ++i) { const int c = tid + 512 * i, row = c >> 4, ch = c & 15;
        kg[i] = z + (rowbase + row) * AB_N + 512 + h * 128 + 8 * ch;
        kdst[i] = lds0 + DA_K_OFF + row * DA_KSTR + ch * 16; vdst[i] = lds0 + DA_V_OFF + (ch >> 2) * 4096 + row * 64 + (ch & 3) * 16; }
    int t0 = 0, tw = 0;
    if (bounded) { constexpr float DA_SKIP = 80.0f; const float dist = DA_SKIP / slope2;
        const int f0 = (int)floorf(((float)(q0 - 63) - dist) * (1.0f / 64.0f)) + 1, fw = (int)floorf(((float)(q0 + 32 * qs - 63) - dist) * (1.0f / 64.0f)) + 1;
        t0 = f0 > 0 ? f0 : 0; tw = fw > 0 ? fw : 0; }
    v4u kreg[2], vreg[2];
#pragma unroll
    for (int i = 0; i < 2; ++i) { kreg[i] = *(const v4u*)(kg[i] + (size_t)t0 * 64 * AB_N); vreg[i] = *(const v4u*)(kg[i] + 512 + (size_t)t0 * 64 * AB_N); }
#pragma unroll
    for (int i = 0; i < 2; ++i) { *(LAS v4u*)(uintptr_t)(kdst[i] + (t0 & 1) * DA_KBUF) = kreg[i]; *(LAS v4u*)(uintptr_t)(vdst[i] + (t0 & 1) * DA_VBUF) = vreg[i]; }
    __syncthreads();
    f32x16 o[4];
#pragma unroll
    for (int d = 0; d < 4; ++d)
#pragma unroll
        for (int i = 0; i < 16; ++i) o[d][i] = 0.f;
    float lsum = 0.f, mref = 0.f;
    const int NT = (q0 + 128) / 64, tmax = (q0 + 32 * qs) / 64;
    const unsigned ka = lds0 + DA_K_OFF + r32 * DA_KSTR + mm * 128 + hi * 16;
    const unsigned va = lds0 + DA_V_OFF + (4 * hi + ((lane & 15) >> 2)) * 64 + (16 * ((lane >> 4) & 1) + 4 * (lane & 3)) * 2;
    auto da_loop = [&](auto nomax_tag) { constexpr bool NOMAX = decltype(nomax_tag)::value;
    for (int t = t0; t < NT; ++t) {
        const int buf = t & 1;
        if (t + 1 < NT) {
#pragma unroll
            for (int i = 0; i < 2; ++i) { kreg[i] = *(const v4u*)(kg[i] + (size_t)(t + 1) * 64 * AB_N); vreg[i] = *(const v4u*)(kg[i] + 512 + (size_t)(t + 1) * 64 * AB_N); } }
        if (t >= tw && t <= tmax) {
            f32x16 p[2];
            if (t < tmax) {
                const float b0 = -slope2 * (float)(qrow - 64 * t) - mref, b1 = b0 + 32.0f * slope2;
#pragma unroll
                for (int r = 0; r < 16; ++r) { p[0][r] = b0 + cr[r]; p[1][r] = b1 + cr[r]; }
            } else {
#pragma unroll
                for (int hf = 0; hf < 2; ++hf)
#pragma unroll
                    for (int r = 0; r < 16; ++r) p[hf][r] = -slope2 * fabsf((float)(qrow - (64 * t + 32 * hf + crow(r, hi)))) - mref;
            }
#pragma unroll
            for (int hf = 0; hf < 2; ++hf)
#pragma unroll
                for (int ks = 0; ks < 4; ++ks) { const bf16x8 a = *(const LAS bf16x8*)(uintptr_t)(ka + buf * DA_KBUF + hf * 32 * DA_KSTR + ks * 32); p[hf] = MFMA32(a, qf[ks], p[hf]); }
            if (!NOMAX) {
            float mx = fmaxf(p[0][0], p[1][0]);
#pragma unroll
            for (int r = 1; r < 16; ++r) mx = fmaxf(mx, fmaxf(p[0][r], p[1][r]));
            mx = xmax32(mx);
            if (__any(mx > 8.0f)) { const float dl = fmaxf(mx, 0.f), alpha = ex2(-dl); mref += dl; lsum *= alpha;
#pragma unroll
                for (int r = 0; r < 16; ++r) { p[0][r] -= dl; p[1][r] -= dl; }
#pragma unroll
                for (int d = 0; d < 4; ++d)
#pragma unroll
                    for (int r = 0; r < 16; ++r) o[d][r] *= alpha; }
            }
            bf16x8 pf[2][2];
#pragma unroll
            for (int hf = 0; hf < 2; ++hf) {
#pragma unroll
                for (int r = 0; r < 16; ++r) { p[hf][r] = ex2(p[hf][r]); lsum += p[hf][r]; }
#pragma unroll
                for (int k2 = 0; k2 < 2; ++k2) { v4u w; w.x = cvtpk(p[hf][8 * k2], p[hf][8 * k2 + 1]); w.y = cvtpk(p[hf][8 * k2 + 2], p[hf][8 * k2 + 3]); w.z = cvtpk(p[hf][8 * k2 + 4], p[hf][8 * k2 + 5]); w.w = cvtpk(p[hf][8 * k2 + 6], p[hf][8 * k2 + 7]);
                    pf[hf][k2] = __builtin_bit_cast(bf16x8, w); } }
#pragma unroll
            for (int db = 0; db < 4; ++db)
#pragma unroll
                for (int hf = 0; hf < 2; ++hf)
#pragma unroll
                    for (int k2 = 0; k2 < 2; ++k2) { const unsigned ad = va + buf * DA_VBUF + db * 4096 + (32 * hf + 16 * k2) * 64;
                        const s16x4 lo = ds_tr16(ad), hh = ds_tr16(ad + 8 * 64);
                        const bf16x8 a = {lo[0], lo[1], lo[2], lo[3], hh[0], hh[1], hh[2], hh[3]};
                        o[db] = MFMA32(a, pf[hf][k2], o[db]); }
        }
        if (t + 1 < NT) {
#pragma unroll
            for (int i = 0; i < 2; ++i) { *(LAS v4u*)(uintptr_t)(kdst[i] + (buf ^ 1) * DA_KBUF) = kreg[i]; *(LAS v4u*)(uintptr_t)(vdst[i] + (buf ^ 1) * DA_VBUF) = vreg[i]; } }
        __syncthreads();
    }
    };
    if (bounded) da_loop(std::true_type{}); else da_loop(std::false_type{});
    lsum = xsum32(lsum);
    const float il = 1.0f / lsum;
    LAS float* xb = (LAS float*)lds + qs * 4096 + lane;
    if (mm == 1) {
#pragma unroll
        for (int db = 0; db < 4; ++db)
#pragma unroll
            for (int r = 0; r < 16; ++r) xb[(db * 16 + r) * 64] = o[db][r] * il;
    }
    __syncthreads();
    if (mm == 0) {
        const float lam = __builtin_bit_cast(float, (unsigned)MISC[2]), lambda_init = __builtin_bit_cast(float, (unsigned)MISC[3]);
        float ss = 0.f;
#pragma unroll
        for (int db = 0; db < 4; ++db)
#pragma unroll
            for (int r = 0; r < 16; ++r) { const float dv = o[db][r] * il - lam * xb[(db * 16 + r) * 64]; o[db][r] = dv; ss += dv * dv; }
        ss += __shfl_xor(ss, 32);
        const float rn = (1.0f - lambda_init) / sqrtf(ss * (1.0f / 128.0f) + EPS);
        bf16* yp = y + (rowbase + qrow) * D + h * 128 + 4 * hi; const float* gp = subln_g + 4 * hi;
#pragma unroll
        for (int db = 0; db < 4; ++db)
#pragma unroll
            for (int g = 0; g < 4; ++g) { const f32x4 gg = *(const f32x4*)(gp + 32 * db + 8 * g);
                const unsigned long long w = (unsigned long long)cvtpk(o[db][4 * g] * rn * gg.x, o[db][4 * g + 1] * rn * gg.y) | ((unsigned long long)cvtpk(o[db][4 * g + 2] * rn * gg.z, o[db][4 * g + 3] * rn * gg.w) << 32);
                *(unsigned long long*)(yp + 32 * db + 8 * g) = w; }
    }
    __syncthreads();
}

__device__ __forceinline__ void phase_mlconv(const bf16* z, const float* conv_w, const float* conv_b, bf16* qkc, int tid, int G) {
    const int cg = tid & 127, rs = tid >> 7, ch = 8 * cg;
    const float scl = (ch >= 512) ? 0.08838834764831845f : 1.0f;
    for (int item = blockIdx.x; item < M / 16; item += G) {
        const int row0 = item * 16 + 4 * rs, t0 = row0 % SEQ;
        v4u xr[7];
#pragma unroll
        for (int j = 0; j < 7; ++j) { const int tt = t0 - 3 + j; xr[j] = (tt >= 0) ? *(const v4u*)(z + (size_t)(row0 - 3 + j) * AB_N + 1536 + ch) : (v4u){0u, 0u, 0u, 0u}; }
        float a4[4][8];
        { const f32x4 b0 = *(const f32x4*)(conv_b + ch), b1 = *(const f32x4*)(conv_b + ch + 4);
#pragma unroll
            for (int r = 0; r < 4; ++r) { a4[r][0] = b0.x; a4[r][1] = b0.y; a4[r][2] = b0.z; a4[r][3] = b0.w; a4[r][4] = b1.x; a4[r][5] = b1.y; a4[r][6] = b1.z; a4[r][7] = b1.w; } }
#pragma unroll
        for (int j = 0; j < 4; ++j) { const f32x4 w0 = *(const f32x4*)(conv_w + j * 1024 + ch), w1 = *(const f32x4*)(conv_w + j * 1024 + ch + 4);
#pragma unroll
            for (int r = 0; r < 4; ++r) { const v4u u = xr[r + j];
                a4[r][0] += bf_lo(u.x) * w0.x; a4[r][1] += bf_hi(u.x) * w0.y; a4[r][2] += bf_lo(u.y) * w0.z; a4[r][3] += bf_hi(u.y) * w0.w;
                a4[r][4] += bf_lo(u.z) * w1.x; a4[r][5] += bf_hi(u.z) * w1.y; a4[r][6] += bf_lo(u.w) * w1.z; a4[r][7] += bf_hi(u.w) * w1.w; } }
#pragma unroll
        for (int r = 0; r < 4; ++r) { float a[8];
#pragma unroll
            for (int i = 0; i < 8; ++i) a[i] = a4[r][i] * fast_sig(a4[r][i]) * scl;
            v4u w; w.x = cvtpk(a[0], a[1]); w.y = cvtpk(a[2], a[3]); w.z = cvtpk(a[4], a[5]); w.w = cvtpk(a[6], a[7]);
            *(v4u*)(qkc + (size_t)(row0 + r) * 1024 + ch) = w; }
    }
}

typedef float f32x4v __attribute__((ext_vector_type(4)));
#define MFMA16(a, b, c) __builtin_amdgcn_mfma_f32_16x16x32_bf16((a), (b), (c), 0, 0, 0)
constexpr int ML_STR = 272, ML_VSTR = 144, ML_Q = 0, ML_K = 17408, ML_KBUF = 80 * ML_STR, ML_V = ML_K + 2 * ML_KBUF, ML_VW = ML_V + 64 * ML_VSTR, ML_P = ML_VW + 64 * ML_VSTR, ML_PSTR = 144,
              ML_H = ML_P + 64 * ML_PSTR, ML_T = ML_H + 64 * ML_VSTR, ML_TPAR = 2048, ML_DENP = ML_T + 2 * ML_TPAR, ML_DN = ML_DENP + 1024, ML_DUMMY = ML_DN + 256, ML_XCH = ML_DUMMY + 512, ML_END = ML_XCH + 16384;
constexpr int ML_RS = RING_BYTES + 1024;
static_assert(ML_END <= RING_BYTES && ML_RS + 4096 <= LDS_BYTES && MISC_OFF + 128 <= RING_BYTES + 1024, "mLSTM LDS map");
#define SCHED_FENCE() __builtin_amdgcn_sched_barrier(0)
__device__ __forceinline__ float bcast63(float v) { return __builtin_bit_cast(float, __builtin_amdgcn_readlane(__builtin_bit_cast(int, v), 63)); }
__device__ __forceinline__ void ml_gate_tables(float lfv, float igv, LAS float* tp, float& mprev, int lane) {
    lfv *= LOG2E; igv *= LOG2E;
    const float a = scan_add(lfv, lane), b = igv - a, cm = scan_max(b, lane);
    const float alast = bcast63(a), bmax = bcast63(cm);
    const float mnew = fmaxf(alast + mprev, alast + bmax), Mv = fmaxf(mprev, cm);
    tp[lane] = b; tp[64 + lane] = Mv; tp[128 + lane] = ex2(mprev - Mv); tp[192 + lane] = ex2(-(a + Mv)); tp[256 + lane] = ex2(alast + b - mnew);
    if (lane == 0) tp[320] = ex2(alast + mprev - mnew);
    mprev = mnew;
}
template <int STRIDE> __device__ __forceinline__ bf16x8 tr_frag(unsigned addr) {
    const s16x4 lo = ds_tr16(addr), hh = ds_tr16(addr + 4 * STRIDE);
    return (bf16x8){lo[0], lo[1], lo[2], lo[3], hh[0], hh[1], hh[2], hh[3]}; }
__device__ __forceinline__ void mlstm_unit(int b, int h, int dh, const bf16* z, const bf16* qkc, const float* gates, bf16* y, LAS unsigned char* lds, int tid, int lane, int wave) {
    const size_t rowbase = (size_t)b * SEQ;
    const unsigned lds0 = (unsigned)(uintptr_t)lds;
    const float* gi = gates + ((size_t)b * 4 + h) * SEQ; const float* glf = gates + (size_t)BATCH * 4 * SEQ + ((size_t)b * 4 + h) * SEQ;
    const int c15 = lane & 15, kq = lane >> 4;
    const int sl = wave >> 1, rr = wave & 1;
    const bf16* gq = qkc + rowbase * 1024 + h * 128;
    const bf16* zv = z + rowbase * AB_N + 2560 + h * 128 + 64 * dh + 8 * (tid & 7);
    const int vrow = tid >> 3;
    v4u qr[2], kr[2], vr;
#define ML_LOADS(cn) do { _Pragma("unroll") for (int i = 0; i < 2; ++i) { const int c_ = tid + 512 * i; const size_t r_ = (size_t)(64 * (cn) + (c_ >> 4)); \
            qr[i] = *(const v4u*)(gq + r_ * 1024 + 8 * (c_ & 15)); kr[i] = *(const v4u*)(gq + r_ * 1024 + 512 + 8 * (c_ & 15)); } \
        vr = *(const v4u*)(zv + (size_t)(64 * (cn) + vrow) * AB_N); } while (0)
#define ML_CONV_STORE(kb) do { _Pragma("unroll") for (int i = 0; i < 2; ++i) { const int c_ = tid + 512 * i; const unsigned o_ = (c_ >> 4) * ML_STR + 16 * (c_ & 15); \
            *(LAS v4u*)(uintptr_t)(lds0 + ML_Q + o_) = qr[i]; *(LAS v4u*)(uintptr_t)(lds0 + ML_K + (kb) * ML_KBUF + o_) = kr[i]; } } while (0)
#define ML_V_STORE(tp) do { const float w_ = (tp)[256 + vrow]; const v4u u = vr; const unsigned o_ = vrow * ML_VSTR + 16 * (tid & 7); \
            *(LAS v4u*)(uintptr_t)(lds0 + ML_V + o_) = u; \
            v4u x_; x_.x = cvtpk(bf_lo(u.x) * w_, bf_hi(u.x) * w_); x_.y = cvtpk(bf_lo(u.y) * w_, bf_hi(u.y) * w_); x_.z = cvtpk(bf_lo(u.z) * w_, bf_hi(u.z) * w_); x_.w = cvtpk(bf_lo(u.w) * w_, bf_hi(u.w) * w_); \
            *(LAS v4u*)(uintptr_t)(lds0 + ML_VW + o_) = x_; } while (0)
    LAS float* T0 = (LAS float*)(lds + ML_T);
    LAS float* denp = (LAS float*)(lds + ML_DENP);
    LAS float* dnr = (LAS float*)(lds + ML_DN);
    LAS float* xch = (LAS float*)(lds + ML_XCH);
    float mprev = 0.f;
    float g_lf = 0.f, g_ig = 0.f;
    if (wave == 7) { ml_gate_tables(glf[lane], gi[lane], T0, mprev, lane); g_lf = glf[64 + lane]; g_ig = gi[64 + lane]; }
    ML_LOADS(0);
    ML_CONV_STORE(0);
    if (tid < 32) *(LAS unsigned long long*)(uintptr_t)(lds0 + ML_K + 64 * ML_STR + 8 * tid) = (unsigned long long)(tid >> 20);
    __syncthreads();
    ML_V_STORE(T0);
    f32x4v C[4], nacc = {0.f, 0.f, 0.f, 0.f};
#pragma unroll
    for (int T = 0; T < 4; ++T) C[T] = (f32x4v){0.f, 0.f, 0.f, 0.f};
    const int lt_s = wave >> 1, half_s = wave & 1;
#define ML_PHASE_C(cc, OG) do { const v4u hv = *(const LAS v4u*)(uintptr_t)(lds0 + ML_H + vrow * ML_VSTR + 16 * (tid & 7)); const v4u og = OG; \
        v4u o_; o_.x = cvtpk(bf_lo(hv.x) * fast_sig(bf_lo(og.x)), bf_hi(hv.x) * fast_sig(bf_hi(og.x))); o_.y = cvtpk(bf_lo(hv.y) * fast_sig(bf_lo(og.y)), bf_hi(hv.y) * fast_sig(bf_hi(og.y))); \
        o_.z = cvtpk(bf_lo(hv.z) * fast_sig(bf_lo(og.z)), bf_hi(hv.z) * fast_sig(bf_hi(og.z))); o_.w = cvtpk(bf_lo(hv.w) * fast_sig(bf_lo(og.w)), bf_hi(hv.w) * fast_sig(bf_hi(og.w))); \
        *(v4u*)(y + (rowbase + 64 * (cc) + vrow) * D + 512 + h * 128 + 64 * dh + 8 * (tid & 7)) = o_; } while (0)
    v4u ogp = (v4u){0u, 0u, 0u, 0u};
    __syncthreads();
    for (int c = 0; c < SEQ / 64; ++c) {
        const int par = c & 1, kb = c & 1; LAS float* tp = T0 + par * (ML_TPAR / 4);
        const unsigned Kb = lds0 + ML_K + kb * ML_KBUF;
        const bool more = (c + 1 < SEQ / 64);
        const v4u vcur = vr;
        float gn_lf = 0.f, gn_ig = 0.f;
        if (more) { ML_LOADS(c + 1); if (wave == 7 && c + 2 < SEQ / 64) { gn_lf = glf[64 * (c + 2) + lane]; gn_ig = gi[64 * (c + 2) + lane]; } }
        const v4u ogr = *(const v4u*)(zv + (size_t)(64 * c + vrow) * AB_N + 512);
        {
            bf16x8 qb[4], kf[2][4], nf[4];
            const int l = 16 * lt_s + c15;
#pragma unroll
            for (int ks = 0; ks < 4; ++ks) qb[ks] = *(const LAS bf16x8*)(uintptr_t)(lds0 + ML_Q + l * ML_STR + (32 * ks + 8 * kq) * 2);
#pragma unroll
            for (int jj = 0; jj < 2; ++jj)
#pragma unroll
                for (int ks = 0; ks < 4; ++ks) kf[jj][ks] = *(const LAS bf16x8*)(uintptr_t)(Kb + (16 * (2 * half_s + jj) + c15) * ML_STR + (32 * ks + 8 * kq) * 2);
#pragma unroll
            for (int ks = 0; ks < 4; ++ks) nf[ks] = *(const LAS bf16x8*)(uintptr_t)(Kb + (64 + c15) * ML_STR + (32 * ks + 8 * kq) * 2);
            const float Ml = tp[64 + l];
            const f32x4v bs0 = *(const LAS f32x4v*)(tp + 16 * (2 * half_s) + 4 * kq), bs1 = *(const LAS f32x4v*)(tp + 16 * (2 * half_s + 1) + 4 * kq);
            if (c > 0) { ML_PHASE_C(c - 1, ogp);
                { const float w_ = tp[256 + vrow]; const v4u u = vcur; const unsigned o_ = vrow * ML_VSTR + 16 * (tid & 7);
                    *(LAS v4u*)(uintptr_t)(lds0 + ML_V + o_) = u;
                    v4u x_; x_.x = cvtpk(bf_lo(u.x) * w_, bf_hi(u.x) * w_); x_.y = cvtpk(bf_lo(u.y) * w_, bf_hi(u.y) * w_); x_.z = cvtpk(bf_lo(u.z) * w_, bf_hi(u.z) * w_); x_.w = cvtpk(bf_lo(u.w) * w_, bf_hi(u.w) * w_);
                    *(LAS v4u*)(uintptr_t)(lds0 + ML_VW + o_) = x_; } }
            if (more && wave == 7) { ml_gate_tables(g_lf, g_ig, T0 + (par ^ 1) * (ML_TPAR / 4), mprev, lane); g_lf = gn_lf; g_ig = gn_ig; }
            ogp = ogr;
            SCHED_FENCE();
            f32x4v acc[2] = {{0.f, 0.f, 0.f, 0.f}, {0.f, 0.f, 0.f, 0.f}}, accn = {0.f, 0.f, 0.f, 0.f};
#pragma unroll
            for (int ks = 0; ks < 4; ++ks) { acc[0] = MFMA16(kf[0][ks], qb[ks], acc[0]); acc[1] = MFMA16(kf[1][ks], qb[ks], acc[1]); if (half_s == 0) accn = MFMA16(nf[ks], qb[ks], accn); }
#pragma unroll
            for (int jj = 0; jj < 2; ++jj) { const int st = 2 * half_s + jj; const f32x4v bs = jj ? bs1 : bs0;
                float p[4], sum = 0.f;
#pragma unroll
                for (int r = 0; r < 4; ++r) { const int sidx = 16 * st + 4 * kq + r; p[r] = (sidx <= l) ? acc[jj][r] * ex2(bs[r] - Ml) : 0.f; sum += p[r]; }
                sum = xsum32(xsum16(sum));
                denp[st * 64 + l] = sum;
                *(LAS unsigned long long*)(uintptr_t)(lds0 + ML_P + l * ML_PSTR + (16 * st + 4 * kq) * 2) = (unsigned long long)cvtpk(p[0], p[1]) | ((unsigned long long)cvtpk(p[2], p[3]) << 32);
            }
            if (half_s == 0) *(LAS float*)(uintptr_t)(kq == 0 ? lds0 + ML_DN + 4 * l : lds0 + ML_DUMMY + 8 * lane) = accn[0];
        }
        f32x4v hp[4];
        {
            bf16x8 cbf[2];
#pragma unroll
            for (int j = 0; j < 2; ++j) { v4u w_; w_.x = cvtpk(C[2 * j][0], C[2 * j][1]); w_.y = cvtpk(C[2 * j][2], C[2 * j][3]); w_.z = cvtpk(C[2 * j + 1][0], C[2 * j + 1][1]); w_.w = cvtpk(C[2 * j + 1][2], C[2 * j + 1][3]);
                cbf[j] = __builtin_bit_cast(bf16x8, w_); }
            unsigned long long qlo[4][2], qhi[4][2];
#pragma unroll
            for (int lt = 0; lt < 4; ++lt)
#pragma unroll
                for (int j = 0; j < 2; ++j) { const unsigned qa = lds0 + ML_Q + (16 * lt + c15) * ML_STR + (32 * (2 * rr + j) + 4 * kq) * 2;
                    qlo[lt][j] = *(const LAS unsigned long long*)(uintptr_t)qa; qhi[lt][j] = *(const LAS unsigned long long*)(uintptr_t)(qa + 32); }
            SCHED_FENCE();
#pragma unroll
            for (int lt = 0; lt < 4; ++lt) { hp[lt] = (f32x4v){0.f, 0.f, 0.f, 0.f};
#pragma unroll
                for (int j = 0; j < 2; ++j) { v4u w_; w_.x = (unsigned)qlo[lt][j]; w_.y = (unsigned)(qlo[lt][j] >> 32); w_.z = (unsigned)qhi[lt][j]; w_.w = (unsigned)(qhi[lt][j] >> 32);
                    hp[lt] = MFMA16(__builtin_bit_cast(bf16x8, w_), cbf[j], hp[lt]); } }
#pragma unroll
            for (int i = 0; i < 2; ++i)
#pragma unroll
                for (int r = 0; r < 4; ++r) xch[((wave * 2 + i) * 4 + r) * 64 + lane] = rr ? hp[i][r] : hp[2 + i][r];
        }
        __syncthreads();
        const float decay = tp[320];
        bf16x8 vb[2], pfr[2][2], vwb[2], wb[2], an[2], af[4][2]; float xp[2][4];
#pragma unroll
        for (int k2 = 0; k2 < 2; ++k2) { vb[k2] = tr_frag<ML_VSTR>(lds0 + ML_V + (32 * k2 + 8 * kq + ((lane & 15) >> 2)) * ML_VSTR + (16 * sl + 4 * (lane & 3)) * 2);
            vwb[k2] = tr_frag<ML_VSTR>(lds0 + ML_VW + (32 * k2 + 8 * kq + ((lane & 15) >> 2)) * ML_VSTR + (16 * sl + 4 * (lane & 3)) * 2);
            an[k2] = tr_frag<ML_STR>(Kb + (32 * k2 + 8 * kq + ((lane & 15) >> 2)) * ML_STR + (16 * wave + 4 * (lane & 3)) * 2);
            const f32x4v w0 = *(const LAS f32x4v*)(tp + 256 + 32 * k2 + 8 * kq), w1 = *(const LAS f32x4v*)(tp + 256 + 32 * k2 + 8 * kq + 4);
            v4u w_; w_.x = cvtpk(w0[0], w0[1]); w_.y = cvtpk(w0[2], w0[3]); w_.z = cvtpk(w1[0], w1[1]); w_.w = cvtpk(w1[2], w1[3]);
            if (c15 != 0) w_ = (v4u){0u, 0u, 0u, 0u};
            wb[k2] = __builtin_bit_cast(bf16x8, w_); }
#pragma unroll
        for (int i = 0; i < 2; ++i) {
#pragma unroll
            for (int r = 0; r < 4; ++r) xp[i][r] = xch[(((wave ^ 1) * 2 + i) * 4 + r) * 64 + lane];
#pragma unroll
            for (int k2 = 0; k2 < 2; ++k2) pfr[i][k2] = *(const LAS bf16x8*)(uintptr_t)(lds0 + ML_P + (16 * (2 * rr + i) + c15) * ML_PSTR + (32 * k2 + 8 * kq) * 2); }
#pragma unroll
        for (int Ti = 0; Ti < 4; ++Ti)
#pragma unroll
            for (int k2 = 0; k2 < 2; ++k2) af[Ti][k2] = tr_frag<ML_STR>(Kb + (32 * k2 + 8 * kq + ((lane & 15) >> 2)) * ML_STR + (16 * (4 * rr + Ti) + 4 * (lane & 3)) * 2);
        LAS float* rsw = (LAS float*)(lds + ML_RS) + wave * 128;
        { const float iwl = tp[128 + lane], fll = tp[192 + lane];
            const float den = iwl * dnr[lane] + ((denp[lane] + denp[64 + lane]) + (denp[128 + lane] + denp[192 + lane]));
            rsw[lane] = iwl; rsw[64 + lane] = __builtin_amdgcn_rcpf(fmaxf(fabsf(den), fll)); }
        f32x4v iw4[2], rs4[2];
#pragma unroll
        for (int i = 0; i < 2; ++i) { iw4[i] = *(const LAS f32x4v*)(rsw + 16 * (2 * rr + i) + 4 * kq); rs4[i] = *(const LAS f32x4v*)(rsw + 64 + 16 * (2 * rr + i) + 4 * kq); }
        SCHED_FENCE();
        {
            f32x4v hacc[2];
#pragma unroll
            for (int i = 0; i < 2; ++i) {
#pragma unroll
                for (int r = 0; r < 4; ++r) hacc[i][r] = ((rr ? hp[2 + i][r] : hp[i][r]) + xp[i][r]) * iw4[i][r];
#pragma unroll
                for (int k2 = 0; k2 < 2; ++k2) hacc[i] = MFMA16(pfr[i][k2], vb[k2], hacc[i]); }
#pragma unroll
            for (int i = 0; i < 2; ++i)
#pragma unroll
                for (int r = 0; r < 4; ++r) { const float hv = hacc[i][r] * rs4[i][r];
                    *(LAS bf16*)(uintptr_t)(lds0 + ML_H + (16 * (2 * rr + i) + 4 * kq + r) * ML_VSTR + (16 * sl + c15) * 2) = (bf16)(cvtpk(hv, 0.f) & 0xffffu); }
        }
        {
#pragma unroll
            for (int r = 0; r < 4; ++r) nacc[r] *= decay;
#pragma unroll
            for (int Ti = 0; Ti < 4; ++Ti) {
#pragma unroll
                for (int r = 0; r < 4; ++r) C[Ti][r] *= decay;
#pragma unroll
                for (int k2 = 0; k2 < 2; ++k2) C[Ti] = MFMA16(af[Ti][k2], vwb[k2], C[Ti]); }
#pragma unroll
            for (int k2 = 0; k2 < 2; ++k2) nacc = MFMA16(an[k2], wb[k2], nacc);
            *(LAS unsigned long long*)(uintptr_t)(c15 == 0 ? lds0 + ML_K + (kb ^ 1) * ML_KBUF + 64 * ML_STR + (16 * wave + 4 * kq) * 2 : lds0 + ML_DUMMY + 8 * lane) = (unsigned long long)cvtpk(nacc[0], nacc[1]) | ((unsigned long long)cvtpk(nacc[2], nacc[3]) << 32);
        }
        if (more) ML_CONV_STORE(kb ^ 1);
        __syncthreads();
    }
    ML_PHASE_C(SEQ / 64 - 1, ogp);
    __syncthreads();
#undef ML_PHASE_C
#undef ML_LOADS
#undef ML_CONV_STORE
#undef ML_V_STORE
}

constexpr int N_PHASES = 1 + 7 * DEPTH;
__global__ void __launch_bounds__(NTHREADS, 2) fwd_kernel(Args args) {
    extern __shared__ __attribute__((aligned(16))) unsigned char lds_raw[];
    LAS unsigned char* lds = (LAS unsigned char*)lds_raw;
    volatile LAS unsigned* MISC = (volatile LAS unsigned*)(lds + MISC_OFF);
    const int tid0 = threadIdx.x;
    const int G = gridDim.x;
    unsigned char* ws = args.ws;
    gu32* ctl = (gu32*)(ws + WS_CTL);
    for (int u = tid0; u < (LDS_BYTES - LDSCTL_OFF) / 4; u += NTHREADS) ((LAS unsigned*)(lds + LDSCTL_OFF))[u] = 0u;
    __syncthreads();
    XcdBarrier bar; bar.bar = (unsigned*)(ctl + CW_BAR); bar.x = 0; bar.st = nullptr;
    const int lo = args.ph_lo, hi = args.ph_hi;
    if (hi - lo > 1) bar = xcd_barrier_post((unsigned*)(ctl + CW_BAR), MISC + 8);
#define IN(k) (lo <= (k) && (k) < hi)
#define FRESH_TID() int tid = tid0; asm volatile("" : "+v"(tid)); const int lane = tid & 63, wave = __builtin_amdgcn_readfirstlane(tid >> 6); (void)lane; (void)wave
#define SEAM(k) do { if (IN(k) && IN((k) + 1)) xcd_barrier(bar); } while (0)

    float* mod = (float*)(ws + WS_MOD);
    float* gates = (float*)(ws + WS_GATE);
    bf16* A1 = (bf16*)(ws + WS_A1);
    bf16* Z = (bf16*)(ws + WS_Z);

    if (IN(0)) for (int rp = 0; rp < REP_PRO; ++rp) { const int tid = tid0, lane = tid & 63, wave = __builtin_amdgcn_readfirstlane(tid >> 6); if (rp) xcd_barrier(bar); phase_prologue(args, lds, tid, lane, wave, G); }
    SEAM(0);

    for (int l = 0; l < DEPTH; ++l) {
        const int base = 1 + 7 * l, j = l >> 1; const bool odd = (l & 1) != 0;
        bf16* XB = (bf16*)args.out;
        bf16* XB2 = (bf16*)(ws + WS_XB2);
        const float* modl = mod + (size_t)l * BATCH * MODW;
        if (IN(base + 0)) for (int rp = 0; rp < REP_NORM; ++rp) { FRESH_TID(); if (rp) xcd_barrier(bar);
            if (l == 0) phase_norm<8, false>(args.in[0], args.in[4] + l * D, modl + 0 * D, modl + 1 * D, A1, args.in[6] + (size_t)j * D * AB_LD, AB_LD, AB_N, args.in[7] + j * 4, args.in[8] + j * 4, gates, lds, tid, lane, wave, G);
            else if (!odd) phase_norm<8, true>(XB, args.in[4] + l * D, modl + 0 * D, modl + 1 * D, A1, args.in[6] + (size_t)j * D * AB_LD, AB_LD, AB_N, args.in[7] + j * 4, args.in[8] + j * 4, gates, lds, tid, lane, wave, G);
            else phase_norm<16, true>(XB, args.in[4] + l * D, modl + 0 * D, modl + 1 * D, A1, args.in[16] + (size_t)j * D * FX_LD, FX_LD, FX_N, nullptr, args.in[17] + j * 16, gates, lds, tid, lane, wave, G);
        }
        SEAM(base + 0);
        if (IN(base + 1)) for (int rp = 0; rp < REP_GIN; ++rp) { if (rp) xcd_barrier(bar);
            const int N = odd ? FX_N : AB_N;
            pg8::Gemm g{A1, odd ? (const bf16*)(ws + WS_WIN_O) + (size_t)j * FX_N * D : (const bf16*)(ws + WS_WIN_E) + (size_t)j * AB_N * D, M, N, D};
            pg8::StaticOrder S; S.init(M, N, G, (int)blockIdx.x);
            pg8::EpiIn E{Z, N, odd ? 1024 : 512, odd ? 2048 : 1024, odd ? args.in[18] + j * 64 : args.in[11] + j * 64, odd ? args.in[19] + j * 64 : args.in[12] + j * 64, 0.125f * LOG2E};
            pg8::gemm_phase<pg8::EpiIn, pg8::StaticOrder, true, true>(lds + RING_OFF, g, S, E);
        }
        SEAM(base + 1);
        if (IN(base + 2)) for (int rp = 0; rp < (odd ? REP_MIX_O : REP_MIX_E); ++rp) { FRESH_TID(); if (rp) xcd_barrier(bar);
            gu32* head = ctl + CW_QUEUE + 64 * (l + 4 * rp);
            if (!odd) {
#if USE_ML_MFMA
                phase_mlconv(Z, args.in[9] + (size_t)j * 4 * 1024, args.in[10] + (size_t)j * 1024, (bf16*)(ws + WS_QKC), tid, G);
                if (hi - lo > 1) xcd_barrier(bar);
#endif
                if (tid0 == 0) { const float lambda_init = 0.8f - 0.6f * expf(-0.3f * (float)l);
                    const float* lp = args.in[13] + j * 256; float s0 = 0.f, s1 = 0.f; for (int d = 0; d < 64; ++d) { s0 += lp[d] * lp[64 + d]; s1 += lp[128 + d] * lp[192 + d]; }
                    MISC[2] = __builtin_bit_cast(unsigned, expf(s0) - expf(s1) + lambda_init); MISC[3] = __builtin_bit_cast(unsigned, lambda_init);
                    const float* gq = args.in[11] + j * 64; const float* gk = args.in[12] + j * 64; float gm = 0.f; for (int d = 0; d < 64; ++d) gm = fmaxf(gm, fabsf(gq[d] * gk[d]));
                    MISC[4] = (8.0f * LOG2E * gm < 64.0f) ? 1u : 0u; }
                for (;;) { int idx = queue_next(head, MISC, tid0); if (idx >= 64 * REP_ML + 1024 * REP_DA) break;
                    if (idx < 64 * REP_ML) idx &= 63; else idx = 64 + ((idx - 64 * REP_ML) & 1023);
                    int tid = tid0; asm volatile("" : "+v"(tid)); const int lane = tid & 63, wave = __builtin_amdgcn_readfirstlane(tid >> 6);
#if USE_ML_MFMA
                    if (idx < 64) mlstm_unit(idx >> 3, (idx >> 1) & 3, idx & 1, Z, (const bf16*)(ws + WS_QKC), gates, A1, lds, tid, lane, wave);
#else
                    if (idx < 32) mlstm_naive_unit(idx >> 2, idx & 3, Z, gates, args.in[9] + (size_t)j * 4 * 1024, args.in[10] + (size_t)j * 1024, A1, lds, tid);
#endif
                    else { const int u = idx - 64, qb = 31 - u / 32, bh = u % 32;
#if USE_DA_MFMA
                        da_unit(bh >> 2, bh & 3, qb, Z, A1, MISC, MISC[4] != 0u, args.in[14] + j * 128, lds, tid, lane, wave);
#ifdef DBG_DA_BOTH
                        da_naive_unit(bh >> 2, bh & 3, qb, Z, A1, args.in[13] + j * 256, args.in[14] + j * 128, l, lane, wave);
#endif
#else
                        da_naive_unit(bh >> 2, bh & 3, qb, Z, A1, args.in[13] + j * 256, args.in[14] + j * 128, l, lane, wave);
#endif
                    } }
            } else {
#if USE_FOX_MFMA
                if (tid0 == 0) { const float* gq = args.in[18] + j * 64; const float* gk = args.in[19] + j * 64; float gm = 0.f; for (int d = 0; d < 64; ++d) gm = fmaxf(gm, fabsf(gq[d] * gk[d]));
                    MISC[4] = (8.0f * LOG2E * gm < 64.0f) ? 1u : 0u; }
                for (;;) { const int idx = queue_next(head, MISC, tid0); if (idx >= 2048) break;
                    int tid = tid0; asm volatile("" : "+v"(tid)); const int lane = tid & 63, wave = __builtin_amdgcn_readfirstlane(tid >> 6);
                    const int qb = 15 - idx / 128, bh = idx % 128; fox_unit(bh >> 4, bh & 15, qb, Z, gates, A1, MISC[4] != 0u, lds, tid, lane, wave); }
#else
                for (;;) { const int idx = queue_next(head, MISC, tid); if (idx >= 1024) break;
                    const int qb = 7 - idx / 128, bh = idx % 128; fox_naive_unit(bh >> 4, bh & 15, qb, Z, gates, A1, lds, tid, lane, wave); }
#endif
            }
        }
        SEAM(base + 2);
        if (IN(base + 3)) for (int rp = 0; rp < REP_GOUT; ++rp) { if (rp) xcd_barrier(bar);
            pg8::Gemm g{A1, (const bf16*)(ws + WS_WOUT) + (size_t)l * D * D, M, D, D};
            pg8::StaticOrder S; S.init(M, D, G, (int)blockIdx.x);
            const bool dry = (rp + 1 < REP_GOUT);
            const bool last = (l == DEPTH - 1); bf16* xo = last ? XB2 : XB;
            pg8::EpiRes E{args.in[0], (l == 0 && !dry) ? nullptr : (dry ? xo : XB), nullptr, xo, dry ? (const float*)(ws + WS_CTL + 512 * 1024) : modl + 2 * D, dry ? 0 : MODW};
            pg8::gemm_phase<pg8::EpiRes, pg8::StaticOrder, true, true>(lds + RING_OFF, g, S, E);
        }
        SEAM(base + 3);
        if (IN(base + 4)) for (int rp = 0; rp < REP_NORM; ++rp) { FRESH_TID(); if (rp) xcd_barrier(bar); phase_norm<0, true>((l == DEPTH - 1) ? XB2 : XB, args.in[5] + l * D, modl + 3 * D, modl + 4 * D, A1, nullptr, 0, 0, nullptr, nullptr, nullptr, lds, tid, lane, wave, G); }
        SEAM(base + 4);
        if (IN(base + 5)) for (int rp = 0; rp < REP_GUP; ++rp) { if (rp) xcd_barrier(bar);
            pg8::Gemm g{A1, (const bf16*)(ws + WS_WUP) + (size_t)l * NUP * D, M, NUP, D};
            pg8::StaticOrder S; S.init(M, NUP, G, (int)blockIdx.x);
            pg8::EpiSwiglu E{Z, FFH};
            pg8::gemm_phase<pg8::EpiSwiglu, pg8::StaticOrder, true, true>(lds + RING_OFF, g, S, E);
        }
        SEAM(base + 5);
        if (IN(base + 6)) for (int rp = 0; rp < REP_GDN; ++rp) { if (rp) xcd_barrier(bar);
            pg8::Gemm g{Z, (const bf16*)(ws + WS_WDN) + (size_t)l * D * FFH, M, D, FFH};
            pg8::StaticOrder S; S.init(M, D, G, (int)blockIdx.x);
            const bool dry = (rp + 1 < REP_GDN);
            const bool last = (l == DEPTH - 1);
            pg8::EpiRes E{nullptr, last ? XB2 : XB, (last && !dry) ? args.out : nullptr, (last && !dry) ? nullptr : (last ? XB2 : XB), dry ? (const float*)(ws + WS_CTL + 512 * 1024) : modl + 5 * D, dry ? 0 : MODW};
            pg8::gemm_phase<pg8::EpiRes, pg8::StaticOrder, true, true>(lds + RING_OFF, g, S, E);
        }
        SEAM(base + 6);
    }
    for (int rp = 0; rp < REP_BAR; ++rp) xcd_barrier(bar);
#undef IN
#undef SEAM
}

extern "C" void kernel_launch(void* const* d_in, const int* in_sizes, int n_in, void* d_out, int out_size, void* d_ws, size_t ws_size, hipStream_t stream) {
    static int grid = 0;
    if (grid == 0) {
        if (n_in != 24 || out_size != M * D || ws_size < WS_END) { fprintf(stderr, "kernel_launch: unexpected shapes (n_in %d, out %d, ws %zu); nothing launched\n", n_in, out_size, ws_size); grid = -1; return; }
        int dev = 0, cus = 0, per_cu = 0;
        if (hipGetDevice(&dev) != hipSuccess || hipDeviceGetAttribute(&cus, hipDeviceAttributeMultiprocessorCount, dev) != hipSuccess) { grid = -1; return; }
        if (hipFuncSetAttribute((const void*)fwd_kernel, hipFuncAttributeMaxDynamicSharedMemorySize, LDS_BYTES) != hipSuccess) { fprintf(stderr, "kernel_launch: hipFuncSetAttribute failed\n"); grid = -1; return; }
        if (hipOccupancyMaxActiveBlocksPerMultiprocessor(&per_cu, (const void*)fwd_kernel, NTHREADS, LDS_BYTES) != hipSuccess || per_cu < 1) { fprintf(stderr, "kernel_launch: occupancy query reports %d blocks per CU\n", per_cu); }
        (void)hipGetLastError();
        grid = cus;
    }
    if (grid < 0) return;
    if (hipMemsetAsync((char*)d_ws + WS_CTL, 0, CTL_ZERO_BYTES, stream) != hipSuccess) return;
    Args a{};
    for (int i = 0; i < 24; ++i) a.in[i] = (const float*)d_in[i];
    a.out = (float*)d_out; a.ws = (unsigned char*)d_ws;
#if MK_SINGLE
    a.ph_lo = 0; a.ph_hi = N_PHASES;
    hipLaunchKernelGGL(fwd_kernel, dim3(grid), dim3(NTHREADS), LDS_BYTES, stream, a);
#else
    for (int p = 0; p < N_PHASES; ++p) { a.ph_lo = p; a.ph_hi = p + 1; hipLaunchKernelGGL(fwd_kernel, dim3(grid), dim3(NTHREADS), LDS_BYTES, stream, a); }
#endif
}
```

```cpp
#include <hip/hip_runtime.h>
#include <cstdio>
#include <cstdint>
#include <cmath>
#ifndef MK_SINGLE
#define MK_SINGLE 1
#endif
#ifndef USE_FOX_MFMA
#define USE_FOX_MFMA 1
#endif
#ifndef USE_DA_MFMA
#define USE_DA_MFMA 1
#endif
#ifndef USE_ML_MFMA
#define USE_ML_MFMA 1
#endif
#ifndef REP_NORM
#define REP_NORM 1
#endif
#ifndef REP_GIN
#define REP_GIN 1
#endif
#ifndef REP_MIX_E
#define REP_MIX_E 1
#endif
#ifndef REP_MIX_O
#define REP_MIX_O 1
#endif
#ifndef REP_GOUT
#define REP_GOUT 1
#endif
#ifndef REP_GUP
#define REP_GUP 1
#endif
#ifndef REP_GDN
#define REP_GDN 1
#endif
#ifndef REP_ML
#define REP_ML 1
#endif
#ifndef REP_DA
#define REP_DA 1
#endif
#ifndef REP_PRO
#define REP_PRO 1
#endif
#ifndef REP_BAR
#define REP_BAR 0
#endif
namespace pg8 {
#define PG8_LAS __attribute__((address_space(3)))
typedef unsigned short bf16_t;
typedef short bf16x8 __attribute__((ext_vector_type(8)));
typedef float f32x4 __attribute__((ext_vector_type(4)));
typedef unsigned u32x4 __attribute__((ext_vector_type(4)));
constexpr int BM = 256, BK = 64, HALF = 128, HTB = HALF * BK * 2  , STAGE_BYTES = 8 * HTB, NXCD = 8, WGM = 8;

__host__ __device__ __forceinline__ int lds_byte(int r, int c) { const int st = (r >> 4) * 2 + (c >> 5), rr = r & 15, cc = c & 31, ob = rr * 64 + cc * 2; return st * 1024 + (ob ^ (((ob >> 9) & 1) << 5)); }
__host__ __device__ __forceinline__ void stage_rc(int b, int& R, int& C) { const int st = b / 1024, sb = b % 1024, swz = sb ^ (((sb >> 9) & 1) << 5); R = (st >> 1) * 16 + swz / 64; C = (st & 1) * 32 + (swz % 64) / 2; }
__host__ __device__ __forceinline__ int perm32(int rho) { const int n = rho >> 4, i = rho & 15; return 8 * (i >> 2) + 4 * n + (i & 3); }

struct Unit { int pm, pn; };
struct Gemm { const bf16_t* A; const bf16_t* Bt; int M, N, K; };

struct StaticOrder {
    int nM, nN, nwg, G, c;
    __host__ __device__ void init(int M, int N, int G_, int c_) { nM = M / BM; nN = N / BM; nwg = nM * nN; G = G_; c = c_; }
    __host__ __device__ bool next(int i, Unit& u) const {
        const long L = (long)i * G + c; if (L >= nwg) return false;
        int wgid = (int)L; { const int q = nwg / NXCD, r = nwg % NXCD, xcd = wgid % NXCD, off = wgid / NXCD; wgid = (xcd < r ? xcd * (q + 1) : r * (q + 1) + (xcd - r) * q) + off; }
        const int nig = WGM * nN, gid = wgid / nig, fm = gid * WGM, gsz = (nM - fm) < WGM ? (nM - fm) : WGM;
        u.pm = fm + ((wgid % nig) % gsz); u.pn = (wgid % nig) / gsz; return true;
    }
    __device__ __forceinline__ void a_ready(const Unit&) const {}
    __device__ __forceinline__ void done(const Unit&) const {}
};

__device__ __forceinline__ unsigned cvt_pk_bf16(float lo, float hi) { unsigned r; asm volatile("v_cvt_pk_bf16_f32 %0, %1, %2" : "=v"(r) : "v"(lo), "v"(hi)); return r; }
typedef float f32x2 __attribute__((ext_vector_type(2)));
constexpr int SEQ_ROWS = 4096;
__device__ __forceinline__ float fast_sigmoid(float x) { return __builtin_amdgcn_rcpf(1.0f + __builtin_amdgcn_exp2f(-1.4426950408889634f * x)); }
struct EpiIn {
    static constexpr bool PERM = true, AFTER_DRAIN = false;
    bf16_t* Z; int ldz; int nq_end, nk_end; const float* gq; const float* gk; float qscale;
    __device__ __forceinline__ void operator()(const f32x4 (&acc)[2][2][4][2], const Unit& u, int wr, int wc, int fr, int fq) const {
        const int c0 = u.pn * BM + 64 * wc;
        const int mode = c0 < nq_end ? 1 : (c0 < nk_end ? 2 : 0);
        const int row0 = u.pm * BM + wr * 64 + fr;
        if (mode != 0) {
            const float* gp = (mode == 1 ? gq : gk) + 8 * fq;
            const float sc = (mode == 1) ? qscale : 1.0f;
            f32x4 gv[2][2];
#pragma unroll
            for (int bj = 0; bj < 2; ++bj)
#pragma unroll
                for (int n = 0; n < 2; ++n) gv[bj][n] = *(const f32x4*)(gp + 32 * bj + 4 * n);
#pragma unroll
            for (int ai = 0; ai < 2; ++ai)
#pragma unroll
                for (int m = 0; m < 4; ++m) {
                    float ss = 0.f;
#pragma unroll
                    for (int bj = 0; bj < 2; ++bj)
#pragma unroll
                        for (int n = 0; n < 2; ++n) { const f32x4 x = acc[ai][bj][m][n]; ss += (x[0] * x[0] + x[1] * x[1]) + (x[2] * x[2] + x[3] * x[3]); }
                    ss += __shfl_xor(ss, 16); ss += __shfl_xor(ss, 32);
                    const float r = sc / sqrtf(ss * (1.0f / 64.0f) + 1e-6f);
                    bf16_t* rowp = Z + (size_t)(row0 + ai * HALF + m * 16) * ldz + c0 + 8 * fq;
#pragma unroll
                    for (int bj = 0; bj < 2; ++bj) { const f32x4 v0 = acc[ai][bj][m][0] * r * gv[bj][0], v1 = acc[ai][bj][m][1] * r * gv[bj][1];
                        u32x4 w; w.x = cvt_pk_bf16(v0[0], v0[1]); w.y = cvt_pk_bf16(v0[2], v0[3]); w.z = cvt_pk_bf16(v1[0], v1[1]); w.w = cvt_pk_bf16(v1[2], v1[3]);
                        *(u32x4*)(rowp + 32 * bj) = w; }
                }
        } else {
#pragma unroll
            for (int ai = 0; ai < 2; ++ai)
#pragma unroll
                for (int m = 0; m < 4; ++m) {
                    bf16_t* rowp = Z + (size_t)(row0 + ai * HALF + m * 16) * ldz + c0 + 8 * fq;
#pragma unroll
                    for (int bj = 0; bj < 2; ++bj) { const f32x4 v0 = acc[ai][bj][m][0], v1 = acc[ai][bj][m][1];
                        u32x4 w; w.x = cvt_pk_bf16(v0[0], v0[1]); w.y = cvt_pk_bf16(v0[2], v0[3]); w.z = cvt_pk_bf16(v1[0], v1[1]); w.w = cvt_pk_bf16(v1[2], v1[3]);
                        *(u32x4*)(rowp + 32 * bj) = w; }
                }
        }
    }
};
struct EpiRes {
    static constexpr bool PERM = true, AFTER_DRAIN = false;
    const float* xin; const bf16_t* xin_bf; float* out; bf16_t* out_bf; const float* gate; int gstride;
    __device__ __forceinline__ void operator()(const f32x4 (&acc)[2][2][4][2], const Unit& u, int wr, int wc, int fr, int fq) const {
        const int b = (u.pm * BM) / SEQ_ROWS;
        const int col0 = u.pn * BM + wc * 32 + 8 * fq;
        const float* gb = gate + (size_t)b * gstride + col0;
        f32x4 gv[2][2];
#pragma unroll
        for (int bj = 0; bj < 2; ++bj)
#pragma unroll
            for (int n = 0; n < 2; ++n) gv[bj][n] = *(const f32x4*)(gb + bj * HALF + 4 * n);
        const int row0 = u.pm * BM + wr * 64 + fr;
#pragma unroll
        for (int ai = 0; ai < 2; ++ai) {
            u32x4 xb[4][2];
            if (xin_bf) {
#pragma unroll
                for (int m = 0; m < 4; ++m) { const size_t off = (size_t)(row0 + ai * HALF + m * 16) * 1024 + col0;
#pragma unroll
                    for (int bj = 0; bj < 2; ++bj) xb[m][bj] = *(const u32x4*)(xin_bf + off + bj * HALF); } }
#pragma unroll
            for (int m = 0; m < 4; ++m) { const size_t off = (size_t)(row0 + ai * HALF + m * 16) * 1024 + col0;
#pragma unroll
                for (int bj = 0; bj < 2; ++bj) {
                    f32x4 x0, x1;
                    if (xin_bf) { const u32x4 w = xb[m][bj];
                        x0 = (f32x4){__builtin_bit_cast(float, w.x << 16), __builtin_bit_cast(float, w.x & 0xffff0000u), __builtin_bit_cast(float, w.y << 16), __builtin_bit_cast(float, w.y & 0xffff0000u)};
                        x1 = (f32x4){__builtin_bit_cast(float, w.z << 16), __builtin_bit_cast(float, w.z & 0xffff0000u), __builtin_bit_cast(float, w.w << 16), __builtin_bit_cast(float, w.w & 0xffff0000u)}; }
                    else { x0 = *(const f32x4*)(xin + off + bj * HALF); x1 = *(const f32x4*)(xin + off + bj * HALF + 4); }
                    const f32x4 v0 = x0 + gv[bj][0] * acc[ai][bj][m][0], v1 = x1 + gv[bj][1] * acc[ai][bj][m][1];
                    if (out_bf) { u32x4 w; w.x = cvt_pk_bf16(v0[0], v0[1]); w.y = cvt_pk_bf16(v0[2], v0[3]); w.z = cvt_pk_bf16(v1[0], v1[1]); w.w = cvt_pk_bf16(v1[2], v1[3]); *(u32x4*)(out_bf + off + bj * HALF) = w; }
                    else { *(f32x4*)(out + off + bj * HALF) = v0; *(f32x4*)(out + off + bj * HALF + 4) = v1; }
                } }
            asm volatile("" ::: "memory"); }
    }
};
struct EpiSwiglu {
    static constexpr bool PERM = true, AFTER_DRAIN = false;
    bf16_t* H; int ldh;
    __device__ __forceinline__ void operator()(const f32x4 (&acc)[2][2][4][2], const Unit& u, int wr, int wc, int fr, int fq) const {
        const int row0 = u.pm * BM + wr * 64 + fr, col0 = u.pn * HALF + wc * 32 + 8 * fq;
#pragma unroll
        for (int ai = 0; ai < 2; ++ai)
#pragma unroll
            for (int m = 0; m < 4; ++m) {
                f32x4 v[2];
#pragma unroll
                for (int n = 0; n < 2; ++n) { const f32x4 a = acc[ai][0][m][n], g = acc[ai][1][m][n];
#pragma unroll
                    for (int i = 0; i < 4; ++i) v[n][i] = a[i] * fast_sigmoid(a[i]) * g[i]; }
                u32x4 w; w.x = cvt_pk_bf16(v[0][0], v[0][1]); w.y = cvt_pk_bf16(v[0][2], v[0][3]); w.z = cvt_pk_bf16(v[1][0], v[1][1]); w.w = cvt_pk_bf16(v[1][2], v[1][3]);
                *(u32x4*)(H + (size_t)(row0 + ai * HALF + m * 16) * ldh + col0) = w;
            }
    }
};
template <class Epi, class Sched, bool ALIGN_EPI = false, bool SP2 = false>
__device__ __forceinline__ void gemm_phase(PG8_LAS unsigned char* lds, const Gemm g, const Sched& S, const Epi& E) {
    int tid = threadIdx.x; asm volatile("" : "+v"(tid));
    const int wid = __builtin_amdgcn_readfirstlane(tid >> 6), lane = tid & 63, wr = wid >> 2, wc = wid & 3, fr = lane & 15, fq = lane >> 4;
    const int K = g.K, nt = K / BK;
    unsigned voffA[2], voffB[2];
#pragma unroll
    for (int i = 0; i < 2; ++i) { int R, C; stage_rc(tid * 16 + i * 8192, R, C); const int Rb = Epi::PERM ? ((R & ~31) + perm32(R & 31)) : R;
        voffA[i] = (unsigned)(R * K + C) * 2u; voffB[i] = (unsigned)(Rb * K + C) * 2u; }
    const size_t kstep = (size_t)(BK * 2);
    const size_t hstep = (size_t)HALF * K * 2;
    const size_t tstep = 2 * hstep;
    const unsigned ldsw = (unsigned)wid * 1024u;
    const int aoff = lds_byte(wr * 64 + fr, fq * 8), boff = lds_byte(wc * 32 + fr, fq * 8);
#define PG8_SA(b, h) (((b) * 2 + (h)) * HTB)
#define PG8_SB(b, h) ((4 + (b) * 2 + (h)) * HTB)
#define PG8_STAGE(bufoff, gbase, voff) do { _Pragma("unroll") for (int _i = 0; _i < 2; ++_i) \
        __builtin_amdgcn_global_load_lds((const unsigned*)((const char*)(gbase) + (voff)[_i]), (PG8_LAS unsigned*)(lds + (bufoff) + ldsw + _i * 8192), 16, 0, 0); } while (0)
#define PG8_LDA(dst, b, h) do { _Pragma("unroll") for (int m = 0; m < 4; ++m) _Pragma("unroll") for (int k = 0; k < 2; ++k) dst[m][k] = *(const PG8_LAS bf16x8*)(lds + PG8_SA(b, h) + aoff + m * 2048 + k * 1024); } while (0)
#define PG8_LDB(dst, b, h) do { _Pragma("unroll") for (int n = 0; n < 2; ++n) _Pragma("unroll") for (int k = 0; k < 2; ++k) dst[n][k] = *(const PG8_LAS bf16x8*)(lds + PG8_SB(b, h) + boff + n * 2048 + k * 1024); } while (0)
#define PG8_MMA(ai, bj, At, Bt) do { __builtin_amdgcn_s_setprio(1); _Pragma("unroll") for (int m = 0; m < 4; ++m) _Pragma("unroll") for (int n = 0; n < 2; ++n) _Pragma("unroll") for (int k = 0; k < 2; ++k) \
        acc[ai][bj][m][n] = __builtin_amdgcn_mfma_f32_16x16x32_bf16(Bt[n][k], At[m][k], acc[ai][bj][m][n], 0, 0, 0); __builtin_amdgcn_s_setprio(0); } while (0)
#define PG8_WAIT_V(n) asm volatile("s_waitcnt vmcnt(" #n ")" ::: "memory")
#define PG8_WAIT_L(n) asm volatile("s_waitcnt lgkmcnt(" #n ")" ::: "memory")
#define PG8_BAR __builtin_amdgcn_s_barrier()
#define PG8_SCHED __builtin_amdgcn_sched_barrier(0)
    Unit cur, nxt; int ui = 0;
    if (!S.next(0, cur)) return;
    f32x4 acc[2][2][4][2];
#pragma unroll
    for (int a = 0; a < 2; ++a)
#pragma unroll
        for (int b = 0; b < 2; ++b)
#pragma unroll
            for (int m = 0; m < 4; ++m)
#pragma unroll
                for (int n = 0; n < 2; ++n) acc[a][b][m][n] = (f32x4){0.f, 0.f, 0.f, 0.f};
    bf16x8 At[4][2], B0[2][2], B1[2][2];
    const char* cA = (const char*)g.A + (size_t)cur.pm * tstep; const char* cB = (const char*)g.Bt + (size_t)cur.pn * tstep;
    S.a_ready(cur);
    if constexpr (SP2) {
        PG8_STAGE(PG8_SB(0, 0), cB, voffB); PG8_STAGE(PG8_SB(0, 1), cB + hstep, voffB); PG8_STAGE(PG8_SA(0, 0), cA, voffA); PG8_STAGE(PG8_SA(0, 1), cA + hstep, voffA);
        if (wr == 1) PG8_BAR;
        PG8_WAIT_V(2); PG8_BAR;
        PG8_STAGE(PG8_SB(1, 0), cB + kstep, voffB); PG8_STAGE(PG8_SA(1, 0), cA + kstep, voffA); PG8_STAGE(PG8_SB(1, 1), cB + hstep + kstep, voffB);
        PG8_WAIT_V(6); PG8_BAR;
    } else {
        PG8_STAGE(PG8_SB(0, 0), cB, voffB); PG8_STAGE(PG8_SA(0, 0), cA, voffA); PG8_STAGE(PG8_SB(0, 1), cB + hstep, voffB); PG8_STAGE(PG8_SA(0, 1), cA + hstep, voffA);
        if (wr == 1) PG8_BAR;
        PG8_WAIT_V(4); PG8_BAR;
        PG8_STAGE(PG8_SB(1, 0), cB + kstep, voffB); PG8_STAGE(PG8_SA(1, 0), cA + kstep, voffA); PG8_STAGE(PG8_SB(1, 1), cB + hstep + kstep, voffB);
        PG8_WAIT_V(6); PG8_BAR;
    }
    for (;;) {
        const bool has_next = S.next(ui + 1, nxt);
        const char* nA = has_next ? (const char*)g.A + (size_t)nxt.pm * tstep : cA; const char* nB = has_next ? (const char*)g.Bt + (size_t)nxt.pn * tstep : cB;
        for (int t = 0; t < nt; t += 2) {
            const bool last = (t == nt - 2);
            const char* a1 = cA + (size_t)(t + 1) * kstep;
            const char* a2 = last ? nA : cA + (size_t)(t + 2) * kstep; const char* b2 = last ? nB : cB + (size_t)(t + 2) * kstep;
            const char* a3 = a2 + kstep; const char* b3 = b2 + kstep;
            if (last && has_next) S.a_ready(nxt);
            if constexpr (SP2) {
            PG8_LDB(B0, 0, 0); PG8_LDB(B1, 0, 1); PG8_SCHED; PG8_LDA(At, 0, 0); PG8_STAGE(PG8_SA(1, 1), a1 + hstep, voffA);
            PG8_WAIT_V(8); PG8_WAIT_L(0); PG8_BAR; PG8_MMA(0, 0, At, B0); PG8_MMA(0, 1, At, B1); PG8_BAR; PG8_SCHED;
            PG8_LDA(At, 0, 1); PG8_STAGE(PG8_SB(0, 0), b2, voffB); PG8_STAGE(PG8_SB(0, 1), b2 + hstep, voffB); PG8_STAGE(PG8_SA(0, 0), a2, voffA);
            PG8_WAIT_V(8); PG8_WAIT_L(0); PG8_BAR; PG8_MMA(1, 0, At, B0); PG8_MMA(1, 1, At, B1); PG8_BAR; PG8_SCHED;
            PG8_LDB(B0, 1, 0); PG8_LDB(B1, 1, 1); PG8_SCHED; PG8_LDA(At, 1, 0); PG8_STAGE(PG8_SA(0, 1), a2 + hstep, voffA);
            PG8_WAIT_V(8); PG8_WAIT_L(0); PG8_BAR; PG8_MMA(0, 0, At, B0); PG8_MMA(0, 1, At, B1); PG8_BAR; PG8_SCHED;
            PG8_LDA(At, 1, 1); PG8_STAGE(PG8_SB(1, 0), b3, voffB); PG8_STAGE(PG8_SB(1, 1), b3 + hstep, voffB); PG8_STAGE(PG8_SA(1, 0), a3, voffA);
            PG8_WAIT_V(8); PG8_WAIT_L(0); PG8_BAR; PG8_MMA(1, 0, At, B0); PG8_MMA(1, 1, At, B1); PG8_BAR; PG8_SCHED;
            } else {
            PG8_LDB(B0, 0, 0); PG8_SCHED; PG8_LDA(At, 0, 0); PG8_STAGE(PG8_SA(1, 1), a1 + hstep, voffA);
            PG8_WAIT_L(8); PG8_BAR; PG8_WAIT_L(0); PG8_MMA(0, 0, At, B0); PG8_BAR; PG8_SCHED;
            PG8_LDB(B1, 0, 1); PG8_STAGE(PG8_SB(0, 0), b2, voffB);
            PG8_BAR; PG8_WAIT_L(0); PG8_MMA(0, 1, At, B1); PG8_BAR;
            PG8_LDA(At, 0, 1); PG8_STAGE(PG8_SA(0, 0), a2, voffA);
            PG8_BAR; PG8_WAIT_L(0); PG8_MMA(1, 0, At, B0); PG8_BAR; PG8_SCHED;
            PG8_STAGE(PG8_SB(0, 1), b2 + hstep, voffB);
            PG8_WAIT_V(6); PG8_BAR; PG8_MMA(1, 1, At, B1); PG8_BAR;
            PG8_LDB(B0, 1, 0); PG8_SCHED; PG8_LDA(At, 1, 0); PG8_STAGE(PG8_SA(0, 1), a2 + hstep, voffA);
            PG8_WAIT_L(8); PG8_BAR; PG8_WAIT_L(0); PG8_MMA(0, 0, At, B0); PG8_BAR; PG8_SCHED;
            PG8_LDB(B1, 1, 1); PG8_STAGE(PG8_SB(1, 0), b3, voffB);
            PG8_BAR; PG8_WAIT_L(0); PG8_MMA(0, 1, At, B1); PG8_BAR;
            PG8_LDA(At, 1, 1); PG8_STAGE(PG8_SA(1, 0), a3, voffA);
            PG8_BAR; PG8_WAIT_L(0); PG8_MMA(1, 0, At, B0); PG8_BAR; PG8_SCHED;
            PG8_STAGE(PG8_SB(1, 1), b3 + hstep, voffB);
            PG8_WAIT_V(6); PG8_BAR; PG8_MMA(1, 1, At, B1); PG8_BAR;
            }
        }
        if constexpr (ALIGN_EPI) { if (wr == 0) PG8_BAR; }
        if constexpr (!Epi::AFTER_DRAIN) { E(acc, cur, wr, wc, fr, fq); S.done(cur); }
        if (!has_next) break;
#pragma unroll
        for (int a = 0; a < 2; ++a)
#pragma unroll
            for (int b = 0; b < 2; ++b)
#pragma unroll
                for (int m = 0; m < 4; ++m)
#pragma unroll
                    for (int n = 0; n < 2; ++n) acc[a][b][m][n] = (f32x4){0.f, 0.f, 0.f, 0.f};
        cur = nxt; cA = nA; cB = nB; ++ui;
        if constexpr (ALIGN_EPI) { if (wr == 1) PG8_BAR; }
    }
    PG8_WAIT_V(0);
    if constexpr (!ALIGN_EPI) { if (wr == 0) PG8_BAR; }
    PG8_BAR;
    if constexpr (Epi::AFTER_DRAIN) { E.fused(acc, cur, wr, wc, fr, fq, lds, wid, lane); S.done(cur); }
#undef PG8_SA
#undef PG8_SB
#undef PG8_STAGE
#undef PG8_LDA
#undef PG8_LDB
#undef PG8_MMA
#undef PG8_WAIT_V
#undef PG8_WAIT_L
#undef PG8_BAR
#undef PG8_SCHED
}
}
#include <type_traits>
constexpr int NWAVES = 8, NTHREADS = NWAVES * 64;
constexpr int D = 1024, BATCH = 8, SEQ = 4096, DEPTH = 4, M = BATCH * SEQ;
constexpr int FFH = 2816, NUP = 2 * FFH;
constexpr int AB_LD = 3592, AB_N = 3584;
constexpr int FX_LD = 3088, FX_N = 3072;
constexpr int MODW = 6 * D;
constexpr float EPS = 1e-6f, LOG2E = 1.4426950408889634f;
static_assert(pg8::SEQ_ROWS == SEQ, "row -> batch");

constexpr size_t MiB = 1u << 20;
constexpr size_t WS_CTL = 0, CTL_ZERO_BYTES = 1 * MiB;
constexpr size_t WS_MOD = 1 * MiB;
constexpr size_t WS_GATE = 2 * MiB;
constexpr size_t WS_WIN_E = 4 * MiB;
constexpr size_t WS_WIN_O = 18 * MiB;
constexpr size_t WS_WOUT = 30 * MiB;
constexpr size_t WS_WUP = 38 * MiB;
constexpr size_t WS_WDN = 82 * MiB;
constexpr size_t WS_A1 = 104 * MiB;
constexpr size_t WS_Z = 168 * MiB;
constexpr size_t WS_XB2 = 344 * MiB;
constexpr size_t WS_QKC = 392 * MiB;
constexpr size_t WS_END = 456 * MiB;
constexpr int CW_BAR = 4096;
constexpr int CW_QUEUE = 16384;

constexpr int RING_OFF = 0, RING_BYTES = 131072;
constexpr int LDSCTL_OFF = RING_BYTES, MISC_OFF = LDSCTL_OFF + 320;
constexpr int LDS_BYTES = 147456;

#define GAS __attribute__((address_space(1)))
#define LAS __attribute__((address_space(3)))
typedef unsigned short bf16;
typedef unsigned v4u __attribute__((ext_vector_type(4)));
typedef float f32x4 __attribute__((ext_vector_type(4)));
typedef short bf16x8 __attribute__((ext_vector_type(8)));
typedef GAS unsigned gu32;
typedef GAS unsigned long long gu64;
#define RLX_AGENT __ATOMIC_RELAXED, __HIP_MEMORY_SCOPE_AGENT
#define LDS_WAIT() asm volatile("s_waitcnt lgkmcnt(0)" ::: "memory")
#define VM_WAIT() asm volatile("s_waitcnt vmcnt(0)" ::: "memory")
__device__ __forceinline__ unsigned long long rt() { return __builtin_amdgcn_s_memrealtime(); }
__device__ __forceinline__ unsigned f2bf(float f) { unsigned u = __builtin_bit_cast(unsigned, f); return (u + 0x7fffu + ((u >> 16) & 1u)) >> 16; }
__device__ __forceinline__ unsigned pk2(float lo, float hi) { return f2bf(lo) | (f2bf(hi) << 16); }

#define XB_TMO      128
#define XB_XCNT(j)  (256  + 64 * (j))
#define XB_XSUB(j)  (1280 + 64 * (j))
#define XB_XGEN(j)  (2304 + 64 * (j))
#define XB_TOP      3328
#define XB_TOPGEN   3392
#define XCD_BAR_WORDS 3456
#define XB_SPIN_CAP (1u << 24)

__device__ __forceinline__ unsigned xb_ld(unsigned* p)              { return __hip_atomic_load(p, __ATOMIC_RELAXED, __HIP_MEMORY_SCOPE_AGENT); }
__device__ __forceinline__ unsigned xb_add(unsigned* p, unsigned v) { return __hip_atomic_fetch_add(p, v, __ATOMIC_RELAXED, __HIP_MEMORY_SCOPE_AGENT); }
__device__ __forceinline__ unsigned xb_xcc_id() { return (unsigned)__builtin_amdgcn_s_getreg((3 << 11) | 20) & 0xFu; }
#define XB_SPIN(cond, bar) do { unsigned _sp = 0; while (cond) { __builtin_amdgcn_s_sleep(1); \
    if ((++_sp & 255u) == 0u) { if (xb_ld(&(bar)[XB_TMO])) break; if (_sp > XB_SPIN_CAP) { atomicAdd(&(bar)[XB_TMO], 1u); break; } } } } while (0)

struct XcdBarrier {
    unsigned* bar; unsigned x;
    volatile LAS unsigned* st;
};

__device__ __forceinline__ XcdBarrier xcd_barrier_post(unsigned* bar, volatile LAS unsigned* st) {
    XcdBarrier b; b.bar = bar; b.x = xb_xcc_id(); b.st = st;
    if (threadIdx.x == 0) (void)xb_add(&bar[XB_XCNT(b.x)], 1u);
    return b;
}
__device__ __forceinline__ void xcd_barrier_complete(unsigned* bar, unsigned x, unsigned& nloc, unsigned& nx) {
    const unsigned G = gridDim.x * gridDim.y * gridDim.z;
    unsigned sum, cnt, mine, sp = 0u;
    for (;;) {
        sum = 0u; cnt = 0u; mine = 0u;
#pragma unroll
        for (unsigned j = 0; j < 16; ++j) { const unsigned c = xb_ld(&bar[XB_XCNT(j)]); sum += c; cnt += (c > 0u) ? 1u : 0u; mine = (j == x) ? c : mine; }
        if (sum == G) break;
        __builtin_amdgcn_s_sleep(1);
        if ((++sp & 255u) == 0u) { if (xb_ld(&bar[XB_TMO])) break; if (sp > XB_SPIN_CAP) { atomicAdd(&bar[XB_TMO], 1u); break; } }
    }
    nloc = mine > 0u ? mine : 1u; nx = cnt > 0u ? cnt : 1u;
}

__device__ __forceinline__ void xcd_barrier(const XcdBarrier& b) {
    asm volatile("s_waitcnt vmcnt(0)" ::: "memory");
    __syncthreads();
    if (threadIdx.x == 0) {
        unsigned* bar = b.bar;
        __builtin_amdgcn_s_waitcnt(0);
        unsigned nloc = b.st[0], nx = b.st[1];
        if (nloc == 0u) { xcd_barrier_complete(bar, b.x, nloc, nx); b.st[0] = nloc; b.st[1] = nx; }
        const unsigned old = xb_add(&bar[XB_XSUB(b.x)], 1u);
        const unsigned gen = old / nloc;
        if (old + 1u == (gen + 1u) * nloc) {
            __builtin_amdgcn_fence(__ATOMIC_RELEASE, "agent");
            asm volatile("s_waitcnt vmcnt(0)" ::: "memory");
            const unsigned og = xb_add(&bar[XB_TOP], 1u);
            const unsigned tg = og / nx;
            if (og + 1u == (tg + 1u) * nx) xb_add(&bar[XB_TOPGEN], 1u);
            else XB_SPIN(xb_ld(&bar[XB_TOPGEN]) == tg, bar);
            __builtin_amdgcn_fence(__ATOMIC_ACQUIRE, "agent");
            xb_add(&bar[XB_XGEN(b.x)], 1u);
            asm volatile("s_waitcnt vmcnt(0)" ::: "memory");
        } else {
            XB_SPIN(xb_ld(&bar[XB_XGEN(b.x)]) == gen, bar);
            __builtin_amdgcn_fence(__ATOMIC_ACQUIRE, "agent");
            asm volatile("s_waitcnt vmcnt(0)" ::: "memory");
        }
    }
    __syncthreads();
}

__device__ __forceinline__ float bf_lo(unsigned u) { return __builtin_bit_cast(float, u << 16); }
__device__ __forceinline__ float bf_hi(unsigned u) { return __builtin_bit_cast(float, u & 0xffff0000u); }
__device__ __forceinline__ float bf1(bf16 u) { return __builtin_bit_cast(float, (unsigned)u << 16); }
__device__ __forceinline__ float ex2(float x) { return __builtin_amdgcn_exp2f(x); }
__device__ __forceinline__ float wave_sum(float v) {
#pragma unroll
    for (int o = 1; o < 64; o <<= 1) v += __shfl_xor(v, o);
    return v;
}
__device__ __forceinline__ float fast_sig(float x) { return __builtin_amdgcn_rcpf(1.0f + __builtin_amdgcn_exp2f(-1.4426950408889634f * x)); }
__device__ __forceinline__ float log_sigmoid(float x) { return fminf(x, 0.f) - log1pf(__expf(-fabsf(x))); }

struct Args { const float* in[24]; float* out; unsigned char* ws; int ph_lo, ph_hi; };

typedef short s16x4 __attribute__((ext_vector_type(4)));
__device__ __forceinline__ s16x4 ds_tr16(unsigned addr) { return __builtin_bit_cast(s16x4, __builtin_amdgcn_ds_read_tr16_b64_v4i16((LAS s16x4*)(uintptr_t)addr)); }
typedef float f32x2_t __attribute__((ext_vector_type(2))); typedef __bf16 bf16x2_t __attribute__((ext_vector_type(2)));
__device__ __forceinline__ unsigned cvtpk(float lo, float hi) { const f32x2_t v = {lo, hi}; return __builtin_bit_cast(unsigned, __builtin_convertvector(v, bf16x2_t)); }

constexpr int CV_TS = 528;
__device__ __forceinline__ int cv_dst_row(int map, int n) {
    if (map == 1) { const int q = (n >> 5) & 7; return (n & ~255) + ((q & 1) * 4 + (q >> 1)) * 32 + (n & 31); }
    if (map >= 2) return (n >> 7) * 256 + (map - 2) * 128 + (n & 127);
    return n; }
struct CvTile { const float* W; bf16* WT; int ld, Kd, k0, n0, map; };
__device__ __forceinline__ CvTile cv_decode(const Args& a, unsigned char* ws, int t) {
    constexpr int T_E = 16 * (AB_N / 256), T_O = 16 * (FX_N / 256), T_OUT = 16 * 4, T_UP = 16 * (FFH / 256), T_DN = (FFH / 64) * 4;
    CvTile c;
    if (t < 2 * T_E) { const int j = t / T_E, r = t % T_E, nb = AB_N / 256; c = {a.in[6] + (size_t)j * D * AB_LD, (bf16*)(ws + WS_WIN_E) + (size_t)j * AB_N * D, AB_LD, D, 64 * (r / nb), 256 * (r % nb), 1}; return c; }
    t -= 2 * T_E;
    if (t < 2 * T_O) { const int j = t / T_O, r = t % T_O, nb = FX_N / 256; c = {a.in[16] + (size_t)j * D * FX_LD, (bf16*)(ws + WS_WIN_O) + (size_t)j * FX_N * D, FX_LD, D, 64 * (r / nb), 256 * (r % nb), 1}; return c; }
    t -= 2 * T_O;
    if (t < 4 * T_OUT) { const int l = t / T_OUT, r = t % T_OUT; c = {((l & 1) ? a.in[20] : a.in[15]) + (size_t)(l >> 1) * D * D, (bf16*)(ws + WS_WOUT) + (size_t)l * D * D, D, D, 64 * (r / 4), 256 * (r % 4), 0}; return c; }
    t -= 4 * T_OUT;
    if (t < 8 * T_UP) { const int lw = t / T_UP, r = t % T_UP, l = lw >> 1, w3 = lw & 1, nb = FFH / 256; c = {(w3 ? a.in[22] : a.in[21]) + (size_t)l * D * FFH, (bf16*)(ws + WS_WUP) + (size_t)l * NUP * D, FFH, D, 64 * (r / nb), 256 * (r % nb), 2 + w3}; return c; }
    t -= 8 * T_UP;
    { const int l = t / T_DN, r = t % T_DN; c = {a.in[23] + (size_t)l * FFH * D, (bf16*)(ws + WS_WDN) + (size_t)l * D * FFH, D, FFH, 64 * (r / 4), 256 * (r % 4), 0}; return c; }
}
constexpr int CV_TILES = 2 * 16 * (AB_N / 256) + 2 * 16 * (FX_N / 256) + 4 * 64 + 8 * 16 * (FFH / 256) + 4 * (FFH / 64) * 4;

__device__ __forceinline__ void phase_prologue(const Args& a, LAS unsigned char* lds, int tid, int lane, int wave, int G) {
    unsigned char* ws = a.ws;
    {
        const unsigned lds0 = (unsigned)(uintptr_t)lds;
        const int lr = tid >> 6, lc = tid & 63;
        const int c15 = lane & 15, kq = lane >> 4;
        f32x4 v[8];
        int t = blockIdx.x;
        CvTile cur = cv_decode(a, ws, t < CV_TILES ? t : 0);
        if (t < CV_TILES) {
#pragma unroll
            for (int i = 0; i < 8; ++i) v[i] = *(const f32x4*)(cur.W + (size_t)(cur.k0 + lr + 8 * i) * cur.ld + cur.n0 + 4 * lc); }
        for (; t < CV_TILES; t += G) {
#pragma unroll
            for (int i = 0; i < 8; ++i) *(LAS unsigned long long*)(uintptr_t)(lds0 + (lr + 8 * i) * CV_TS + 8 * lc) = (unsigned long long)cvtpk(v[i].x, v[i].y) | ((unsigned long long)cvtpk(v[i].z, v[i].w) << 32);
            const CvTile nxt = cv_decode(a, ws, t + G < CV_TILES ? t + G : 0);
            if (t + G < CV_TILES) {
#pragma unroll
                for (int i = 0; i < 8; ++i) v[i] = *(const f32x4*)(nxt.W + (size_t)(nxt.k0 + lr + 8 * i) * nxt.ld + nxt.n0 + 4 * lc); }
            __syncthreads();
#pragma unroll
            for (int j = 0; j < 2; ++j) { const int nb = 2 * wave + j, n = cur.n0 + 16 * nb + c15;
                bf16* drow = cur.WT + (size_t)cv_dst_row(cur.map, n) * cur.Kd + cur.k0 + 8 * kq;
#pragma unroll
                for (int ks = 0; ks < 2; ++ks) { const unsigned ad = lds0 + (32 * ks + 8 * kq + ((lane & 15) >> 2)) * CV_TS + (16 * nb + 4 * (lane & 3)) * 2;
                    const s16x4 lo = ds_tr16(ad), hh = ds_tr16(ad + 4 * CV_TS);
                    v4u w; w.x = (unsigned)(unsigned short)lo[0] | ((unsigned)(unsigned short)lo[1] << 16); w.y = (unsigned)(unsigned short)lo[2] | ((unsigned)(unsigned short)lo[3] << 16);
                    w.z = (unsigned)(unsigned short)hh[0] | ((unsigned)(unsigned short)hh[1] << 16); w.w = (unsigned)(unsigned short)hh[2] | ((unsigned)(unsigned short)hh[3] << 16);
                    *(GAS v4u*)(drow + 32 * ks) = w; } }
            __syncthreads();
            cur = nxt;
        }
    }
    __syncthreads();
    {
        LAS float* cact = (LAS float*)lds;
        LAS float* red = (LAS float*)(lds + 32768);
        const float* c = a.in[1];
        for (int i = tid; i < BATCH * D; i += NTHREADS) { const float v = c[i]; cact[i] = v / (1.0f + __expf(-v)); }
        __syncthreads();
        float* mod = (float*)(ws + WS_MOD);
        for (int it = blockIdx.x; it < DEPTH * (MODW / 64); it += G) {
            const int l = it / (MODW / 64), cg = it % (MODW / 64);
            const float* wp = a.in[2] + ((size_t)l * D + 128 * wave) * MODW + 64 * cg + lane;
            float acc[BATCH];
#pragma unroll
            for (int b = 0; b < BATCH; ++b) acc[b] = 0.f;
#pragma unroll 8
            for (int kk = 0; kk < 128; ++kk) { const float wv = wp[(size_t)kk * MODW];
#pragma unroll
                for (int b = 0; b < BATCH; ++b) acc[b] += cact[b * D + 128 * wave + kk] * wv; }
#pragma unroll
            for (int b = 0; b < BATCH; ++b) red[(wave * BATCH + b) * 64 + lane] = acc[b];
            __syncthreads();
            { const int b = tid >> 6; float s = 0.f;
#pragma unroll
                for (int w = 0; w < NWAVES; ++w) s += red[(w * BATCH + b) * 64 + lane];
                mod[((size_t)l * BATCH + b) * MODW + 64 * cg + lane] = s + a.in[3][(size_t)l * MODW + 64 * cg + lane]; }
            __syncthreads();
        }
    }
}

template <int NG, bool XBF>
__device__ __forceinline__ void phase_norm(const void* xin_v, const float* gain, const float* shift, const float* scale  , bf16* hout,
                                           const float* Wg, int ldw, int gcol0, const float* bias_a, const float* bias_b, float* gate_out,
                                           LAS unsigned char* lds, int tid, int lane, int wave, int G) {
    LAS float* wgt = (LAS float*)lds;
    if constexpr (NG > 0) {
        for (int i = tid; i < NG * D; i += NTHREADS) { const int k = i / NG, g = i % NG; wgt[g * D + k] = Wg[(size_t)k * ldw + gcol0 + g]; }
        __syncthreads();
    }
    const int gw = blockIdx.x * NWAVES + wave, NGW = G * NWAVES;
    for (int item = gw; item < M / 16; item += NGW) {
        const int row0 = item * 16, b = row0 / SEQ;
        f32x4 A[4], S[4];
#pragma unroll
        for (int j = 0; j < 4; ++j) { const int c = 4 * lane + 256 * j;
            const f32x4 g4 = *(const f32x4*)(gain + c), sc4 = *(const f32x4*)(scale + (size_t)b * MODW + c);
            A[j] = g4 * (sc4 + 1.0f); S[j] = *(const f32x4*)(shift + (size_t)b * MODW + c); }
        for (int r = 0; r < 16; ++r) {
            asm volatile("" ::: "memory");
            const int row = row0 + r;
            f32x4 v[4]; float ss = 0.f;
            if constexpr (XBF) { const GAS unsigned long long* xr = (const GAS unsigned long long*)((const bf16*)xin_v + (size_t)row * D) + lane;
#pragma unroll
                for (int j = 0; j < 4; ++j) { const unsigned long long w = xr[64 * j]; const unsigned lo = (unsigned)w, hh = (unsigned)(w >> 32); v[j] = (f32x4){bf_lo(lo), bf_hi(lo), bf_lo(hh), bf_hi(hh)}; } }
            else { const GAS f32x4* xr = (const GAS f32x4*)((const float*)xin_v + (size_t)row * D) + lane;
#pragma unroll
                for (int j = 0; j < 4; ++j) v[j] = xr[64 * j]; }
#pragma unroll
            for (int j = 0; j < 4; ++j) ss += (v[j].x * v[j].x + v[j].y * v[j].y) + (v[j].z * v[j].z + v[j].w * v[j].w);
            const float rinv = 1.0f / sqrtf(wave_sum(ss) * (1.0f / D) + EPS);
#pragma unroll
            for (int j = 0; j < 4; ++j) v[j] = v[j] * rinv * A[j] + S[j];
            GAS unsigned long long* o8 = (GAS unsigned long long*)(hout + (size_t)row * D) + lane;
#pragma unroll
            for (int j = 0; j < 4; ++j) o8[64 * j] = (unsigned long long)pk2(v[j].x, v[j].y) | ((unsigned long long)pk2(v[j].z, v[j].w) << 32);
            if constexpr (NG > 0) {
                float p[NG];
#pragma unroll
                for (int g = 0; g < NG; ++g) { float s = 0.f;
#pragma unroll
                    for (int j = 0; j < 4; ++j) { const f32x4 w4 = *(const LAS f32x4*)(wgt + g * D + 4 * lane + 256 * j); s += (v[j].x * w4.x + v[j].y * w4.y) + (v[j].z * w4.z + v[j].w * w4.w); }
                    p[g] = s; }
#define HALVE(NV, OFF) do { const bool up = (lane & (OFF)) != 0; _Pragma("unroll") for (int i = 0; i < (NV); ++i) { const float keep = up ? p[i + (NV)] : p[i], send = up ? p[i] : p[i + (NV)]; p[i] = keep + __shfl_xor(send, (OFF)); } } while (0)
                if constexpr (NG == 16) { HALVE(8, 32); HALVE(4, 16); HALVE(2, 8); HALVE(1, 4); } else { HALVE(4, 32); HALVE(2, 16); HALVE(1, 8); }
#undef HALVE
                float val = p[0];
                constexpr int REM = (NG == 16) ? 2 : 4;
#pragma unroll
                for (int off = REM; off >= 1; off >>= 1) val += __shfl_xor(val, off);
                const int t = row % SEQ;
                if constexpr (NG == 16) { if ((lane & 3) == 0) { const int g = lane >> 2; gate_out[((size_t)b * 16 + g) * SEQ + t] = log_sigmoid(val + bias_b[g]); } }
                else { if ((lane & 7) == 0) { const int g = lane >> 3;
                        if (g < 4) gate_out[((size_t)b * 4 + g) * SEQ + t] = val + bias_a[g];
                        else gate_out[(size_t)BATCH * 4 * SEQ + ((size_t)b * 4 + (g - 4)) * SEQ + t] = log_sigmoid(val + bias_b[g - 4]); } }
            }
        }
    }
}

__device__ __forceinline__ int queue_next(gu32* head, volatile LAS unsigned* MISC, int tid) {
    __syncthreads();
    if (tid == 0) MISC[0] = __hip_atomic_fetch_add(head, 1u, RLX_AGENT);
    __syncthreads();
    return (int)MISC[0];
}

__device__ __forceinline__ void fox_naive_unit(int b, int h, int qb, const bf16* z, const float* lf, bf16* y, LAS unsigned char* lds, int tid, int lane, int wave) {
    LAS float* F = (LAS float*)lds;
    if (wave == 0) { const int seg = 8 * (qb + 1); const float* p = lf + ((size_t)b * 16 + h) * SEQ + lane * seg; float s = 0.f;
        for (int i = 0; i < seg; ++i) s += p[i];
        float inc = s;
#pragma unroll
        for (int off = 1; off < 64; off <<= 1) { const float t = __shfl_up(inc, off); if (lane >= off) inc += t; }
        float run = inc - s;
        for (int i = 0; i < seg; ++i) { run += p[i]; F[lane * seg + i] = run * LOG2E; } }
    __syncthreads();
    const int t = qb * 512 + tid; const size_t rowbase = (size_t)b * SEQ;
    float q[64];
    { const v4u* qp = (const v4u*)(z + (rowbase + t) * FX_N + h * 64);
#pragma unroll
        for (int c = 0; c < 8; ++c) { const v4u u = qp[c]; q[8 * c] = bf_lo(u.x); q[8 * c + 1] = bf_hi(u.x); q[8 * c + 2] = bf_lo(u.y); q[8 * c + 3] = bf_hi(u.y); q[8 * c + 4] = bf_lo(u.z); q[8 * c + 5] = bf_hi(u.z); q[8 * c + 6] = bf_lo(u.w); q[8 * c + 7] = bf_hi(u.w); } }
    float o[64];
#pragma unroll
    for (int d = 0; d < 64; ++d) o[d] = 0.f;
    float m = -INFINITY, l = 0.f; const float Ft = F[t];
    const int smax = qb * 512 + wave * 64 + 63;
    for (int s = 0; s <= smax; ++s) {
        const v4u* kp = (const v4u*)(z + (rowbase + s) * FX_N + 1024 + h * 64);
        float dot = 0.f;
#pragma unroll
        for (int c = 0; c < 8; ++c) { const v4u u = kp[c];
            dot += q[8 * c] * bf_lo(u.x) + q[8 * c + 1] * bf_hi(u.x) + q[8 * c + 2] * bf_lo(u.y) + q[8 * c + 3] * bf_hi(u.y) + q[8 * c + 4] * bf_lo(u.z) + q[8 * c + 5] * bf_hi(u.z) + q[8 * c + 6] * bf_lo(u.w) + q[8 * c + 7] * bf_hi(u.w); }
        float lg = dot + (Ft - F[s]);
        lg = (s <= t) ? lg : -INFINITY;
        const float mn = fmaxf(m, lg), alpha = ex2(m - mn), p = ex2(lg - mn);
        l = l * alpha + p; m = mn;
        const v4u* vp = (const v4u*)(z + (rowbase + s) * FX_N + 2048 + h * 64);
#pragma unroll
        for (int c = 0; c < 8; ++c) { const v4u u = vp[c];
            o[8 * c] = o[8 * c] * alpha + p * bf_lo(u.x); o[8 * c + 1] = o[8 * c + 1] * alpha + p * bf_hi(u.x); o[8 * c + 2] = o[8 * c + 2] * alpha + p * bf_lo(u.y); o[8 * c + 3] = o[8 * c + 3] * alpha + p * bf_hi(u.y);
            o[8 * c + 4] = o[8 * c + 4] * alpha + p * bf_lo(u.z); o[8 * c + 5] = o[8 * c + 5] * alpha + p * bf_hi(u.z); o[8 * c + 6] = o[8 * c + 6] * alpha + p * bf_lo(u.w); o[8 * c + 7] = o[8 * c + 7] * alpha + p * bf_hi(u.w); }
    }
    const float il = 1.0f / l;
    v4u* yp = (v4u*)(y + (rowbase + t) * D + h * 64);
#pragma unroll
    for (int c = 0; c < 8; ++c) { v4u w; w.x = pk2(o[8 * c] * il, o[8 * c + 1] * il); w.y = pk2(o[8 * c + 2] * il, o[8 * c + 3] * il); w.z = pk2(o[8 * c + 4] * il, o[8 * c + 5] * il); w.w = pk2(o[8 * c + 6] * il, o[8 * c + 7] * il); yp[c] = w; }
}

__device__ __forceinline__ void da_naive_unit(int b, int h, int qb, const bf16* z, bf16* y, const float* lam_p, const float* subln_g, int layer, int lane, int wave) {
    const int r = lane & 15, mm = (lane >> 4) & 1, vh = lane >> 5;
    const int t = qb * 128 + wave * 16 + r; const size_t rowbase = (size_t)b * SEQ;
    const float lambda_init = 0.8f - 0.6f * expf(-0.3f * (float)layer);
    float lam;
    { float s0 = 0.f, s1 = 0.f; for (int d = 0; d < 64; ++d) { s0 += lam_p[d] * lam_p[64 + d]; s1 += lam_p[128 + d] * lam_p[192 + d]; } lam = expf(s0) - expf(s1) + lambda_init; }
    const float slope2 = exp2f(-2.0f * (float)(h + 1)) * LOG2E;
    float q[64];
    { const v4u* qp = (const v4u*)(z + (rowbase + t) * AB_N + h * 128 + mm * 64);
#pragma unroll
        for (int c = 0; c < 8; ++c) { const v4u u = qp[c]; q[8 * c] = bf_lo(u.x); q[8 * c + 1] = bf_hi(u.x); q[8 * c + 2] = bf_lo(u.y); q[8 * c + 3] = bf_hi(u.y); q[8 * c + 4] = bf_lo(u.z); q[8 * c + 5] = bf_hi(u.z); q[8 * c + 6] = bf_lo(u.w); q[8 * c + 7] = bf_hi(u.w); } }
    float o[64];
#pragma unroll
    for (int d = 0; d < 64; ++d) o[d] = 0.f;
    float m = -INFINITY, l = 0.f;
    const int smax = (qb * 128 + wave * 16) / 64 * 64 + 63;
    for (int s = 0; s <= smax; ++s) {
        const v4u* kp = (const v4u*)(z + (rowbase + s) * AB_N + 512 + h * 128 + mm * 64);
        float dot = 0.f;
#pragma unroll
        for (int c = 0; c < 8; ++c) { const v4u u = kp[c];
            dot += q[8 * c] * bf_lo(u.x) + q[8 * c + 1] * bf_hi(u.x) + q[8 * c + 2] * bf_lo(u.y) + q[8 * c + 3] * bf_hi(u.y) + q[8 * c + 4] * bf_lo(u.z) + q[8 * c + 5] * bf_hi(u.z) + q[8 * c + 6] * bf_lo(u.w) + q[8 * c + 7] * bf_hi(u.w); }
        const float lg = dot - slope2 * fabsf((float)(t - s));
        const float mn = fmaxf(m, lg), alpha = ex2(m - mn), p = ex2(lg - mn);
        l = l * alpha + p; m = mn;
        const v4u* vp = (const v4u*)(z + (rowbase + s) * AB_N + 1024 + h * 128 + vh * 64);
#pragma unroll
        for (int c = 0; c < 8; ++c) { const v4u u = vp[c];
            o[8 * c] = o[8 * c] * alpha + p * bf_lo(u.x); o[8 * c + 1] = o[8 * c + 1] * alpha + p * bf_hi(u.x); o[8 * c + 2] = o[8 * c + 2] * alpha + p * bf_lo(u.y); o[8 * c + 3] = o[8 * c + 3] * alpha + p * bf_hi(u.y);
            o[8 * c + 4] = o[8 * c + 4] * alpha + p * bf_lo(u.z); o[8 * c + 5] = o[8 * c + 5] * alpha + p * bf_hi(u.z); o[8 * c + 6] = o[8 * c + 6] * alpha + p * bf_lo(u.w); o[8 * c + 7] = o[8 * c + 7] * alpha + p * bf_hi(u.w); }
    }
    const float il = 1.0f / l; float ss = 0.f;
#pragma unroll
    for (int d = 0; d < 64; ++d) { const float mine = o[d] * il, other = __shfl_xor(mine, 16); o[d] = mine - lam * other; ss += o[d] * o[d]; }
    ss += __shfl_xor(ss, 32);
    const float rn = (1.0f - lambda_init) / sqrtf(ss * (1.0f / 128.0f) + EPS);
    if (mm == 0) {
        v4u* yp = (v4u*)(y + (rowbase + t) * D + h * 128 + vh * 64);
#pragma unroll
        for (int c = 0; c < 8; ++c) { float e[8];
#pragma unroll
            for (int i = 0; i < 8; ++i) e[i] = o[8 * c + i] * rn * subln_g[vh * 64 + 8 * c + i];
            v4u w; w.x = pk2(e[0], e[1]); w.y = pk2(e[2], e[3]); w.z = pk2(e[4], e[5]); w.w = pk2(e[6], e[7]); yp[c] = w; }
    }
}

__device__ __forceinline__ void mlstm_naive_unit(int b, int h, const bf16* z, const float* gates, const float* conv_w, const float* conv_b, bf16* y, LAS unsigned char* lds, int tid) {
    LAS float* qs = (LAS float*)lds;
    LAS float* ks = (LAS float*)(lds + 32768);
    LAS float* pn = (LAS float*)(lds + 65536);
    LAS float* pd = (LAS float*)(lds + 65536 + 4096);
    const int dv = tid & 127, eq = tid >> 7; const size_t rowbase = (size_t)b * SEQ;
    const float* gi = gates + ((size_t)b * 4 + h) * SEQ; const float* glf = gates + (size_t)BATCH * 4 * SEQ + ((size_t)b * 4 + h) * SEQ;
    float C[32], n[32];
#pragma unroll
    for (int i = 0; i < 32; ++i) { C[i] = 0.f; n[i] = 0.f; }
    float m = 0.f;
    for (int c = 0; c < SEQ / 64; ++c) {
        for (int it = tid; it < 2048; it += NTHREADS) {
            const int isk = it >> 10, r = (it >> 4) & 63, g = it & 15; const int t = 64 * c + r;
            const int ch = isk * 512 + h * 128 + 8 * g;
            float acc[8];
#pragma unroll
            for (int i = 0; i < 8; ++i) acc[i] = conv_b[ch + i];
#pragma unroll
            for (int j = 0; j < 4; ++j) { const int tt = t - 3 + j;
                if (tt >= 0) { const v4u u = *(const v4u*)(z + (rowbase + tt) * AB_N + 1536 + ch); const float* w = conv_w + j * 1024 + ch;
                    acc[0] += bf_lo(u.x) * w[0]; acc[1] += bf_hi(u.x) * w[1]; acc[2] += bf_lo(u.y) * w[2]; acc[3] += bf_hi(u.y) * w[3];
                    acc[4] += bf_lo(u.z) * w[4]; acc[5] += bf_hi(u.z) * w[5]; acc[6] += bf_lo(u.w) * w[6]; acc[7] += bf_hi(u.w) * w[7]; } }
            LAS float* dst = (isk ? ks : qs) + r * 128 + 8 * g; const float scl = isk ? 0.08838834764831845f : 1.0f;
#pragma unroll
            for (int i = 0; i < 8; ++i) dst[i] = acc[i] / (1.0f + __expf(-acc[i])) * scl;
        }
        __syncthreads();
        for (int r = 0; r < 64; ++r) {
            const int t = 64 * c + r;
            const float lf = glf[t], ig = gi[t];
            const float mn = fmaxf(lf + m, ig), fd = __expf(lf + m - mn), ii = __expf(ig - mn); m = mn;
            const float vv = bf1(z[(rowbase + t) * AB_N + 2560 + h * 128 + dv]) * ii;
            float pnum = 0.f, pden = 0.f;
#pragma unroll
            for (int i = 0; i < 32; ++i) { const float kk = ks[r * 128 + 32 * eq + i], qq = qs[r * 128 + 32 * eq + i];
                C[i] = fd * C[i] + vv * kk; n[i] = fd * n[i] + ii * kk; pnum += C[i] * qq; pden += n[i] * qq; }
            pn[((r & 1) * 4 + eq) * 128 + dv] = pnum; if (dv == 0) pd[(r & 1) * 4 + eq] = pden;
            __syncthreads();
            if (eq == 0) {
                const float num = (pn[((r & 1) * 4 + 0) * 128 + dv] + pn[((r & 1) * 4 + 1) * 128 + dv]) + (pn[((r & 1) * 4 + 2) * 128 + dv] + pn[((r & 1) * 4 + 3) * 128 + dv]);
                const float den = (pd[(r & 1) * 4 + 0] + pd[(r & 1) * 4 + 1]) + (pd[(r & 1) * 4 + 2] + pd[(r & 1) * 4 + 3]);
                const float hh = num / fmaxf(fabsf(den), __expf(-m));
                const float og = bf1(z[(rowbase + t) * AB_N + 3072 + h * 128 + dv]);
                y[(rowbase + t) * D + 512 + h * 128 + dv] = (bf16)f2bf(hh / (1.0f + __expf(-og)));
            }
        }
        __syncthreads();
    }
}

typedef float f32x16 __attribute__((ext_vector_type(16)));
__device__ __forceinline__ int crow(int r, int hi) { return (r & 3) + 8 * (r >> 2) + 4 * hi; }
#define MFMA32(a, b, c) __builtin_amdgcn_mfma_f32_32x32x16_bf16((a), (b), (c), 0, 0, 0)
template <int CTRL, int ROWMASK> __device__ __forceinline__ float dpp_f(float oldv, float x) {
    return __builtin_bit_cast(float, __builtin_amdgcn_update_dpp(__builtin_bit_cast(int, oldv), __builtin_bit_cast(int, x), CTRL, ROWMASK, 0xf, false)); }
__device__ __forceinline__ float scan_add(float v, int) {
    v += dpp_f<0x111, 0xf>(0.f, v); v += dpp_f<0x112, 0xf>(0.f, v); v += dpp_f<0x114, 0xf>(0.f, v); v += dpp_f<0x118, 0xf>(0.f, v);
    v += dpp_f<0x142, 0xa>(0.f, v); v += dpp_f<0x143, 0xc>(0.f, v); return v; }
__device__ __forceinline__ float scan_max(float v, int) {
    const float ninf = -INFINITY;
    v = fmaxf(v, dpp_f<0x111, 0xf>(ninf, v)); v = fmaxf(v, dpp_f<0x112, 0xf>(ninf, v)); v = fmaxf(v, dpp_f<0x114, 0xf>(ninf, v)); v = fmaxf(v, dpp_f<0x118, 0xf>(ninf, v));
    v = fmaxf(v, dpp_f<0x142, 0xa>(ninf, v)); v = fmaxf(v, dpp_f<0x143, 0xc>(ninf, v)); return v; }
__device__ __forceinline__ void swap32(unsigned& a, unsigned& b) { asm volatile("s_nop 1\n\tv_permlane32_swap_b32 %0, %1\n\ts_nop 1" : "+v"(a), "+v"(b)); }
__device__ __forceinline__ void swap16(unsigned& a, unsigned& b) { asm volatile("s_nop 1\n\tv_permlane16_swap_b32 %0, %1\n\ts_nop 1" : "+v"(a), "+v"(b)); }
__device__ __forceinline__ float xsum32(float v) { unsigned a = __builtin_bit_cast(unsigned, v), b = a; swap32(a, b); return __builtin_bit_cast(float, a) + __builtin_bit_cast(float, b); }
__device__ __forceinline__ float xsum16(float v) { unsigned a = __builtin_bit_cast(unsigned, v), b = a; swap16(a, b); return __builtin_bit_cast(float, a) + __builtin_bit_cast(float, b); }
__device__ __forceinline__ float xmax32(float v) { unsigned a = __builtin_bit_cast(unsigned, v), b = a; swap32(a, b); return fmaxf(__builtin_bit_cast(float, a), __builtin_bit_cast(float, b)); }

constexpr int FX_KSTR = 144, FX_F_OFF = 0, FX_K_OFF = 16384, FX_KBUF = 64 * FX_KSTR, FX_V_OFF = FX_K_OFF + 2 * FX_KBUF, FX_VBUF = 8192, FX_WT_OFF = FX_V_OFF + 3 * FX_VBUF;
__device__ __forceinline__ void fox_unit(int b, int h, int qb, const bf16* z, const float* lf, bf16* y, bool bounded, float skipT, LAS unsigned char* lds, int tid, int lane, int wave) {
    const int q0 = qb * 256; const size_t rowbase = (size_t)b * SEQ;
    const int r32 = lane & 31, hi = lane >> 5;
    LAS float* F2 = (LAS float*)(lds + FX_F_OFF);
    const unsigned lds0 = (unsigned)(uintptr_t)lds;
    const int qrow = q0 + 32 * wave + r32;
    bf16x8 qf[4];
    { const bf16* qp = z + (rowbase + qrow) * FX_N + h * 64 + 8 * hi;
#pragma unroll
        for (int ks = 0; ks < 4; ++ks) qf[ks] = *(const bf16x8*)(qp + 16 * ks); }
    const int srow = tid >> 3, sch = tid & 7;
    const bf16* kg = z + (rowbase + srow) * FX_N + 1024 + h * 64 + 8 * sch;
    const bf16* vg = kg + 1024;
    const unsigned kdst = lds0 + FX_K_OFF + srow * FX_KSTR + sch * 16;
    const unsigned vdst = lds0 + FX_V_OFF + (sch >> 2) * 4096 + srow * 64 + (sch & 3) * 16;
    const int NT = 4 * (qb + 1), tmax = 4 * qb + (wave >> 1);
    v4u kA, vA, kB, vB;
    {
        const int n = q0 + 256; float v[8];
        if (tid * 8 < n) { const float* p = lf + ((size_t)b * 16 + h) * SEQ + tid * 8; const f32x4 a = *(const f32x4*)p, c = *(const f32x4*)(p + 4);
            v[0] = a.x; v[1] = v[0] + a.y; v[2] = v[1] + a.z; v[3] = v[2] + a.w; v[4] = v[3] + c.x; v[5] = v[4] + c.y; v[6] = v[5] + c.z; v[7] = v[6] + c.w; }
        else {
#pragma unroll
            for (int i = 0; i < 8; ++i) v[i] = 0.f; }
        const float inc = scan_add(v[7], lane);
        LAS float* wt = (LAS float*)(lds + FX_WT_OFF);
        if (lane == 63) wt[wave] = inc;
        __syncthreads();
        float base = inc - v[7];
        for (int w = 0; w < wave; ++w) base += wt[w];
        if (tid * 8 < n) { f32x4 a, c; a.x = (base + v[0]) * LOG2E; a.y = (base + v[1]) * LOG2E; a.z = (base + v[2]) * LOG2E; a.w = (base + v[3]) * LOG2E;
            c.x = (base + v[4]) * LOG2E; c.y = (base + v[5]) * LOG2E; c.z = (base + v[6]) * LOG2E; c.w = (base + v[7]) * LOG2E;
            *(LAS f32x4*)(F2 + tid * 8) = a; *(LAS f32x4*)(F2 + tid * 8 + 4) = c; }
    }
    __syncthreads();
    int t0 = 0, tw = 0;
    if (bounded) { const float FX_SKIP = skipT;
        { const float lim = F2[q0] + FX_SKIP; int lo = 0, hi2 = NT - 1;
            while (lo < hi2) { const int mid = (lo + hi2) >> 1; if (F2[64 * mid + 63] <= lim) hi2 = mid; else lo = mid + 1; }
            t0 = lo & ~1; }
        { const float lim = F2[q0 + 32 * wave] + FX_SKIP; int lo = t0, hi2 = tmax;
            while (lo < hi2) { const int mid = (lo + hi2) >> 1; if (F2[64 * mid + 63] <= lim) hi2 = mid; else lo = mid + 1; }
            tw = lo; } }
    { const v4u k0 = *(const v4u*)(kg + (size_t)t0 * 64 * FX_N), v0 = *(const v4u*)(vg + (size_t)t0 * 64 * FX_N);
        kB = *(const v4u*)(kg + (size_t)(t0 + 1) * 64 * FX_N); vB = *(const v4u*)(vg + (size_t)(t0 + 1) * 64 * FX_N);
        *(LAS v4u*)(uintptr_t)kdst = k0; *(LAS v4u*)(uintptr_t)(vdst + (unsigned)(t0 % 3) * FX_VBUF) = v0; }
    __syncthreads();
    const float Fq = F2[qrow];
    f32x16 o[2];
#pragma unroll
    for (int i = 0; i < 16; ++i) { o[0][i] = 0.f; o[1][i] = 0.f; }
    float lsum = 0.f, mref = 0.f;
    const unsigned ka = lds0 + FX_K_OFF + r32 * FX_KSTR + hi * 16;
    const unsigned va = lds0 + FX_V_OFF + (4 * hi + ((lane & 15) >> 2)) * 64 + (16 * ((lane >> 4) & 1) + 4 * (lane & 3)) * 2;
#define FX_QK(P, tt) do { const LAS float* fk_ = F2 + 64 * (tt) + 4 * hi; const float bq_ = Fq - mref; const unsigned kb_ = ka + ((tt) & 1) * FX_KBUF; \
        _Pragma("unroll") for (int hf = 0; hf < 2; ++hf) _Pragma("unroll") for (int g = 0; g < 4; ++g) { const f32x4 f_ = *(const LAS f32x4*)(fk_ + 32 * hf + 8 * g); \
            P[hf][4 * g] = bq_ - f_.x; P[hf][4 * g + 1] = bq_ - f_.y; P[hf][4 * g + 2] = bq_ - f_.z; P[hf][4 * g + 3] = bq_ - f_.w; } \
        _Pragma("unroll") for (int ks = 0; ks < 4; ++ks) _Pragma("unroll") for (int hf = 0; hf < 2; ++hf) { const bf16x8 a_ = *(const LAS bf16x8*)(uintptr_t)(kb_ + hf * 32 * FX_KSTR + ks * 32); P[hf] = MFMA32(a_, qf[ks], P[hf]); } } while (0)
#define FX_SM(P, NOMAX, tt) do { \
        if (64 * (tt) + 63 > q0 + 32 * wave) { _Pragma("unroll") for (int hf = 0; hf < 2; ++hf) _Pragma("unroll") for (int r = 0; r < 16; ++r) { const int kv_ = 64 * (tt) + 32 * hf + crow(r, hi); if (kv_ > qrow) P[hf][r] = -INFINITY; } } \
        if (!(NOMAX)) { float mx_ = fmaxf(P[0][0], P[1][0]); \
            _Pragma("unroll") for (int r = 1; r < 16; ++r) mx_ = fmaxf(mx_, fmaxf(P[0][r], P[1][r])); \
            mx_ = xmax32(mx_); \
            if (__any(mx_ > 8.0f)) { const float dl_ = fmaxf(mx_, 0.f), alpha_ = ex2(-dl_); mref += dl_; lsum *= alpha_; \
                _Pragma("unroll") for (int r = 0; r < 16; ++r) { P[0][r] -= dl_; P[1][r] -= dl_; o[0][r] *= alpha_; o[1][r] *= alpha_; } } } \
        _Pragma("unroll") for (int hf = 0; hf < 2; ++hf) { \
            _Pragma("unroll") for (int r = 0; r < 16; ++r) { P[hf][r] = ex2(P[hf][r]); lsum += P[hf][r]; } \
            _Pragma("unroll") for (int k2 = 0; k2 < 2; ++k2) { v4u w_; w_.x = cvtpk(P[hf][8 * k2], P[hf][8 * k2 + 1]); w_.y = cvtpk(P[hf][8 * k2 + 2], P[hf][8 * k2 + 3]); w_.z = cvtpk(P[hf][8 * k2 + 4], P[hf][8 * k2 + 5]); w_.w = cvtpk(P[hf][8 * k2 + 6], P[hf][8 * k2 + 7]); \
                pf[hf][k2] = __builtin_bit_cast(bf16x8, w_); } } } while (0)
#define FX_PV(tt) do { const unsigned vs_ = va + (unsigned)((tt) % 3) * FX_VBUF; \
        _Pragma("unroll") for (int hf = 0; hf < 2; ++hf) _Pragma("unroll") for (int k2 = 0; k2 < 2; ++k2) _Pragma("unroll") for (int db = 0; db < 2; ++db) { const unsigned ad_ = vs_ + db * 4096 + (32 * hf + 16 * k2) * 64; \
            const s16x4 lo_ = ds_tr16(ad_), hh_ = ds_tr16(ad_ + 8 * 64); const bf16x8 a_ = {lo_[0], lo_[1], lo_[2], lo_[3], hh_[0], hh_[1], hh_[2], hh_[3]}; \
            o[db] = MFMA32(a_, pf[hf][k2], o[db]); } } while (0)
#define FX_ITER(t, KL, VL, KS, VS, NOMAX, LAG) do { \
        if ((t) + 2 < NT) { KL = *(const v4u*)(kg + (size_t)((t) + 2) * 64 * FX_N); VL = *(const v4u*)(vg + (size_t)((t) + 2) * 64 * FX_N); } \
        if (LAG) { if ((t) - 1 >= tw && (t) - 1 <= tmax) FX_PV((t) - 1); if ((t) >= tw && (t) <= tmax) { FX_QK(pc, (t)); FX_SM(pc, NOMAX, (t)); } } \
        else { if ((t) >= tw && (t) <= tmax) { FX_QK(pc, (t)); FX_SM(pc, NOMAX, (t)); FX_PV((t)); } } \
        if ((t) + 1 < NT) { *(LAS v4u*)(uintptr_t)(kdst + (((t) + 1) & 1) * FX_KBUF) = KS; *(LAS v4u*)(uintptr_t)(vdst + (unsigned)(((t) + 1) % 3) * FX_VBUF) = VS; } \
        __syncthreads(); } while (0)
    f32x16 pc[2]; bf16x8 pf[2][2];
    if (wave < 4) {
        if (bounded) { for (int t = t0; t < NT; t += 2) { FX_ITER(t, kA, vA, kB, vB, true, false); FX_ITER(t + 1, kB, vB, kA, vA, true, false); } }
        else { for (int t = t0; t < NT; t += 2) { FX_ITER(t, kA, vA, kB, vB, false, false); FX_ITER(t + 1, kB, vB, kA, vA, false, false); } }
    } else {
        if (bounded) { for (int t = t0; t < NT; t += 2) { FX_ITER(t, kA, vA, kB, vB, true, true); FX_ITER(t + 1, kB, vB, kA, vA, true, true); } }
        else { for (int t = t0; t < NT; t += 2) { FX_ITER(t, kA, vA, kB, vB, false, true); FX_ITER(t + 1, kB, vB, kA, vA, false, true); } }
        if (tmax == NT - 1) FX_PV(NT - 1);
    }
#undef FX_ITER
#undef FX_QK
#undef FX_SM
#undef FX_PV
    lsum = xsum32(lsum);
    const float il = 1.0f / lsum;
    bf16* yp = y + (rowbase + qrow) * D + h * 64 + 4 * hi;
#pragma unroll
    for (int db = 0; db < 2; ++db)
#pragma unroll
        for (int g = 0; g < 4; ++g) { const unsigned long long w = (unsigned long long)cvtpk(o[db][4 * g] * il, o[db][4 * g + 1] * il) | ((unsigned long long)cvtpk(o[db][4 * g + 2] * il, o[db][4 * g + 3] * il) << 32);
            *(unsigned long long*)(yp + 32 * db + 8 * g) = w; }
}

constexpr int DA_KSTR = 272, DA_K_OFF = 0, DA_KBUF = 64 * DA_KSTR, DA_V_OFF = 2 * DA_KBUF, DA_VBUF = 16384;
static_assert(DA_V_OFF + 2 * DA_VBUF >= 65536 && DA_V_OFF + 2 * DA_VBUF <= RING_BYTES, "DA LDS map (the exchange reuses the K/V region)");
__device__ __forceinline__ void da_unit(int b, int h, int qb, const bf16* z, bf16* y, volatile LAS unsigned* MISC, bool bounded, const float* subln_g, LAS unsigned char* lds, int tid, int lane, int wave) {
    const int q0 = qb * 128, qs = wave & 3, mm = wave >> 2; const size_t rowbase = (size_t)b * SEQ;
    const int r32 = lane & 31, hi = lane >> 5;
    const unsigned lds0 = (unsigned)(uintptr_t)lds;
    const float slope2 = exp2f(-2.0f * (float)(h + 1)) * LOG2E;
    const int qrow = q0 + 32 * qs + r32;
    float cr[16];
#pragma unroll
    for (int r = 0; r < 16; ++r) cr[r] = slope2 * (float)crow(r, hi);
#ifdef DBG_DA_SYNC
    for (int i = tid; i < 69632 / 4; i += NTHREADS) ((LAS unsigned*)lds)[i] = 0u;
    __syncthreads();
#endif
    bf16x8 qf[4];
    { const bf16* qp = z + (rowbase + qrow) * AB_N + h * 128 + mm * 64 + 8 * hi;
#pragma unroll
        for (int ks = 0; ks < 4; ++ks) qf[ks] = *(const bf16x8*)(qp + 16 * ks); }
    const bf16* kg[2]; unsigned kdst[2], vdst[2];
#pragma unroll
    for (int i = 0; i < 2; ++i) { const int c = tid + 512 * i, row = c >> 4, ch = c & 15;
        kg[i] = z + (rowbase + row) * AB_N + 512 + h * 128 + 8 * ch;
        kdst[i] = lds0 + DA_K_OFF + row * DA_KSTR + ch * 16; vdst[i] = lds0 + DA_V_OFF + (ch >> 2) * 4096 + row * 64 + (ch & 3) * 16; }
    int t0 = 0, tw = 0;
    if (bounded) { const float DA_SKIP = __builtin_bit_cast(float, (unsigned)MISC[5]); const float dist = DA_SKIP / slope2;
        const int f0 = (int)floorf(((float)(q0 - 63) - dist) * (1.0f / 64.0f)) + 1, fw = (int)floorf(((float)(q0 + 32 * qs - 63) - dist) * (1.0f / 64.0f)) + 1;
        t0 = f0 > 0 ? f0 : 0; tw = fw > 0 ? fw : 0; }
    v4u kreg[2], vreg[2];
#pragma unroll
    for (int i = 0; i < 2; ++i) { kreg[i] = *(const v4u*)(kg[i] + (size_t)t0 * 64 * AB_N); vreg[i] = *(const v4u*)(kg[i] + 512 + (size_t)t0 * 64 * AB_N); }
#pragma unroll
    for (int i = 0; i < 2; ++i) { *(LAS v4u*)(uintptr_t)(kdst[i] + (t0 & 1) * DA_KBUF) = kreg[i]; *(LAS v4u*)(uintptr_t)(vdst[i] + (t0 & 1) * DA_VBUF) = vreg[i]; }
    __syncthreads();
    f32x16 o[4];
#pragma unroll
    for (int d = 0; d < 4; ++d)
#pragma unroll
        for (int i = 0; i < 16; ++i) o[d][i] = 0.f;
    float lsum = 0.f, mref = 0.f;
    const int NT = (q0 + 128) / 64, tmax = (q0 + 32 * qs) / 64;
    const unsigned ka = lds0 + DA_K_OFF + r32 * DA_KSTR + mm * 128 + hi * 16;
    const unsigned va = lds0 + DA_V_OFF + (4 * hi + ((lane & 15) >> 2)) * 64 + (16 * ((lane >> 4) & 1) + 4 * (lane & 3)) * 2;
    auto da_loop = [&](auto nomax_tag) { constexpr bool NOMAX = decltype(nomax_tag)::value;
    for (int t = t0; t < NT; ++t) {
        const int buf = t & 1;
        if (t + 1 < NT) {
#pragma unroll
            for (int i = 0; i < 2; ++i) { kreg[i] = *(const v4u*)(kg[i] + (size_t)(t + 1) * 64 * AB_N); vreg[i] = *(const v4u*)(kg[i] + 512 + (size_t)(t + 1) * 64 * AB_N); } }
        if (t >= tw && t <= tmax) {
            f32x16 p[2];
            if (t < tmax) {
                const float b0 = -slope2 * (float)(qrow - 64 * t) - mref, b1 = b0 + 32.0f * slope2;
#pragma unroll
                for (int r = 0; r < 16; ++r) { p[0][r] = b0 + cr[r]; p[1][r] = b1 + cr[r]; }
            } else {
#pragma unroll
                for (int hf = 0; hf < 2; ++hf)
#pragma unroll
                    for (int r = 0; r < 16; ++r) p[hf][r] = -slope2 * fabsf((float)(qrow - (64 * t + 32 * hf + crow(r, hi)))) - mref;
            }
#pragma unroll
            for (int hf = 0; hf < 2; ++hf)
#pragma unroll
                for (int ks = 0; ks < 4; ++ks) { const bf16x8 a = *(const LAS bf16x8*)(uintptr_t)(ka + buf * DA_KBUF + hf * 32 * DA_KSTR + ks * 32); p[hf] = MFMA32(a, qf[ks], p[hf]); }
            if (!NOMAX) {
            float mx = fmaxf(p[0][0], p[1][0]);
#pragma unroll
            for (int r = 1; r < 16; ++r) mx = fmaxf(mx, fmaxf(p[0][r], p[1][r]));
            mx = xmax32(mx);
            if (__any(mx > 8.0f)) { const float dl = fmaxf(mx, 0.f), alpha = ex2(-dl); mref += dl; lsum *= alpha;
#pragma unroll
                for (int r = 0; r < 16; ++r) { p[0][r] -= dl; p[1][r] -= dl; }
#pragma unroll
                for (int d = 0; d < 4; ++d)
#pragma unroll
                    for (int r = 0; r < 16; ++r) o[d][r] *= alpha; }
            }
            bf16x8 pf[2][2];
#pragma unroll
            for (int hf = 0; hf < 2; ++hf) {
#pragma unroll
                for (int r = 0; r < 16; ++r) { p[hf][r] = ex2(p[hf][r]); lsum += p[hf][r]; }
#pragma unroll
                for (int k2 = 0; k2 < 2; ++k2) { v4u w; w.x = cvtpk(p[hf][8 * k2], p[hf][8 * k2 + 1]); w.y = cvtpk(p[hf][8 * k2 + 2], p[hf][8 * k2 + 3]); w.z = cvtpk(p[hf][8 * k2 + 4], p[hf][8 * k2 + 5]); w.w = cvtpk(p[hf][8 * k2 + 6], p[hf][8 * k2 + 7]);
                    pf[hf][k2] = __builtin_bit_cast(bf16x8, w); } }
#pragma unroll
            for (int db = 0; db < 4; ++db)
#pragma unroll
                for (int hf = 0; hf < 2; ++hf)
#pragma unroll
                    for (int k2 = 0; k2 < 2; ++k2) { const unsigned ad = va + buf * DA_VBUF + db * 4096 + (32 * hf + 16 * k2) * 64;
                        const s16x4 lo = ds_tr16(ad), hh = ds_tr16(ad + 8 * 64);
                        const bf16x8 a = {lo[0], lo[1], lo[2], lo[3], hh[0], hh[1], hh[2], hh[3]};
                        o[db] = MFMA32(a, pf[hf][k2], o[db]); }
        }
        if (t + 1 < NT) {
#pragma unroll
            for (int i = 0; i < 2; ++i) { *(LAS v4u*)(uintptr_t)(kdst[i] + (buf ^ 1) * DA_KBUF) = kreg[i]; *(LAS v4u*)(uintptr_t)(vdst[i] + (buf ^ 1) * DA_VBUF) = vreg[i]; } }
        __syncthreads();
    }
    };
    if (bounded) da_loop(std::true_type{}); else da_loop(std::false_type{});
    lsum = xsum32(lsum);
    const float il = 1.0f / lsum;
    LAS float* xb = (LAS float*)lds + qs * 4096 + lane;
    if (mm == 1) {
#pragma unroll
        for (int db = 0; db < 4; ++db)
#pragma unroll
            for (int r = 0; r < 16; ++r) xb[(db * 16 + r) * 64] = o[db][r] * il;
    }
    __syncthreads();
    if (mm == 0) {
        const float lam = __builtin_bit_cast(float, (unsigned)MISC[2]), lambda_init = __builtin_bit_cast(float, (unsigned)MISC[3]);
        float ss = 0.f;
#pragma unroll
        for (int db = 0; db < 4; ++db)
#pragma unroll
            for (int r = 0; r < 16; ++r) { const float dv = o[db][r] * il - lam * xb[(db * 16 + r) * 64]; o[db][r] = dv; ss += dv * dv; }
        ss += __shfl_xor(ss, 32);
        const float rn = (1.0f - lambda_init) / sqrtf(ss * (1.0f / 128.0f) + EPS);
        bf16* yp = y + (rowbase + qrow) * D + h * 128 + 4 * hi; const float* gp = subln_g + 4 * hi;
#pragma unroll
        for (int db = 0; db < 4; ++db)
#pragma unroll
            for (int g = 0; g < 4; ++g) { const f32x4 gg = *(const f32x4*)(gp + 32 * db + 8 * g);
                const unsigned long long w = (unsigned long long)cvtpk(o[db][4 * g] * rn * gg.x, o[db][4 * g + 1] * rn * gg.y) | ((unsigned long long)cvtpk(o[db][4 * g + 2] * rn * gg.z, o[db][4 * g + 3] * rn * gg.w) << 32);
                *(unsigned long long*)(yp + 32 * db + 8 * g) = w; }
    }
    __syncthreads();
}

__device__ __forceinline__ void phase_mlconv(const bf16* z, const float* conv_w, const float* conv_b, bf16* qkc, int tid, int G) {
    const int cg = tid & 127, rs = tid >> 7, ch = 8 * cg;
    const float scl = (ch >= 512) ? 0.08838834764831845f : 1.0f;
    for (int item = blockIdx.x; item < M / 16; item += G) {
        const int row0 = item * 16 + 4 * rs, t0 = row0 % SEQ;
        v4u xr[7];
#pragma unroll
        for (int j = 0; j < 7; ++j) { const int tt = t0 - 3 + j; xr[j] = (tt >= 0) ? *(const v4u*)(z + (size_t)(row0 - 3 + j) * AB_N + 1536 + ch) : (v4u){0u, 0u, 0u, 0u}; }
        float a4[4][8];
        { const f32x4 b0 = *(const f32x4*)(conv_b + ch), b1 = *(const f32x4*)(conv_b + ch + 4);
#pragma unroll
            for (int r = 0; r < 4; ++r) { a4[r][0] = b0.x; a4[r][1] = b0.y; a4[r][2] = b0.z; a4[r][3] = b0.w; a4[r][4] = b1.x; a4[r][5] = b1.y; a4[r][6] = b1.z; a4[r][7] = b1.w; } }
#pragma unroll
        for (int j = 0; j < 4; ++j) { const f32x4 w0 = *(const f32x4*)(conv_w + j * 1024 + ch), w1 = *(const f32x4*)(conv_w + j * 1024 + ch + 4);
#pragma unroll
            for (int r = 0; r < 4; ++r) { const v4u u = xr[r + j];
                a4[r][0] += bf_lo(u.x) * w0.x; a4[r][1] += bf_hi(u.x) * w0.y; a4[r][2] += bf_lo(u.y) * w0.z; a4[r][3] += bf_hi(u.y) * w0.w;
                a4[r][4] += bf_lo(u.z) * w1.x; a4[r][5] += bf_hi(u.z) * w1.y; a4[r][6] += bf_lo(u.w) * w1.z; a4[r][7] += bf_hi(u.w) * w1.w; } }
#pragma unroll
        for (int r = 0; r < 4; ++r) { float a[8];
#pragma unroll
            for (int i = 0; i < 8; ++i) a[i] = a4[r][i] * fast_sig(a4[r][i]) * scl;
            v4u w; w.x = cvtpk(a[0], a[1]); w.y = cvtpk(a[2], a[3]); w.z = cvtpk(a[4], a[5]); w.w = cvtpk(a[6], a[7]);
            *(v4u*)(qkc + (size_t)(row0 + r) * 1024 + ch) = w; }
    }
}

typedef float f32x4v __attribute__((ext_vector_type(4)));
#define MFMA16(a, b, c) __builtin_amdgcn_mfma_f32_16x16x32_bf16((a), (b), (c), 0, 0, 0)
constexpr int ML_STR = 272, ML_VSTR = 144, ML_Q = 0, ML_K = 17408, ML_KBUF = 80 * ML_STR, ML_V = ML_K + 2 * ML_KBUF, ML_VW = ML_V + 64 * ML_VSTR, ML_P = ML_VW + 64 * ML_VSTR, ML_PSTR = 144,
              ML_H = ML_P + 64 * ML_PSTR, ML_T = ML_H + 64 * ML_VSTR, ML_TPAR = 2048, ML_DENP = ML_T + 2 * ML_TPAR, ML_DN = ML_DENP + 1024, ML_DUMMY = ML_DN + 256, ML_XCH = ML_DUMMY + 512, ML_END = ML_XCH + 16384;
constexpr int ML_RS = RING_BYTES + 1024;
static_assert(ML_END <= RING_BYTES && ML_RS + 4096 <= LDS_BYTES && MISC_OFF + 128 <= RING_BYTES + 1024, "mLSTM LDS map");
#define SCHED_FENCE() __builtin_amdgcn_sched_barrier(0)
__device__ __forceinline__ float bcast63(float v) { return __builtin_bit_cast(float, __builtin_amdgcn_readlane(__builtin_bit_cast(int, v), 63)); }
__device__ __forceinline__ void ml_gate_tables(float lfv, float igv, LAS float* tp, float& mprev, int lane) {
    lfv *= LOG2E; igv *= LOG2E;
    const float a = scan_add(lfv, lane), b = igv - a, cm = scan_max(b, lane);
    const float alast = bcast63(a), bmax = bcast63(cm);
    const float mnew = fmaxf(alast + mprev, alast + bmax), Mv = fmaxf(mprev, cm);
    tp[lane] = b; tp[64 + lane] = Mv; tp[128 + lane] = ex2(mprev - Mv); tp[192 + lane] = ex2(-(a + Mv)); tp[256 + lane] = ex2(alast + b - mnew);
    if (lane == 0) tp[320] = ex2(alast + mprev - mnew);
    mprev = mnew;
}
template <int STRIDE> __device__ __forceinline__ bf16x8 tr_frag(unsigned addr) {
    const s16x4 lo = ds_tr16(addr), hh = ds_tr16(addr + 4 * STRIDE);
    return (bf16x8){lo[0], lo[1], lo[2], lo[3], hh[0], hh[1], hh[2], hh[3]}; }
__device__ __forceinline__ void mlstm_unit(int b, int h, int dh, const bf16* z, const bf16* qkc, const float* gates, bf16* y, LAS unsigned char* lds, int tid, int lane, int wave) {
    const size_t rowbase = (size_t)b * SEQ;
    const unsigned lds0 = (unsigned)(uintptr_t)lds;
    const float* gi = gates + ((size_t)b * 4 + h) * SEQ; const float* glf = gates + (size_t)BATCH * 4 * SEQ + ((size_t)b * 4 + h) * SEQ;
    const int c15 = lane & 15, kq = lane >> 4;
    const int sl = wave >> 1, rr = wave & 1;
    const bf16* gq = qkc + rowbase * 1024 + h * 128;
    const bf16* zv = z + rowbase * AB_N + 2560 + h * 128 + 64 * dh + 8 * (tid & 7);
    const int vrow = tid >> 3;
    v4u qr[2], kr[2], vr;
#define ML_LOADS(cn) do { _Pragma("unroll") for (int i = 0; i < 2; ++i) { const int c_ = tid + 512 * i; const size_t r_ = (size_t)(64 * (cn) + (c_ >> 4)); \
            qr[i] = *(const v4u*)(gq + r_ * 1024 + 8 * (c_ & 15)); kr[i] = *(const v4u*)(gq + r_ * 1024 + 512 + 8 * (c_ & 15)); } \
        vr = *(const v4u*)(zv + (size_t)(64 * (cn) + vrow) * AB_N); } while (0)
#define ML_CONV_STORE(kb) do { _Pragma("unroll") for (int i = 0; i < 2; ++i) { const int c_ = tid + 512 * i; const unsigned o_ = (c_ >> 4) * ML_STR + 16 * (c_ & 15); \
            *(LAS v4u*)(uintptr_t)(lds0 + ML_Q + o_) = qr[i]; *(LAS v4u*)(uintptr_t)(lds0 + ML_K + (kb) * ML_KBUF + o_) = kr[i]; } } while (0)
#define ML_V_STORE(tp) do { const float w_ = (tp)[256 + vrow]; const v4u u = vr; const unsigned o_ = vrow * ML_VSTR + 16 * (tid & 7); \
            *(LAS v4u*)(uintptr_t)(lds0 + ML_V + o_) = u; \
            v4u x_; x_.x = cvtpk(bf_lo(u.x) * w_, bf_hi(u.x) * w_); x_.y = cvtpk(bf_lo(u.y) * w_, bf_hi(u.y) * w_); x_.z = cvtpk(bf_lo(u.z) * w_, bf_hi(u.z) * w_); x_.w = cvtpk(bf_lo(u.w) * w_, bf_hi(u.w) * w_); \
            *(LAS v4u*)(uintptr_t)(lds0 + ML_VW + o_) = x_; } while (0)
    LAS float* T0 = (LAS float*)(lds + ML_T);
    LAS float* denp = (LAS float*)(lds + ML_DENP);
    LAS float* dnr = (LAS float*)(lds + ML_DN);
    LAS float* xch = (LAS float*)(lds + ML_XCH);
    float mprev = 0.f;
    float g_lf = 0.f, g_ig = 0.f;
    if (wave == 7) { ml_gate_tables(glf[lane], gi[lane], T0, mprev, lane); g_lf = glf[64 + lane]; g_ig = gi[64 + lane]; }
    ML_LOADS(0);
    ML_CONV_STORE(0);
    if (tid < 32) *(LAS unsigned long long*)(uintptr_t)(lds0 + ML_K + 64 * ML_STR + 8 * tid) = (unsigned long long)(tid >> 20);
    __syncthreads();
    ML_V_STORE(T0);
    f32x4v C[4], nacc = {0.f, 0.f, 0.f, 0.f};
#pragma unroll
    for (int T = 0; T < 4; ++T) C[T] = (f32x4v){0.f, 0.f, 0.f, 0.f};
    const int lt_s = wave >> 1, half_s = wave & 1;
#define ML_PHASE_C(cc, OG) do { const v4u hv = *(const LAS v4u*)(uintptr_t)(lds0 + ML_H + vrow * ML_VSTR + 16 * (tid & 7)); const v4u og = OG; \
        v4u o_; o_.x = cvtpk(bf_lo(hv.x) * fast_sig(bf_lo(og.x)), bf_hi(hv.x) * fast_sig(bf_hi(og.x))); o_.y = cvtpk(bf_lo(hv.y) * fast_sig(bf_lo(og.y)), bf_hi(hv.y) * fast_sig(bf_hi(og.y))); \
        o_.z = cvtpk(bf_lo(hv.z) * fast_sig(bf_lo(og.z)), bf_hi(hv.z) * fast_sig(bf_hi(og.z))); o_.w = cvtpk(bf_lo(hv.w) * fast_sig(bf_lo(og.w)), bf_hi(hv.w) * fast_sig(bf_hi(og.w))); \
        *(v4u*)(y + (rowbase + 64 * (cc) + vrow) * D + 512 + h * 128 + 64 * dh + 8 * (tid & 7)) = o_; } while (0)
    v4u ogp = (v4u){0u, 0u, 0u, 0u};
    __syncthreads();
    for (int c = 0; c < SEQ / 64; ++c) {
        const int par = c & 1, kb = c & 1; LAS float* tp = T0 + par * (ML_TPAR / 4);
        const unsigned Kb = lds0 + ML_K + kb * ML_KBUF;
        const bool more = (c + 1 < SEQ / 64);
        const v4u vcur = vr;
        float gn_lf = 0.f, gn_ig = 0.f;
        if (more) { ML_LOADS(c + 1); if (wave == 7 && c + 2 < SEQ / 64) { gn_lf = glf[64 * (c + 2) + lane]; gn_ig = gi[64 * (c + 2) + lane]; } }
        const v4u ogr = *(const v4u*)(zv + (size_t)(64 * c + vrow) * AB_N + 512);
        {
            bf16x8 qb[4], kf[2][4], nf[4];
            const int l = 16 * lt_s + c15;
#pragma unroll
            for (int ks = 0; ks < 4; ++ks) qb[ks] = *(const LAS bf16x8*)(uintptr_t)(lds0 + ML_Q + l * ML_STR + (32 * ks + 8 * kq) * 2);
#pragma unroll
            for (int jj = 0; jj < 2; ++jj)
#pragma unroll
                for (int ks = 0; ks < 4; ++ks) kf[jj][ks] = *(const LAS bf16x8*)(uintptr_t)(Kb + (16 * (2 * half_s + jj) + c15) * ML_STR + (32 * ks + 8 * kq) * 2);
#pragma unroll
            for (int ks = 0; ks < 4; ++ks) nf[ks] = *(const LAS bf16x8*)(uintptr_t)(Kb + (64 + c15) * ML_STR + (32 * ks + 8 * kq) * 2);
            const float Ml = tp[64 + l];
            const f32x4v bs0 = *(const LAS f32x4v*)(tp + 16 * (2 * half_s) + 4 * kq), bs1 = *(const LAS f32x4v*)(tp + 16 * (2 * half_s + 1) + 4 * kq);
            if (c > 0) { ML_PHASE_C(c - 1, ogp);
                { const float w_ = tp[256 + vrow]; const v4u u = vcur; const unsigned o_ = vrow * ML_VSTR + 16 * (tid & 7);
                    *(LAS v4u*)(uintptr_t)(lds0 + ML_V + o_) = u;
                    v4u x_; x_.x = cvtpk(bf_lo(u.x) * w_, bf_hi(u.x) * w_); x_.y = cvtpk(bf_lo(u.y) * w_, bf_hi(u.y) * w_); x_.z = cvtpk(bf_lo(u.z) * w_, bf_hi(u.z) * w_); x_.w = cvtpk(bf_lo(u.w) * w_, bf_hi(u.w) * w_);
                    *(LAS v4u*)(uintptr_t)(lds0 + ML_VW + o_) = x_; } }
            if (more && wave == 7) { ml_gate_tables(g_lf, g_ig, T0 + (par ^ 1) * (ML_TPAR / 4), mprev, lane); g_lf = gn_lf; g_ig = gn_ig; }
            ogp = ogr;
            SCHED_FENCE();
            f32x4v acc[2] = {{0.f, 0.f, 0.f, 0.f}, {0.f, 0.f, 0.f, 0.f}}, accn = {0.f, 0.f, 0.f, 0.f};
#pragma unroll
            for (int ks = 0; ks < 4; ++ks) { acc[0] = MFMA16(kf[0][ks], qb[ks], acc[0]); acc[1] = MFMA16(kf[1][ks], qb[ks], acc[1]); if (half_s == 0) accn = MFMA16(nf[ks], qb[ks], accn); }
#pragma unroll
            for (int jj = 0; jj < 2; ++jj) { const int st = 2 * half_s + jj; const f32x4v bs = jj ? bs1 : bs0;
                float p[4], sum = 0.f;
#pragma unroll
                for (int r = 0; r < 4; ++r) { const int sidx = 16 * st + 4 * kq + r; p[r] = (sidx <= l) ? acc[jj][r] * ex2(bs[r] - Ml) : 0.f; sum += p[r]; }
                sum = xsum32(xsum16(sum));
                denp[st * 64 + l] = sum;
                *(LAS unsigned long long*)(uintptr_t)(lds0 + ML_P + l * ML_PSTR + (16 * st + 4 * kq) * 2) = (unsigned long long)cvtpk(p[0], p[1]) | ((unsigned long long)cvtpk(p[2], p[3]) << 32);
            }
            if (half_s == 0) *(LAS float*)(uintptr_t)(kq == 0 ? lds0 + ML_DN + 4 * l : lds0 + ML_DUMMY + 8 * lane) = accn[0];
        }
        f32x4v hp[4];
        {
            bf16x8 cbf[2];
#pragma unroll
            for (int j = 0; j < 2; ++j) { v4u w_; w_.x = cvtpk(C[2 * j][0], C[2 * j][1]); w_.y = cvtpk(C[2 * j][2], C[2 * j][3]); w_.z = cvtpk(C[2 * j + 1][0], C[2 * j + 1][1]); w_.w = cvtpk(C[2 * j + 1][2], C[2 * j + 1][3]);
                cbf[j] = __builtin_bit_cast(bf16x8, w_); }
            unsigned long long qlo[4][2], qhi[4][2];
#pragma unroll
            for (int lt = 0; lt < 4; ++lt)
#pragma unroll
                for (int j = 0; j < 2; ++j) { const unsigned qa = lds0 + ML_Q + (16 * lt + c15) * ML_STR + (32 * (2 * rr + j) + 4 * kq) * 2;
                    qlo[lt][j] = *(const LAS unsigned long long*)(uintptr_t)qa; qhi[lt][j] = *(const LAS unsigned long long*)(uintptr_t)(qa + 32); }
            SCHED_FENCE();
#pragma unroll
            for (int lt = 0; lt < 4; ++lt) { hp[lt] = (f32x4v){0.f, 0.f, 0.f, 0.f};
#pragma unroll
                for (int j = 0; j < 2; ++j) { v4u w_; w_.x = (unsigned)qlo[lt][j]; w_.y = (unsigned)(qlo[lt][j] >> 32); w_.z = (unsigned)qhi[lt][j]; w_.w = (unsigned)(qhi[lt][j] >> 32);
                    hp[lt] = MFMA16(__builtin_bit_cast(bf16x8, w_), cbf[j], hp[lt]); } }
#pragma unroll
            for (int i = 0; i < 2; ++i)
#pragma unroll
                for (int r = 0; r < 4; ++r) xch[((wave * 2 + i) * 4 + r) * 64 + lane] = rr ? hp[i][r] : hp[2 + i][r];
        }
        __syncthreads();
        const float decay = tp[320];
        bf16x8 vb[2], pfr[2][2], vwb[2], wb[2], an[2], af[4][2]; float xp[2][4];
#pragma unroll
        for (int k2 = 0; k2 < 2; ++k2) { vb[k2] = tr_frag<ML_VSTR>(lds0 + ML_V + (32 * k2 + 8 * kq + ((lane & 15) >> 2)) * ML_VSTR + (16 * sl + 4 * (lane & 3)) * 2);
            vwb[k2] = tr_frag<ML_VSTR>(lds0 + ML_VW + (32 * k2 + 8 * kq + ((lane & 15) >> 2)) * ML_VSTR + (16 * sl + 4 * (lane & 3)) * 2);
            an[k2] = tr_frag<ML_STR>(Kb + (32 * k2 + 8 * kq + ((lane & 15) >> 2)) * ML_STR + (16 * wave + 4 * (lane & 3)) * 2);
            const f32x4v w0 = *(const LAS f32x4v*)(tp + 256 + 32 * k2 + 8 * kq), w1 = *(const LAS f32x4v*)(tp + 256 + 32 * k2 + 8 * kq + 4);
            v4u w_; w_.x = cvtpk(w0[0], w0[1]); w_.y = cvtpk(w0[2], w0[3]); w_.z = cvtpk(w1[0], w1[1]); w_.w = cvtpk(w1[2], w1[3]);
            if (c15 != 0) w_ = (v4u){0u, 0u, 0u, 0u};
            wb[k2] = __builtin_bit_cast(bf16x8, w_); }
#pragma unroll
        for (int i = 0; i < 2; ++i) {
#pragma unroll
            for (int r = 0; r < 4; ++r) xp[i][r] = xch[(((wave ^ 1) * 2 + i) * 4 + r) * 64 + lane];
#pragma unroll
            for (int k2 = 0; k2 < 2; ++k2) pfr[i][k2] = *(const LAS bf16x8*)(uintptr_t)(lds0 + ML_P + (16 * (2 * rr + i) + c15) * ML_PSTR + (32 * k2 + 8 * kq) * 2); }
#pragma unroll
        for (int Ti = 0; Ti < 4; ++Ti)
#pragma unroll
            for (int k2 = 0; k2 < 2; ++k2) af[Ti][k2] = tr_frag<ML_STR>(Kb + (32 * k2 + 8 * kq + ((lane & 15) >> 2)) * ML_STR + (16 * (4 * rr + Ti) + 4 * (lane & 3)) * 2);
        LAS float* rsw = (LAS float*)(lds + ML_RS) + wave * 128;
        { const float iwl = tp[128 + lane], fll = tp[192 + lane];
            const float den = iwl * dnr[lane] + ((denp[lane] + denp[64 + lane]) + (denp[128 + lane] + denp[192 + lane]));
            rsw[lane] = iwl; rsw[64 + lane] = __builtin_amdgcn_rcpf(fmaxf(fabsf(den), fll)); }
        f32x4v iw4[2], rs4[2];
#pragma unroll
        for (int i = 0; i < 2; ++i) { iw4[i] = *(const LAS f32x4v*)(rsw + 16 * (2 * rr + i) + 4 * kq); rs4[i] = *(const LAS f32x4v*)(rsw + 64 + 16 * (2 * rr + i) + 4 * kq); }
        SCHED_FENCE();
        {
            f32x4v hacc[2];
#pragma unroll
            for (int i = 0; i < 2; ++i) {
#pragma unroll
                for (int r = 0; r < 4; ++r) hacc[i][r] = ((rr ? hp[2 + i][r] : hp[i][r]) + xp[i][r]) * iw4[i][r];
#pragma unroll
                for (int k2 = 0; k2 < 2; ++k2) hacc[i] = MFMA16(pfr[i][k2], vb[k2], hacc[i]); }
#pragma unroll
            for (int i = 0; i < 2; ++i)
#pragma unroll
                for (int r = 0; r < 4; ++r) { const float hv = hacc[i][r] * rs4[i][r];
                    *(LAS bf16*)(uintptr_t)(lds0 + ML_H + (16 * (2 * rr + i) + 4 * kq + r) * ML_VSTR + (16 * sl + c15) * 2) = (bf16)(cvtpk(hv, 0.f) & 0xffffu); }
        }
        {
#pragma unroll
            for (int r = 0; r < 4; ++r) nacc[r] *= decay;
#pragma unroll
            for (int Ti = 0; Ti < 4; ++Ti) {
#pragma unroll
                for (int r = 0; r < 4; ++r) C[Ti][r] *= decay;
#pragma unroll
                for (int k2 = 0; k2 < 2; ++k2) C[Ti] = MFMA16(af[Ti][k2], vwb[k2], C[Ti]); }
#pragma unroll
            for (int k2 = 0; k2 < 2; ++k2) nacc = MFMA16(an[k2], wb[k2], nacc);
            *(LAS unsigned long long*)(uintptr_t)(c15 == 0 ? lds0 + ML_K + (kb ^ 1) * ML_KBUF + 64 * ML_STR + (16 * wave + 4 * kq) * 2 : lds0 + ML_DUMMY + 8 * lane) = (unsigned long long)cvtpk(nacc[0], nacc[1]) | ((unsigned long long)cvtpk(nacc[2], nacc[3]) << 32);
        }
        if (more) ML_CONV_STORE(kb ^ 1);
        __syncthreads();
    }
    ML_PHASE_C(SEQ / 64 - 1, ogp);
    __syncthreads();
#undef ML_PHASE_C
#undef ML_LOADS
#undef ML_CONV_STORE
#undef ML_V_STORE
}

constexpr int N_PHASES = 1 + 7 * DEPTH;
__global__ void __launch_bounds__(NTHREADS, 2) fwd_kernel(Args args) {
    extern __shared__ __attribute__((aligned(16))) unsigned char lds_raw[];
    LAS unsigned char* lds = (LAS unsigned char*)lds_raw;
    volatile LAS unsigned* MISC = (volatile LAS unsigned*)(lds + MISC_OFF);
    const int tid0 = threadIdx.x;
    const int G = gridDim.x;
    unsigned char* ws = args.ws;
    gu32* ctl = (gu32*)(ws + WS_CTL);
    for (int u = tid0; u < (LDS_BYTES - LDSCTL_OFF) / 4; u += NTHREADS) ((LAS unsigned*)(lds + LDSCTL_OFF))[u] = 0u;
    __syncthreads();
    XcdBarrier bar; bar.bar = (unsigned*)(ctl + CW_BAR); bar.x = 0; bar.st = nullptr;
    const int lo = args.ph_lo, hi = args.ph_hi;
    if (hi - lo > 1) bar = xcd_barrier_post((unsigned*)(ctl + CW_BAR), MISC + 8);
#define IN(k) (lo <= (k) && (k) < hi)
#define FRESH_TID() int tid = tid0; asm volatile("" : "+v"(tid)); const int lane = tid & 63, wave = __builtin_amdgcn_readfirstlane(tid >> 6); (void)lane; (void)wave
#define SEAM(k) do { if (IN(k) && IN((k) + 1)) xcd_barrier(bar); } while (0)

    float* mod = (float*)(ws + WS_MOD);
    float* gates = (float*)(ws + WS_GATE);
    bf16* A1 = (bf16*)(ws + WS_A1);
    bf16* Z = (bf16*)(ws + WS_Z);

    if (IN(0)) for (int rp = 0; rp < REP_PRO; ++rp) { const int tid = tid0, lane = tid & 63, wave = __builtin_amdgcn_readfirstlane(tid >> 6); if (rp) xcd_barrier(bar); phase_prologue(args, lds, tid, lane, wave, G); }
    SEAM(0);

    for (int l = 0; l < DEPTH; ++l) {
        const int base = 1 + 7 * l, j = l >> 1; const bool odd = (l & 1) != 0;
        bf16* XB = (bf16*)args.out;
        bf16* XB2 = (bf16*)(ws + WS_XB2);
        const float* modl = mod + (size_t)l * BATCH * MODW;
        if (IN(base + 0)) for (int rp = 0; rp < REP_NORM; ++rp) { FRESH_TID(); if (rp) xcd_barrier(bar);
            if (l == 0) phase_norm<8, false>(args.in[0], args.in[4] + l * D, modl + 0 * D, modl + 1 * D, A1, args.in[6] + (size_t)j * D * AB_LD, AB_LD, AB_N, args.in[7] + j * 4, args.in[8] + j * 4, gates, lds, tid, lane, wave, G);
            else if (!odd) phase_norm<8, true>(XB, args.in[4] + l * D, modl + 0 * D, modl + 1 * D, A1, args.in[6] + (size_t)j * D * AB_LD, AB_LD, AB_N, args.in[7] + j * 4, args.in[8] + j * 4, gates, lds, tid, lane, wave, G);
            else phase_norm<16, true>(XB, args.in[4] + l * D, modl + 0 * D, modl + 1 * D, A1, args.in[16] + (size_t)j * D * FX_LD, FX_LD, FX_N, nullptr, args.in[17] + j * 16, gates, lds, tid, lane, wave, G);
        }
        SEAM(base + 0);
        if (IN(base + 1)) for (int rp = 0; rp < REP_GIN; ++rp) { if (rp) xcd_barrier(bar);
            const int N = odd ? FX_N : AB_N;
            pg8::Gemm g{A1, odd ? (const bf16*)(ws + WS_WIN_O) + (size_t)j * FX_N * D : (const bf16*)(ws + WS_WIN_E) + (size_t)j * AB_N * D, M, N, D};
            pg8::StaticOrder S; S.init(M, N, G, (int)blockIdx.x);
            pg8::EpiIn E{Z, N, odd ? 1024 : 512, odd ? 2048 : 1024, odd ? args.in[18] + j * 64 : args.in[11] + j * 64, odd ? args.in[19] + j * 64 : args.in[12] + j * 64, 0.125f * LOG2E};
            pg8::gemm_phase<pg8::EpiIn, pg8::StaticOrder, true, true>(lds + RING_OFF, g, S, E);
        }
        SEAM(base + 1);
        if (IN(base + 2)) for (int rp = 0; rp < (odd ? REP_MIX_O : REP_MIX_E); ++rp) { FRESH_TID(); if (rp) xcd_barrier(bar);
            gu32* head = ctl + CW_QUEUE + 64 * (l + 4 * rp);
            if (!odd) {
#if USE_ML_MFMA
                phase_mlconv(Z, args.in[9] + (size_t)j * 4 * 1024, args.in[10] + (size_t)j * 1024, (bf16*)(ws + WS_QKC), tid, G);
                if (hi - lo > 1) xcd_barrier(bar);
#endif
                if (tid0 == 0) { const float lambda_init = 0.8f - 0.6f * expf(-0.3f * (float)l);
                    const float* lp = args.in[13] + j * 256; float s0 = 0.f, s1 = 0.f; for (int d = 0; d < 64; ++d) { s0 += lp[d] * lp[64 + d]; s1 += lp[128 + d] * lp[192 + d]; }
                    MISC[2] = __builtin_bit_cast(unsigned, expf(s0) - expf(s1) + lambda_init); MISC[3] = __builtin_bit_cast(unsigned, lambda_init);
                    const float* gq = args.in[11] + j * 64; const float* gk = args.in[12] + j * 64; float gm = 0.f; for (int d = 0; d < 64; ++d) gm = fmaxf(gm, fabsf(gq[d] * gk[d]));
                    MISC[4] = (8.0f * LOG2E * gm < 64.0f) ? 1u : 0u;
                    MISC[5] = __builtin_bit_cast(unsigned, 54.0f + 16.0f * LOG2E * gm); }
                for (;;) { int idx = queue_next(head, MISC, tid0); if (idx >= 64 * REP_ML + 1024 * REP_DA) break;
                    if (idx < 64 * REP_ML) idx &= 63; else idx = 64 + ((idx - 64 * REP_ML) & 1023);
                    int tid = tid0; asm volatile("" : "+v"(tid)); const int lane = tid & 63, wave = __builtin_amdgcn_readfirstlane(tid >> 6);
#if USE_ML_MFMA
                    if (idx < 64) mlstm_unit(idx >> 3, (idx >> 1) & 3, idx & 1, Z, (const bf16*)(ws + WS_QKC), gates, A1, lds, tid, lane, wave);
#else
                    if (idx < 32) mlstm_naive_unit(idx >> 2, idx & 3, Z, gates, args.in[9] + (size_t)j * 4 * 1024, args.in[10] + (size_t)j * 1024, A1, lds, tid);
#endif
                    else { const int u = idx - 64, qb = 31 - u / 32, bh = u % 32;
#if USE_DA_MFMA
                        da_unit(bh >> 2, bh & 3, qb, Z, A1, MISC, MISC[4] != 0u, args.in[14] + j * 128, lds, tid, lane, wave);
#ifdef DBG_DA_BOTH
                        da_naive_unit(bh >> 2, bh & 3, qb, Z, A1, args.in[13] + j * 256, args.in[14] + j * 128, l, lane, wave);
#endif
#else
                        da_naive_unit(bh >> 2, bh & 3, qb, Z, A1, args.in[13] + j * 256, args.in[14] + j * 128, l, lane, wave);
#endif
                    } }
            } else {
#if USE_FOX_MFMA
                if (tid0 == 0) { const float* gq = args.in[18] + j * 64; const float* gk = args.in[19] + j * 64; float gm = 0.f; for (int d = 0; d < 64; ++d) gm = fmaxf(gm, fabsf(gq[d] * gk[d]));
                    MISC[4] = (8.0f * LOG2E * gm < 64.0f) ? 1u : 0u;
                    MISC[5] = __builtin_bit_cast(unsigned, 54.0f + 16.0f * LOG2E * gm); }
                for (;;) { const int idx = queue_next(head, MISC, tid0); if (idx >= 2048) break;
                    int tid = tid0; asm volatile("" : "+v"(tid)); const int lane = tid & 63, wave = __builtin_amdgcn_readfirstlane(tid >> 6);
                    const int qb = 15 - idx / 128, bh = idx % 128; fox_unit(bh >> 4, bh & 15, qb, Z, gates, A1, MISC[4] != 0u, __builtin_bit_cast(float, (unsigned)MISC[5]), lds, tid, lane, wave); }
#else
                for (;;) { const int idx = queue_next(head, MISC, tid); if (idx >= 1024) break;
                    const int qb = 7 - idx / 128, bh = idx % 128; fox_naive_unit(bh >> 4, bh & 15, qb, Z, gates, A1, lds, tid, lane, wave); }
#endif
            }
        }
        SEAM(base + 2);
        if (IN(base + 3)) for (int rp = 0; rp < REP_GOUT; ++rp) { if (rp) xcd_barrier(bar);
            pg8::Gemm g{A1, (const bf16*)(ws + WS_WOUT) + (size_t)l * D * D, M, D, D};
            pg8::StaticOrder S; S.init(M, D, G, (int)blockIdx.x);
            const bool dry = (rp + 1 < REP_GOUT);
            const bool last = (l == DEPTH - 1); bf16* xo = last ? XB2 : XB;
            pg8::EpiRes E{args.in[0], (l == 0 && !dry) ? nullptr : (dry ? xo : XB), nullptr, xo, dry ? (const float*)(ws + WS_CTL + 512 * 1024) : modl + 2 * D, dry ? 0 : MODW};
            pg8::gemm_phase<pg8::EpiRes, pg8::StaticOrder, true, true>(lds + RING_OFF, g, S, E);
        }
        SEAM(base + 3);
        if (IN(base + 4)) for (int rp = 0; rp < REP_NORM; ++rp) { FRESH_TID(); if (rp) xcd_barrier(bar); phase_norm<0, true>((l == DEPTH - 1) ? XB2 : XB, args.in[5] + l * D, modl + 3 * D, modl + 4 * D, A1, nullptr, 0, 0, nullptr, nullptr, nullptr, lds, tid, lane, wave, G); }
        SEAM(base + 4);
        if (IN(base + 5)) for (int rp = 0; rp < REP_GUP; ++rp) { if (rp) xcd_barrier(bar);
            pg8::Gemm g{A1, (const bf16*)(ws + WS_WUP) + (size_t)l * NUP * D, M, NUP, D};
            pg8::StaticOrder S; S.init(M, NUP, G, (int)blockIdx.x);
            pg8::EpiSwiglu E{Z, FFH};
            pg8::gemm_phase<pg8::EpiSwiglu, pg8::StaticOrder, true, true>(lds + RING_OFF, g, S, E);
        }
        SEAM(base + 5);
        if (IN(base + 6)) for (int rp = 0; rp < REP_GDN; ++rp) { if (rp) xcd_barrier(bar);
            pg8::Gemm g{Z, (const bf16*)(ws + WS_WDN) + (size_t)l * D * FFH, M, D, FFH};
            pg8::StaticOrder S; S.init(M, D, G, (int)blockIdx.x);
            const bool dry = (rp + 1 < REP_GDN);
            const bool last = (l == DEPTH - 1);
            pg8::EpiRes E{nullptr, last ? XB2 : XB, (last && !dry) ? args.out : nullptr, (last && !dry) ? nullptr : (last ? XB2 : XB), dry ? (const float*)(ws + WS_CTL + 512 * 1024) : modl + 5 * D, dry ? 0 : MODW};
            pg8::gemm_phase<pg8::EpiRes, pg8::StaticOrder, true, true>(lds + RING_OFF, g, S, E);
        }
        SEAM(base + 6);
    }
    for (int rp = 0; rp < REP_BAR; ++rp) xcd_barrier(bar);
#undef IN
#undef SEAM
}

extern "C" void kernel_launch(void* const* d_in, const int* in_sizes, int n_in, void* d_out, int out_size, void* d_ws, size_t ws_size, hipStream_t stream) {
    static int grid = 0;
    if (grid == 0) {
        if (n_in != 24 || out_size != M * D || ws_size < WS_END) { fprintf(stderr, "kernel_launch: unexpected shapes (n_in %d, out %d, ws %zu); nothing launched\n", n_in, out_size, ws_size); grid = -1; return; }
        int dev = 0, cus = 0, per_cu = 0;
        if (hipGetDevice(&dev) != hipSuccess || hipDeviceGetAttribute(&cus, hipDeviceAttributeMultiprocessorCount, dev) != hipSuccess) { grid = -1; return; }
        if (hipFuncSetAttribute((const void*)fwd_kernel, hipFuncAttributeMaxDynamicSharedMemorySize, LDS_BYTES) != hipSuccess) { fprintf(stderr, "kernel_launch: hipFuncSetAttribute failed\n"); grid = -1; return; }
        if (hipOccupancyMaxActiveBlocksPerMultiprocessor(&per_cu, (const void*)fwd_kernel, NTHREADS, LDS_BYTES) != hipSuccess || per_cu < 1) { fprintf(stderr, "kernel_launch: occupancy query reports %d blocks per CU\n", per_cu); }
        (void)hipGetLastError();
        grid = cus;
    }
    if (grid < 0) return;
    if (hipMemsetAsync((char*)d_ws + WS_CTL, 0, CTL_ZERO_BYTES, stream) != hipSuccess) return;
    Args a{};
    for (int i = 0; i < 24; ++i) a.in[i] = (const float*)d_in[i];
    a.out = (float*)d_out; a.ws = (unsigned char*)d_ws;
#if MK_SINGLE
    a.ph_lo = 0; a.ph_hi = N_PHASES;
    hipLaunchKernelGGL(fwd_kernel, dim3(grid), dim3(NTHREADS), LDS_BYTES, stream, a);
#else
    for (int p = 0; p < N_PHASES; ++p) { a.ph_lo = p; a.ph_hi = p + 1; hipLaunchKernelGGL(fwd_kernel, dim3(grid), dim3(NTHREADS), LDS_BYTES, stream, a); }
#endif
}
```

```cpp
#include <hip/hip_runtime.h>
#include <cstdio>
#include <cstdint>
#include <cmath>
#ifndef MK_SINGLE
#define MK_SINGLE 1
#endif
#ifndef USE_FOX_MFMA
#define USE_FOX_MFMA 1
#endif
#ifndef USE_DA_MFMA
#define USE_DA_MFMA 1
#endif
#ifndef USE_ML_MFMA
#define USE_ML_MFMA 1
#endif
#ifndef REP_NORM
#define REP_NORM 1
#endif
#ifndef REP_GIN
#define REP_GIN 1
#endif
#ifndef REP_MIX_E
#define REP_MIX_E 1
#endif
#ifndef REP_MIX_O
#define REP_MIX_O 1
#endif
#ifndef REP_GOUT
#define REP_GOUT 1
#endif
#ifndef REP_GUP
#define REP_GUP 1
#endif
#ifndef REP_GDN
#define REP_GDN 1
#endif
#ifndef REP_ML
#define REP_ML 1
#endif
#ifndef REP_DA
#define REP_DA 1
#endif
#ifndef REP_PRO
#define REP_PRO 1
#endif
#ifndef REP_BAR
#define REP_BAR 0
#endif
#ifndef PROBE_V2
#define PROBE_V2 0
#endif
#ifndef PROBE_M2
#define PROBE_M2 0
#endif
namespace pg8 {
#define PG8_LAS __attribute__((address_space(3)))
typedef unsigned short bf16_t;
typedef short bf16x8 __attribute__((ext_vector_type(8)));
typedef float f32x4 __attribute__((ext_vector_type(4)));
typedef unsigned u32x4 __attribute__((ext_vector_type(4)));
constexpr int BM = 256, BK = 64, HALF = 128, HTB = HALF * BK * 2  , STAGE_BYTES = 8 * HTB, NXCD = 8, WGM = 8;

__host__ __device__ __forceinline__ int lds_byte(int r, int c) { const int st = (r >> 4) * 2 + (c >> 5), rr = r & 15, cc = c & 31, ob = rr * 64 + cc * 2; return st * 1024 + (ob ^ (((ob >> 9) & 1) << 5)); }
__host__ __device__ __forceinline__ void stage_rc(int b, int& R, int& C) { const int st = b / 1024, sb = b % 1024, swz = sb ^ (((sb >> 9) & 1) << 5); R = (st >> 1) * 16 + swz / 64; C = (st & 1) * 32 + (swz % 64) / 2; }
__host__ __device__ __forceinline__ int perm32(int rho) { const int n = rho >> 4, i = rho & 15; return 8 * (i >> 2) + 4 * n + (i & 3); }

struct Unit { int pm, pn; };
struct Gemm { const bf16_t* A; const bf16_t* Bt; int M, N, K; };

struct StaticOrder {
    int nM, nN, nwg, G, c;
    __host__ __device__ void init(int M, int N, int G_, int c_) { nM = M / BM; nN = N / BM; nwg = nM * nN; G = G_; c = c_; }
    __host__ __device__ bool next(int i, Unit& u) const {
        const long L = (long)i * G + c; if (L >= nwg) return false;
        int wgid = (int)L; { const int q = nwg / NXCD, r = nwg % NXCD, xcd = wgid % NXCD, off = wgid / NXCD; wgid = (xcd < r ? xcd * (q + 1) : r * (q + 1) + (xcd - r) * q) + off; }
        const int nig = WGM * nN, gid = wgid / nig, fm = gid * WGM, gsz = (nM - fm) < WGM ? (nM - fm) : WGM;
        u.pm = fm + ((wgid % nig) % gsz); u.pn = (wgid % nig) / gsz; return true;
    }
    __device__ __forceinline__ void a_ready(const Unit&) const {}
    __device__ __forceinline__ void done(const Unit&) const {}
};

__device__ __forceinline__ unsigned cvt_pk_bf16(float lo, float hi) { unsigned r; asm volatile("v_cvt_pk_bf16_f32 %0, %1, %2" : "=v"(r) : "v"(lo), "v"(hi)); return r; }
typedef float f32x2 __attribute__((ext_vector_type(2)));
constexpr int SEQ_ROWS = 4096;
__device__ __forceinline__ float fast_sigmoid(float x) { return __builtin_amdgcn_rcpf(1.0f + __builtin_amdgcn_exp2f(-1.4426950408889634f * x)); }
struct EpiIn {
    static constexpr bool PERM = true, AFTER_DRAIN = false;
    bf16_t* Z; int ldz; int nq_end, nk_end; const float* gq; const float* gk; float qscale;
    __device__ __forceinline__ void operator()(const f32x4 (&acc)[2][2][4][2], const Unit& u, int wr, int wc, int fr, int fq) const {
        const int c0 = u.pn * BM + 64 * wc;
        const int mode = c0 < nq_end ? 1 : (c0 < nk_end ? 2 : 0);
        const int row0 = u.pm * BM + wr * 64 + fr;
        if (mode != 0) {
            const float* gp = (mode == 1 ? gq : gk) + 8 * fq;
            const float sc = (mode == 1) ? qscale : 1.0f;
            f32x4 gv[2][2];
#pragma unroll
            for (int bj = 0; bj < 2; ++bj)
#pragma unroll
                for (int n = 0; n < 2; ++n) gv[bj][n] = *(const f32x4*)(gp + 32 * bj + 4 * n);
#pragma unroll
            for (int ai = 0; ai < 2; ++ai)
#pragma unroll
                for (int m = 0; m < 4; ++m) {
                    float ss = 0.f;
#pragma unroll
                    for (int bj = 0; bj < 2; ++bj)
#pragma unroll
                        for (int n = 0; n < 2; ++n) { const f32x4 x = acc[ai][bj][m][n]; ss += (x[0] * x[0] + x[1] * x[1]) + (x[2] * x[2] + x[3] * x[3]); }
                    ss += __shfl_xor(ss, 16); ss += __shfl_xor(ss, 32);
                    const float r = sc / sqrtf(ss * (1.0f / 64.0f) + 1e-6f);
                    bf16_t* rowp = Z + (size_t)(row0 + ai * HALF + m * 16) * ldz + c0 + 8 * fq;
#pragma unroll
                    for (int bj = 0; bj < 2; ++bj) { const f32x4 v0 = acc[ai][bj][m][0] * r * gv[bj][0], v1 = acc[ai][bj][m][1] * r * gv[bj][1];
                        u32x4 w; w.x = cvt_pk_bf16(v0[0], v0[1]); w.y = cvt_pk_bf16(v0[2], v0[3]); w.z = cvt_pk_bf16(v1[0], v1[1]); w.w = cvt_pk_bf16(v1[2], v1[3]);
                        *(u32x4*)(rowp + 32 * bj) = w; }
                }
        } else {
#pragma unroll
            for (int ai = 0; ai < 2; ++ai)
#pragma unroll
                for (int m = 0; m < 4; ++m) {
                    bf16_t* rowp = Z + (size_t)(row0 + ai * HALF + m * 16) * ldz + c0 + 8 * fq;
#pragma unroll
                    for (int bj = 0; bj < 2; ++bj) { const f32x4 v0 = acc[ai][bj][m][0], v1 = acc[ai][bj][m][1];
                        u32x4 w; w.x = cvt_pk_bf16(v0[0], v0[1]); w.y = cvt_pk_bf16(v0[2], v0[3]); w.z = cvt_pk_bf16(v1[0], v1[1]); w.w = cvt_pk_bf16(v1[2], v1[3]);
                        *(u32x4*)(rowp + 32 * bj) = w; }
                }
        }
    }
};
struct EpiRes {
    static constexpr bool PERM = true, AFTER_DRAIN = false;
    const float* xin; const bf16_t* xin_bf; float* out; bf16_t* out_bf; const float* gate; int gstride;
    __device__ __forceinline__ void operator()(const f32x4 (&acc)[2][2][4][2], const Unit& u, int wr, int wc, int fr, int fq) const {
        const int b = (u.pm * BM) / SEQ_ROWS;
        const int col0 = u.pn * BM + wc * 32 + 8 * fq;
        const float* gb = gate + (size_t)b * gstride + col0;
        f32x4 gv[2][2];
#pragma unroll
        for (int bj = 0; bj < 2; ++bj)
#pragma unroll
            for (int n = 0; n < 2; ++n) gv[bj][n] = *(const f32x4*)(gb + bj * HALF + 4 * n);
        const int row0 = u.pm * BM + wr * 64 + fr;
#pragma unroll
        for (int ai = 0; ai < 2; ++ai) {
            u32x4 xb[4][2];
            if (xin_bf) {
#pragma unroll
                for (int m = 0; m < 4; ++m) { const size_t off = (size_t)(row0 + ai * HALF + m * 16) * 1024 + col0;
#pragma unroll
                    for (int bj = 0; bj < 2; ++bj) xb[m][bj] = *(const u32x4*)(xin_bf + off + bj * HALF); } }
#pragma unroll
            for (int m = 0; m < 4; ++m) { const size_t off = (size_t)(row0 + ai * HALF + m * 16) * 1024 + col0;
#pragma unroll
                for (int bj = 0; bj < 2; ++bj) {
                    f32x4 x0, x1;
                    if (xin_bf) { const u32x4 w = xb[m][bj];
                        x0 = (f32x4){__builtin_bit_cast(float, w.x << 16), __builtin_bit_cast(float, w.x & 0xffff0000u), __builtin_bit_cast(float, w.y << 16), __builtin_bit_cast(float, w.y & 0xffff0000u)};
                        x1 = (f32x4){__builtin_bit_cast(float, w.z << 16), __builtin_bit_cast(float, w.z & 0xffff0000u), __builtin_bit_cast(float, w.w << 16), __builtin_bit_cast(float, w.w & 0xffff0000u)}; }
                    else { x0 = *(const f32x4*)(xin + off + bj * HALF); x1 = *(const f32x4*)(xin + off + bj * HALF + 4); }
                    const f32x4 v0 = x0 + gv[bj][0] * acc[ai][bj][m][0], v1 = x1 + gv[bj][1] * acc[ai][bj][m][1];
                    if (out_bf) { u32x4 w; w.x = cvt_pk_bf16(v0[0], v0[1]); w.y = cvt_pk_bf16(v0[2], v0[3]); w.z = cvt_pk_bf16(v1[0], v1[1]); w.w = cvt_pk_bf16(v1[2], v1[3]); *(u32x4*)(out_bf + off + bj * HALF) = w; }
                    else { *(f32x4*)(out + off + bj * HALF) = v0; *(f32x4*)(out + off + bj * HALF + 4) = v1; }
                } }
            asm volatile("" ::: "memory"); }
    }
};
struct EpiSwiglu {
    static constexpr bool PERM = true, AFTER_DRAIN = false;
    bf16_t* H; int ldh;
    __device__ __forceinline__ void operator()(const f32x4 (&acc)[2][2][4][2], const Unit& u, int wr, int wc, int fr, int fq) const {
        const int row0 = u.pm * BM + wr * 64 + fr, col0 = u.pn * HALF + wc * 32 + 8 * fq;
#pragma unroll
        for (int ai = 0; ai < 2; ++ai)
#pragma unroll
            for (int m = 0; m < 4; ++m) {
                f32x4 v[2];
#pragma unroll
                for (int n = 0; n < 2; ++n) { const f32x4 a = acc[ai][0][m][n], g = acc[ai][1][m][n];
#pragma unroll
                    for (int i = 0; i < 4; ++i) v[n][i] = a[i] * fast_sigmoid(a[i]) * g[i]; }
                u32x4 w; w.x = cvt_pk_bf16(v[0][0], v[0][1]); w.y = cvt_pk_bf16(v[0][2], v[0][3]); w.z = cvt_pk_bf16(v[1][0], v[1][1]); w.w = cvt_pk_bf16(v[1][2], v[1][3]);
                *(u32x4*)(H + (size_t)(row0 + ai * HALF + m * 16) * ldh + col0) = w;
            }
    }
};
template <class Epi, class Sched, bool ALIGN_EPI = false, bool SP2 = false>
__device__ __forceinline__ void gemm_phase(PG8_LAS unsigned char* lds, const Gemm g, const Sched& S, const Epi& E) {
    int tid = threadIdx.x; asm volatile("" : "+v"(tid));
    const int wid = __builtin_amdgcn_readfirstlane(tid >> 6), lane = tid & 63, wr = wid >> 2, wc = wid & 3, fr = lane & 15, fq = lane >> 4;
    const int K = g.K, nt = K / BK;
    unsigned voffA[2], voffB[2];
#pragma unroll
    for (int i = 0; i < 2; ++i) { int R, C; stage_rc(tid * 16 + i * 8192, R, C); const int Rb = Epi::PERM ? ((R & ~31) + perm32(R & 31)) : R;
        voffA[i] = (unsigned)(R * K + C) * 2u; voffB[i] = (unsigned)(Rb * K + C) * 2u; }
    const size_t kstep = (size_t)(BK * 2);
    const size_t hstep = (size_t)HALF * K * 2;
    const size_t tstep = 2 * hstep;
    const unsigned ldsw = (unsigned)wid * 1024u;
    const int aoff = lds_byte(wr * 64 + fr, fq * 8), boff = lds_byte(wc * 32 + fr, fq * 8);
#define PG8_SA(b, h) (((b) * 2 + (h)) * HTB)
#define PG8_SB(b, h) ((4 + (b) * 2 + (h)) * HTB)
#define PG8_STAGE(bufoff, gbase, voff) do { _Pragma("unroll") for (int _i = 0; _i < 2; ++_i) \
        __builtin_amdgcn_global_load_lds((const unsigned*)((const char*)(gbase) + (voff)[_i]), (PG8_LAS unsigned*)(lds + (bufoff) + ldsw + _i * 8192), 16, 0, 0); } while (0)
#define PG8_LDA(dst, b, h) do { _Pragma("unroll") for (int m = 0; m < 4; ++m) _Pragma("unroll") for (int k = 0; k < 2; ++k) dst[m][k] = *(const PG8_LAS bf16x8*)(lds + PG8_SA(b, h) + aoff + m * 2048 + k * 1024); } while (0)
#define PG8_LDB(dst, b, h) do { _Pragma("unroll") for (int n = 0; n < 2; ++n) _Pragma("unroll") for (int k = 0; k < 2; ++k) dst[n][k] = *(const PG8_LAS bf16x8*)(lds + PG8_SB(b, h) + boff + n * 2048 + k * 1024); } while (0)
#define PG8_MMA(ai, bj, At, Bt) do { __builtin_amdgcn_s_setprio(1); _Pragma("unroll") for (int m = 0; m < 4; ++m) _Pragma("unroll") for (int n = 0; n < 2; ++n) _Pragma("unroll") for (int k = 0; k < 2; ++k) \
        acc[ai][bj][m][n] = __builtin_amdgcn_mfma_f32_16x16x32_bf16(Bt[n][k], At[m][k], acc[ai][bj][m][n], 0, 0, 0); __builtin_amdgcn_s_setprio(0); } while (0)
#define PG8_WAIT_V(n) asm volatile("s_waitcnt vmcnt(" #n ")" ::: "memory")
#define PG8_WAIT_L(n) asm volatile("s_waitcnt lgkmcnt(" #n ")" ::: "memory")
#define PG8_BAR __builtin_amdgcn_s_barrier()
#define PG8_SCHED __builtin_amdgcn_sched_barrier(0)
    Unit cur, nxt; int ui = 0;
    if (!S.next(0, cur)) return;
    f32x4 acc[2][2][4][2];
#pragma unroll
    for (int a = 0; a < 2; ++a)
#pragma unroll
        for (int b = 0; b < 2; ++b)
#pragma unroll
            for (int m = 0; m < 4; ++m)
#pragma unroll
                for (int n = 0; n < 2; ++n) acc[a][b][m][n] = (f32x4){0.f, 0.f, 0.f, 0.f};
    bf16x8 At[4][2], B0[2][2], B1[2][2];
    const char* cA = (const char*)g.A + (size_t)cur.pm * tstep; const char* cB = (const char*)g.Bt + (size_t)cur.pn * tstep;
    S.a_ready(cur);
    if constexpr (SP2) {
        PG8_STAGE(PG8_SB(0, 0), cB, voffB); PG8_STAGE(PG8_SB(0, 1), cB + hstep, voffB); PG8_STAGE(PG8_SA(0, 0), cA, voffA); PG8_STAGE(PG8_SA(0, 1), cA + hstep, voffA);
        if (wr == 1) PG8_BAR;
        PG8_WAIT_V(2); PG8_BAR;
        PG8_STAGE(PG8_SB(1, 0), cB + kstep, voffB); PG8_STAGE(PG8_SA(1, 0), cA + kstep, voffA); PG8_STAGE(PG8_SB(1, 1), cB + hstep + kstep, voffB);
        PG8_WAIT_V(6); PG8_BAR;
    } else {
        PG8_STAGE(PG8_SB(0, 0), cB, voffB); PG8_STAGE(PG8_SA(0, 0), cA, voffA); PG8_STAGE(PG8_SB(0, 1), cB + hstep, voffB); PG8_STAGE(PG8_SA(0, 1), cA + hstep, voffA);
        if (wr == 1) PG8_BAR;
        PG8_WAIT_V(4); PG8_BAR;
        PG8_STAGE(PG8_SB(1, 0), cB + kstep, voffB); PG8_STAGE(PG8_SA(1, 0), cA + kstep, voffA); PG8_STAGE(PG8_SB(1, 1), cB + hstep + kstep, voffB);
        PG8_WAIT_V(6); PG8_BAR;
    }
    for (;;) {
        const bool has_next = S.next(ui + 1, nxt);
        const char* nA = has_next ? (const char*)g.A + (size_t)nxt.pm * tstep : cA; const char* nB = has_next ? (const char*)g.Bt + (size_t)nxt.pn * tstep : cB;
        for (int t = 0; t < nt; t += 2) {
            const bool last = (t == nt - 2);
            const char* a1 = cA + (size_t)(t + 1) * kstep;
            const char* a2 = last ? nA : cA + (size_t)(t + 2) * kstep; const char* b2 = last ? nB : cB + (size_t)(t + 2) * kstep;
            const char* a3 = a2 + kstep; const char* b3 = b2 + kstep;
            if (last && has_next) S.a_ready(nxt);
            if constexpr (SP2) {
            PG8_LDB(B0, 0, 0); PG8_LDB(B1, 0, 1); PG8_SCHED; PG8_LDA(At, 0, 0); PG8_STAGE(PG8_SA(1, 1), a1 + hstep, voffA);
            PG8_WAIT_V(8); PG8_WAIT_L(0); PG8_BAR; PG8_MMA(0, 0, At, B0); PG8_MMA(0, 1, At, B1); PG8_BAR; PG8_SCHED;
            PG8_LDA(At, 0, 1); PG8_STAGE(PG8_SB(0, 0), b2, voffB); PG8_STAGE(PG8_SB(0, 1), b2 + hstep, voffB); PG8_STAGE(PG8_SA(0, 0), a2, voffA);
            PG8_WAIT_V(8); PG8_WAIT_L(0); PG8_BAR; PG8_MMA(1, 0, At, B0); PG8_MMA(1, 1, At, B1); PG8_BAR; PG8_SCHED;
            PG8_LDB(B0, 1, 0); PG8_LDB(B1, 1, 1); PG8_SCHED; PG8_LDA(At, 1, 0); PG8_STAGE(PG8_SA(0, 1), a2 + hstep, voffA);
            PG8_WAIT_V(8); PG8_WAIT_L(0); PG8_BAR; PG8_MMA(0, 0, At, B0); PG8_MMA(0, 1, At, B1); PG8_BAR; PG8_SCHED;
            PG8_LDA(At, 1, 1); PG8_STAGE(PG8_SB(1, 0), b3, voffB); PG8_STAGE(PG8_SB(1, 1), b3 + hstep, voffB); PG8_STAGE(PG8_SA(1, 0), a3, voffA);
            PG8_WAIT_V(8); PG8_WAIT_L(0); PG8_BAR; PG8_MMA(1, 0, At, B0); PG8_MMA(1, 1, At, B1); PG8_BAR; PG8_SCHED;
            } else {
            PG8_LDB(B0, 0, 0); PG8_SCHED; PG8_LDA(At, 0, 0); PG8_STAGE(PG8_SA(1, 1), a1 + hstep, voffA);
            PG8_WAIT_L(8); PG8_BAR; PG8_WAIT_L(0); PG8_MMA(0, 0, At, B0); PG8_BAR; PG8_SCHED;
            PG8_LDB(B1, 0, 1); PG8_STAGE(PG8_SB(0, 0), b2, voffB);
            PG8_BAR; PG8_WAIT_L(0); PG8_MMA(0, 1, At, B1); PG8_BAR;
            PG8_LDA(At, 0, 1); PG8_STAGE(PG8_SA(0, 0), a2, voffA);
            PG8_BAR; PG8_WAIT_L(0); PG8_MMA(1, 0, At, B0); PG8_BAR; PG8_SCHED;
            PG8_STAGE(PG8_SB(0, 1), b2 + hstep, voffB);
            PG8_WAIT_V(6); PG8_BAR; PG8_MMA(1, 1, At, B1); PG8_BAR;
            PG8_LDB(B0, 1, 0); PG8_SCHED; PG8_LDA(At, 1, 0); PG8_STAGE(PG8_SA(0, 1), a2 + hstep, voffA);
            PG8_WAIT_L(8); PG8_BAR; PG8_WAIT_L(0); PG8_MMA(0, 0, At, B0); PG8_BAR; PG8_SCHED;
            PG8_LDB(B1, 1, 1); PG8_STAGE(PG8_SB(1, 0), b3, voffB);
            PG8_BAR; PG8_WAIT_L(0); PG8_MMA(0, 1, At, B1); PG8_BAR;
            PG8_LDA(At, 1, 1); PG8_STAGE(PG8_SA(1, 0), a3, voffA);
            PG8_BAR; PG8_WAIT_L(0); PG8_MMA(1, 0, At, B0); PG8_BAR; PG8_SCHED;
            PG8_STAGE(PG8_SB(1, 1), b3 + hstep, voffB);
            PG8_WAIT_V(6); PG8_BAR; PG8_MMA(1, 1, At, B1); PG8_BAR;
            }
        }
        if constexpr (ALIGN_EPI) { if (wr == 0) PG8_BAR; }
        if constexpr (!Epi::AFTER_DRAIN) { E(acc, cur, wr, wc, fr, fq); S.done(cur); }
        if (!has_next) break;
#pragma unroll
        for (int a = 0; a < 2; ++a)
#pragma unroll
            for (int b = 0; b < 2; ++b)
#pragma unroll
                for (int m = 0; m < 4; ++m)
#pragma unroll
                    for (int n = 0; n < 2; ++n) acc[a][b][m][n] = (f32x4){0.f, 0.f, 0.f, 0.f};
        cur = nxt; cA = nA; cB = nB; ++ui;
        if constexpr (ALIGN_EPI) { if (wr == 1) PG8_BAR; }
    }
    PG8_WAIT_V(0);
    if constexpr (!ALIGN_EPI) { if (wr == 0) PG8_BAR; }
    PG8_BAR;
    if constexpr (Epi::AFTER_DRAIN) { E.fused(acc, cur, wr, wc, fr, fq, lds, wid, lane); S.done(cur); }
#undef PG8_SA
#undef PG8_SB
#undef PG8_STAGE
#undef PG8_LDA
#undef PG8_LDB
#undef PG8_MMA
#undef PG8_WAIT_V
#undef PG8_WAIT_L
#undef PG8_BAR
#undef PG8_SCHED
}
}
#include <type_traits>
constexpr int NWAVES = 8, NTHREADS = NWAVES * 64;
constexpr int D = 1024, BATCH = 8, SEQ = 4096, DEPTH = 4, M = BATCH * SEQ;
constexpr int FFH = 2816, NUP = 2 * FFH;
constexpr int AB_LD = 3592, AB_N = 3584;
constexpr int FX_LD = 3088, FX_N = 3072;
constexpr int MODW = 6 * D;
constexpr float EPS = 1e-6f, LOG2E = 1.4426950408889634f;
static_assert(pg8::SEQ_ROWS == SEQ, "row -> batch");

constexpr size_t MiB = 1u << 20;
constexpr size_t WS_CTL = 0, CTL_ZERO_BYTES = 1 * MiB;
constexpr size_t WS_MOD = 1 * MiB;
constexpr size_t WS_GATE = 2 * MiB;
constexpr size_t WS_WIN_E = 4 * MiB;
constexpr size_t WS_WIN_O = 18 * MiB;
constexpr size_t WS_WOUT = 30 * MiB;
constexpr size_t WS_WUP = 38 * MiB;
constexpr size_t WS_WDN = 82 * MiB;
constexpr size_t WS_A1 = 104 * MiB;
constexpr size_t WS_Z = 168 * MiB;
constexpr size_t WS_XB2 = 344 * MiB;
constexpr size_t WS_QKC = 392 * MiB;
constexpr size_t WS_END = 456 * MiB;
constexpr int CW_BAR = 4096;
constexpr int CW_QUEUE = 16384;

constexpr int RING_OFF = 0, RING_BYTES = 131072;
constexpr int LDSCTL_OFF = RING_BYTES, MISC_OFF = LDSCTL_OFF + 320;
constexpr int LDS_BYTES = 147456;

#define GAS __attribute__((address_space(1)))
#define LAS __attribute__((address_space(3)))
typedef unsigned short bf16;
typedef unsigned v4u __attribute__((ext_vector_type(4)));
typedef float f32x4 __attribute__((ext_vector_type(4)));
typedef short bf16x8 __attribute__((ext_vector_type(8)));
typedef GAS unsigned gu32;
typedef GAS unsigned long long gu64;
#define RLX_AGENT __ATOMIC_RELAXED, __HIP_MEMORY_SCOPE_AGENT
#define LDS_WAIT() asm volatile("s_waitcnt lgkmcnt(0)" ::: "memory")
#define VM_WAIT() asm volatile("s_waitcnt vmcnt(0)" ::: "memory")
__device__ __forceinline__ unsigned long long rt() { return __builtin_amdgcn_s_memrealtime(); }
__device__ __forceinline__ unsigned f2bf(float f) { unsigned u = __builtin_bit_cast(unsigned, f); return (u + 0x7fffu + ((u >> 16) & 1u)) >> 16; }
__device__ __forceinline__ unsigned pk2(float lo, float hi) { return f2bf(lo) | (f2bf(hi) << 16); }

#define XB_TMO      128
#define XB_XCNT(j)  (256  + 64 * (j))
#define XB_XSUB(j)  (1280 + 64 * (j))
#define XB_XGEN(j)  (2304 + 64 * (j))
#define XB_TOP      3328
#define XB_TOPGEN   3392
#define XCD_BAR_WORDS 3456
#define XB_SPIN_CAP (1u << 24)

__device__ __forceinline__ unsigned xb_ld(unsigned* p)              { return __hip_atomic_load(p, __ATOMIC_RELAXED, __HIP_MEMORY_SCOPE_AGENT); }
__device__ __forceinline__ unsigned xb_add(unsigned* p, unsigned v) { return __hip_atomic_fetch_add(p, v, __ATOMIC_RELAXED, __HIP_MEMORY_SCOPE_AGENT); }
__device__ __forceinline__ unsigned xb_xcc_id() { return (unsigned)__builtin_amdgcn_s_getreg((3 << 11) | 20) & 0xFu; }
#define XB_SPIN(cond, bar) do { unsigned _sp = 0; while (cond) { __builtin_amdgcn_s_sleep(1); \
    if ((++_sp & 255u) == 0u) { if (xb_ld(&(bar)[XB_TMO])) break; if (_sp > XB_SPIN_CAP) { atomicAdd(&(bar)[XB_TMO], 1u); break; } } } } while (0)

struct XcdBarrier {
    unsigned* bar; unsigned x;
    volatile LAS unsigned* st;
};

__device__ __forceinline__ XcdBarrier xcd_barrier_post(unsigned* bar, volatile LAS unsigned* st) {
    XcdBarrier b; b.bar = bar; b.x = xb_xcc_id(); b.st = st;
    if (threadIdx.x == 0) (void)xb_add(&bar[XB_XCNT(b.x)], 1u);
    return b;
}
__device__ __forceinline__ void xcd_barrier_complete(unsigned* bar, unsigned x, unsigned& nloc, unsigned& nx) {
    const unsigned G = gridDim.x * gridDim.y * gridDim.z;
    unsigned sum, cnt, mine, sp = 0u;
    for (;;) {
        sum = 0u; cnt = 0u; mine = 0u;
#pragma unroll
        for (unsigned j = 0; j < 16; ++j) { const unsigned c = xb_ld(&bar[XB_XCNT(j)]); sum += c; cnt += (c > 0u) ? 1u : 0u; mine = (j == x) ? c : mine; }
        if (sum == G) break;
        __builtin_amdgcn_s_sleep(1);
        if ((++sp & 255u) == 0u) { if (xb_ld(&bar[XB_TMO])) break; if (sp > XB_SPIN_CAP) { atomicAdd(&bar[XB_TMO], 1u); break; } }
    }
    nloc = mine > 0u ? mine : 1u; nx = cnt > 0u ? cnt : 1u;
}

__device__ __forceinline__ void xcd_barrier(const XcdBarrier& b) {
    asm volatile("s_waitcnt vmcnt(0)" ::: "memory");
    __syncthreads();
    if (threadIdx.x == 0) {
        unsigned* bar = b.bar;
        __builtin_amdgcn_s_waitcnt(0);
        unsigned nloc = b.st[0], nx = b.st[1];
        if (nloc == 0u) { xcd_barrier_complete(bar, b.x, nloc, nx); b.st[0] = nloc; b.st[1] = nx; }
        const unsigned old = xb_add(&bar[XB_XSUB(b.x)], 1u);
        const unsigned gen = old / nloc;
        if (old + 1u == (gen + 1u) * nloc) {
            __builtin_amdgcn_fence(__ATOMIC_RELEASE, "agent");
            asm volatile("s_waitcnt vmcnt(0)" ::: "memory");
            const unsigned og = xb_add(&bar[XB_TOP], 1u);
            const unsigned tg = og / nx;
            if (og + 1u == (tg + 1u) * nx) xb_add(&bar[XB_TOPGEN], 1u);
            else XB_SPIN(xb_ld(&bar[XB_TOPGEN]) == tg, bar);
            __builtin_amdgcn_fence(__ATOMIC_ACQUIRE, "agent");
            xb_add(&bar[XB_XGEN(b.x)], 1u);
            asm volatile("s_waitcnt vmcnt(0)" ::: "memory");
        } else {
            XB_SPIN(xb_ld(&bar[XB_XGEN(b.x)]) == gen, bar);
            __builtin_amdgcn_fence(__ATOMIC_ACQUIRE, "agent");
            asm volatile("s_waitcnt vmcnt(0)" ::: "memory");
        }
    }
    __syncthreads();
}

__device__ __forceinline__ float bf_lo(unsigned u) { return __builtin_bit_cast(float, u << 16); }
__device__ __forceinline__ float bf_hi(unsigned u) { return __builtin_bit_cast(float, u & 0xffff0000u); }
__device__ __forceinline__ float bf1(bf16 u) { return __builtin_bit_cast(float, (unsigned)u << 16); }
__device__ __forceinline__ float ex2(float x) { return __builtin_amdgcn_exp2f(x); }
__device__ __forceinline__ float wave_sum(float v) {
#pragma unroll
    for (int o = 1; o < 64; o <<= 1) v += __shfl_xor(v, o);
    return v;
}
__device__ __forceinline__ float fast_sig(float x) { return __builtin_amdgcn_rcpf(1.0f + __builtin_amdgcn_exp2f(-1.4426950408889634f * x)); }
__device__ __forceinline__ float log_sigmoid(float x) { return fminf(x, 0.f) - log1pf(__expf(-fabsf(x))); }

struct Args { const float* in[24]; float* out; unsigned char* ws; int ph_lo, ph_hi; };

typedef short s16x4 __attribute__((ext_vector_type(4)));
__device__ __forceinline__ s16x4 ds_tr16(unsigned addr) { return __builtin_bit_cast(s16x4, __builtin_amdgcn_ds_read_tr16_b64_v4i16((LAS s16x4*)(uintptr_t)addr)); }
typedef float f32x2_t __attribute__((ext_vector_type(2))); typedef __bf16 bf16x2_t __attribute__((ext_vector_type(2)));
__device__ __forceinline__ unsigned cvtpk(float lo, float hi) { const f32x2_t v = {lo, hi}; return __builtin_bit_cast(unsigned, __builtin_convertvector(v, bf16x2_t)); }

constexpr int CV_TS = 528;
__device__ __forceinline__ int cv_dst_row(int map, int n) {
    if (map == 1) { const int q = (n >> 5) & 7; return (n & ~255) + ((q & 1) * 4 + (q >> 1)) * 32 + (n & 31); }
    if (map >= 2) return (n >> 7) * 256 + (map - 2) * 128 + (n & 127);
    return n; }
struct CvTile { const float* W; bf16* WT; int ld, Kd, k0, n0, map; };
__device__ __forceinline__ CvTile cv_decode(const Args& a, unsigned char* ws, int t) {
    constexpr int T_E = 16 * (AB_N / 256), T_O = 16 * (FX_N / 256), T_OUT = 16 * 4, T_UP = 16 * (FFH / 256), T_DN = (FFH / 64) * 4;
    CvTile c;
    if (t < 2 * T_E) { const int j = t / T_E, r = t % T_E, nb = AB_N / 256; c = {a.in[6] + (size_t)j * D * AB_LD, (bf16*)(ws + WS_WIN_E) + (size_t)j * AB_N * D, AB_LD, D, 64 * (r / nb), 256 * (r % nb), 1}; return c; }
    t -= 2 * T_E;
    if (t < 2 * T_O) { const int j = t / T_O, r = t % T_O, nb = FX_N / 256; c = {a.in[16] + (size_t)j * D * FX_LD, (bf16*)(ws + WS_WIN_O) + (size_t)j * FX_N * D, FX_LD, D, 64 * (r / nb), 256 * (r % nb), 1}; return c; }
    t -= 2 * T_O;
    if (t < 4 * T_OUT) { const int l = t / T_OUT, r = t % T_OUT; c = {((l & 1) ? a.in[20] : a.in[15]) + (size_t)(l >> 1) * D * D, (bf16*)(ws + WS_WOUT) + (size_t)l * D * D, D, D, 64 * (r / 4), 256 * (r % 4), 0}; return c; }
    t -= 4 * T_OUT;
    if (t < 8 * T_UP) { const int lw = t / T_UP, r = t % T_UP, l = lw >> 1, w3 = lw & 1, nb = FFH / 256; c = {(w3 ? a.in[22] : a.in[21]) + (size_t)l * D * FFH, (bf16*)(ws + WS_WUP) + (size_t)l * NUP * D, FFH, D, 64 * (r / nb), 256 * (r % nb), 2 + w3}; return c; }
    t -= 8 * T_UP;
    { const int l = t / T_DN, r = t % T_DN; c = {a.in[23] + (size_t)l * FFH * D, (bf16*)(ws + WS_WDN) + (size_t)l * D * FFH, D, FFH, 64 * (r / 4), 256 * (r % 4), 0}; return c; }
}
constexpr int CV_TILES = 2 * 16 * (AB_N / 256) + 2 * 16 * (FX_N / 256) + 4 * 64 + 8 * 16 * (FFH / 256) + 4 * (FFH / 64) * 4;

__device__ __forceinline__ void phase_prologue(const Args& a, LAS unsigned char* lds, int tid, int lane, int wave, int G) {
    unsigned char* ws = a.ws;
    {
        const unsigned lds0 = (unsigned)(uintptr_t)lds;
        const int lr = tid >> 6, lc = tid & 63;
        const int c15 = lane & 15, kq = lane >> 4;
        f32x4 v[8];
        int t = blockIdx.x;
        CvTile cur = cv_decode(a, ws, t < CV_TILES ? t : 0);
        if (t < CV_TILES) {
#pragma unroll
            for (int i = 0; i < 8; ++i) v[i] = *(const f32x4*)(cur.W + (size_t)(cur.k0 + lr + 8 * i) * cur.ld + cur.n0 + 4 * lc); }
        for (; t < CV_TILES; t += G) {
#pragma unroll
            for (int i = 0; i < 8; ++i) *(LAS unsigned long long*)(uintptr_t)(lds0 + (lr + 8 * i) * CV_TS + 8 * lc) = (unsigned long long)cvtpk(v[i].x, v[i].y) | ((unsigned long long)cvtpk(v[i].z, v[i].w) << 32);
            const CvTile nxt = cv_decode(a, ws, t + G < CV_TILES ? t + G : 0);
            if (t + G < CV_TILES) {
#pragma unroll
                for (int i = 0; i < 8; ++i) v[i] = *(const f32x4*)(nxt.W + (size_t)(nxt.k0 + lr + 8 * i) * nxt.ld + nxt.n0 + 4 * lc); }
            __syncthreads();
#pragma unroll
            for (int j = 0; j < 2; ++j) { const int nb = 2 * wave + j, n = cur.n0 + 16 * nb + c15;
                bf16* drow = cur.WT + (size_t)cv_dst_row(cur.map, n) * cur.Kd + cur.k0 + 8 * kq;
#pragma unroll
                for (int ks = 0; ks < 2; ++ks) { const unsigned ad = lds0 + (32 * ks + 8 * kq + ((lane & 15) >> 2)) * CV_TS + (16 * nb + 4 * (lane & 3)) * 2;
                    const s16x4 lo = ds_tr16(ad), hh = ds_tr16(ad + 4 * CV_TS);
                    v4u w; w.x = (unsigned)(unsigned short)lo[0] | ((unsigned)(unsigned short)lo[1] << 16); w.y = (unsigned)(unsigned short)lo[2] | ((unsigned)(unsigned short)lo[3] << 16);
                    w.z = (unsigned)(unsigned short)hh[0] | ((unsigned)(unsigned short)hh[1] << 16); w.w = (unsigned)(unsigned short)hh[2] | ((unsigned)(unsigned short)hh[3] << 16);
                    *(GAS v4u*)(drow + 32 * ks) = w; } }
            __syncthreads();
            cur = nxt;
        }
    }
    __syncthreads();
    {
        LAS float* cact = (LAS float*)lds;
        LAS float* red = (LAS float*)(lds + 32768);
        const float* c = a.in[1];
        for (int i = tid; i < BATCH * D; i += NTHREADS) { const float v = c[i]; cact[i] = v / (1.0f + __expf(-v)); }
        __syncthreads();
        float* mod = (float*)(ws + WS_MOD);
        for (int it = blockIdx.x; it < DEPTH * (MODW / 64); it += G) {
            const int l = it / (MODW / 64), cg = it % (MODW / 64);
            const float* wp = a.in[2] + ((size_t)l * D + 128 * wave) * MODW + 64 * cg + lane;
            float acc[BATCH];
#pragma unroll
            for (int b = 0; b < BATCH; ++b) acc[b] = 0.f;
#pragma unroll 8
            for (int kk = 0; kk < 128; ++kk) { const float wv = wp[(size_t)kk * MODW];
#pragma unroll
                for (int b = 0; b < BATCH; ++b) acc[b] += cact[b * D + 128 * wave + kk] * wv; }
#pragma unroll
            for (int b = 0; b < BATCH; ++b) red[(wave * BATCH + b) * 64 + lane] = acc[b];
            __syncthreads();
            { const int b = tid >> 6; float s = 0.f;
#pragma unroll
                for (int w = 0; w < NWAVES; ++w) s += red[(w * BATCH + b) * 64 + lane];
                mod[((size_t)l * BATCH + b) * MODW + 64 * cg + lane] = s + a.in[3][(size_t)l * MODW + 64 * cg + lane]; }
            __syncthreads();
        }
    }
}

template <int NG, bool XBF>
__device__ __forceinline__ void phase_norm(const void* xin_v, const float* gain, const float* shift, const float* scale  , bf16* hout,
                                           const float* Wg, int ldw, int gcol0, const float* bias_a, const float* bias_b, float* gate_out,
                                           LAS unsigned char* lds, int tid, int lane, int wave, int G) {
    LAS float* wgt = (LAS float*)lds;
    if constexpr (NG > 0) {
        for (int i = tid; i < NG * D; i += NTHREADS) { const int k = i / NG, g = i % NG; wgt[g * D + k] = Wg[(size_t)k * ldw + gcol0 + g]; }
        __syncthreads();
    }
    const int gw = blockIdx.x * NWAVES + wave, NGW = G * NWAVES;
    for (int item = gw; item < M / 16; item += NGW) {
        const int row0 = item * 16, b = row0 / SEQ;
        f32x4 A[4], S[4];
#pragma unroll
        for (int j = 0; j < 4; ++j) { const int c = 4 * lane + 256 * j;
            const f32x4 g4 = *(const f32x4*)(gain + c), sc4 = *(const f32x4*)(scale + (size_t)b * MODW + c);
            A[j] = g4 * (sc4 + 1.0f); S[j] = *(const f32x4*)(shift + (size_t)b * MODW + c); }
        for (int r = 0; r < 16; ++r) {
            asm volatile("" ::: "memory");
            const int row = row0 + r;
            f32x4 v[4]; float ss = 0.f;
            if constexpr (XBF) { const GAS unsigned long long* xr = (const GAS unsigned long long*)((const bf16*)xin_v + (size_t)row * D) + lane;
#pragma unroll
                for (int j = 0; j < 4; ++j) { const unsigned long long w = xr[64 * j]; const unsigned lo = (unsigned)w, hh = (unsigned)(w >> 32); v[j] = (f32x4){bf_lo(lo), bf_hi(lo), bf_lo(hh), bf_hi(hh)}; } }
            else { const GAS f32x4* xr = (const GAS f32x4*)((const float*)xin_v + (size_t)row * D) + lane;
#pragma unroll
                for (int j = 0; j < 4; ++j) v[j] = xr[64 * j]; }
#pragma unroll
            for (int j = 0; j < 4; ++j) ss += (v[j].x * v[j].x + v[j].y * v[j].y) + (v[j].z * v[j].z + v[j].w * v[j].w);
            const float rinv = 1.0f / sqrtf(wave_sum(ss) * (1.0f / D) + EPS);
#pragma unroll
            for (int j = 0; j < 4; ++j) v[j] = v[j] * rinv * A[j] + S[j];
            GAS unsigned long long* o8 = (GAS unsigned long long*)(hout + (size_t)row * D) + lane;
#pragma unroll
            for (int j = 0; j < 4; ++j) o8[64 * j] = (unsigned long long)pk2(v[j].x, v[j].y) | ((unsigned long long)pk2(v[j].z, v[j].w) << 32);
            if constexpr (NG > 0) {
                float p[NG];
#pragma unroll
                for (int g = 0; g < NG; ++g) { float s = 0.f;
#pragma unroll
                    for (int j = 0; j < 4; ++j) { const f32x4 w4 = *(const LAS f32x4*)(wgt + g * D + 4 * lane + 256 * j); s += (v[j].x * w4.x + v[j].y * w4.y) + (v[j].z * w4.z + v[j].w * w4.w); }
                    p[g] = s; }
#define HALVE(NV, OFF) do { const bool up = (lane & (OFF)) != 0; _Pragma("unroll") for (int i = 0; i < (NV); ++i) { const float keep = up ? p[i + (NV)] : p[i], send = up ? p[i] : p[i + (NV)]; p[i] = keep + __shfl_xor(send, (OFF)); } } while (0)
                if constexpr (NG == 16) { HALVE(8, 32); HALVE(4, 16); HALVE(2, 8); HALVE(1, 4); } else { HALVE(4, 32); HALVE(2, 16); HALVE(1, 8); }
#undef HALVE
                float val = p[0];
                constexpr int REM = (NG == 16) ? 2 : 4;
#pragma unroll
                for (int off = REM; off >= 1; off >>= 1) val += __shfl_xor(val, off);
                const int t = row % SEQ;
                if constexpr (NG == 16) { if ((lane & 3) == 0) { const int g = lane >> 2; gate_out[((size_t)b * 16 + g) * SEQ + t] = log_sigmoid(val + bias_b[g]); } }
                else { if ((lane & 7) == 0) { const int g = lane >> 3;
                        if (g < 4) gate_out[((size_t)b * 4 + g) * SEQ + t] = val + bias_a[g];
                        else gate_out[(size_t)BATCH * 4 * SEQ + ((size_t)b * 4 + (g - 4)) * SEQ + t] = log_sigmoid(val + bias_b[g - 4]); } }
            }
        }
    }
}

__device__ __forceinline__ int queue_next(gu32* head, volatile LAS unsigned* MISC, int tid) {
    __syncthreads();
    if (tid == 0) MISC[0] = __hip_atomic_fetch_add(head, 1u, RLX_AGENT);
    __syncthreads();
    return (int)MISC[0];
}

__device__ __forceinline__ void fox_naive_unit(int b, int h, int qb, const bf16* z, const float* lf, bf16* y, LAS unsigned char* lds, int tid, int lane, int wave) {
    LAS float* F = (LAS float*)lds;
    if (wave == 0) { const int seg = 8 * (qb + 1); const float* p = lf + ((size_t)b * 16 + h) * SEQ + lane * seg; float s = 0.f;
        for (int i = 0; i < seg; ++i) s += p[i];
        float inc = s;
#pragma unroll
        for (int off = 1; off < 64; off <<= 1) { const float t = __shfl_up(inc, off); if (lane >= off) inc += t; }
        float run = inc - s;
        for (int i = 0; i < seg; ++i) { run += p[i]; F[lane * seg + i] = run * LOG2E; } }
    __syncthreads();
    const int t = qb * 512 + tid; const size_t rowbase = (size_t)b * SEQ;
    float q[64];
    { const v4u* qp = (const v4u*)(z + (rowbase + t) * FX_N + h * 64);
#pragma unroll
        for (int c = 0; c < 8; ++c) { const v4u u = qp[c]; q[8 * c] = bf_lo(u.x); q[8 * c + 1] = bf_hi(u.x); q[8 * c + 2] = bf_lo(u.y); q[8 * c + 3] = bf_hi(u.y); q[8 * c + 4] = bf_lo(u.z); q[8 * c + 5] = bf_hi(u.z); q[8 * c + 6] = bf_lo(u.w); q[8 * c + 7] = bf_hi(u.w); } }
    float o[64];
#pragma unroll
    for (int d = 0; d < 64; ++d) o[d] = 0.f;
    float m = -INFINITY, l = 0.f; const float Ft = F[t];
    const int smax = qb * 512 + wave * 64 + 63;
    for (int s = 0; s <= smax; ++s) {
        const v4u* kp = (const v4u*)(z + (rowbase + s) * FX_N + 1024 + h * 64);
        float dot = 0.f;
#pragma unroll
        for (int c = 0; c < 8; ++c) { const v4u u = kp[c];
            dot += q[8 * c] * bf_lo(u.x) + q[8 * c + 1] * bf_hi(u.x) + q[8 * c + 2] * bf_lo(u.y) + q[8 * c + 3] * bf_hi(u.y) + q[8 * c + 4] * bf_lo(u.z) + q[8 * c + 5] * bf_hi(u.z) + q[8 * c + 6] * bf_lo(u.w) + q[8 * c + 7] * bf_hi(u.w); }
        float lg = dot + (Ft - F[s]);
        lg = (s <= t) ? lg : -INFINITY;
        const float mn = fmaxf(m, lg), alpha = ex2(m - mn), p = ex2(lg - mn);
        l = l * alpha + p; m = mn;
        const v4u* vp = (const v4u*)(z + (rowbase + s) * FX_N + 2048 + h * 64);
#pragma unroll
        for (int c = 0; c < 8; ++c) { const v4u u = vp[c];
            o[8 * c] = o[8 * c] * alpha + p * bf_lo(u.x); o[8 * c + 1] = o[8 * c + 1] * alpha + p * bf_hi(u.x); o[8 * c + 2] = o[8 * c + 2] * alpha + p * bf_lo(u.y); o[8 * c + 3] = o[8 * c + 3] * alpha + p * bf_hi(u.y);
            o[8 * c + 4] = o[8 * c + 4] * alpha + p * bf_lo(u.z); o[8 * c + 5] = o[8 * c + 5] * alpha + p * bf_hi(u.z); o[8 * c + 6] = o[8 * c + 6] * alpha + p * bf_lo(u.w); o[8 * c + 7] = o[8 * c + 7] * alpha + p * bf_hi(u.w); }
    }
    const float il = 1.0f / l;
    v4u* yp = (v4u*)(y + (rowbase + t) * D + h * 64);
#pragma unroll
    for (int c = 0; c < 8; ++c) { v4u w; w.x = pk2(o[8 * c] * il, o[8 * c + 1] * il); w.y = pk2(o[8 * c + 2] * il, o[8 * c + 3] * il); w.z = pk2(o[8 * c + 4] * il, o[8 * c + 5] * il); w.w = pk2(o[8 * c + 6] * il, o[8 * c + 7] * il); yp[c] = w; }
}

__device__ __forceinline__ void da_naive_unit(int b, int h, int qb, const bf16* z, bf16* y, const float* lam_p, const float* subln_g, int layer, int lane, int wave) {
    const int r = lane & 15, mm = (lane >> 4) & 1, vh = lane >> 5;
    const int t = qb * 128 + wave * 16 + r; const size_t rowbase = (size_t)b * SEQ;
    const float lambda_init = 0.8f - 0.6f * expf(-0.3f * (float)layer);
    float lam;
    { float s0 = 0.f, s1 = 0.f; for (int d = 0; d < 64; ++d) { s0 += lam_p[d] * lam_p[64 + d]; s1 += lam_p[128 + d] * lam_p[192 + d]; } lam = expf(s0) - expf(s1) + lambda_init; }
    const float slope2 = exp2f(-2.0f * (float)(h + 1)) * LOG2E;
    float q[64];
    { const v4u* qp = (const v4u*)(z + (rowbase + t) * AB_N + h * 128 + mm * 64);
#pragma unroll
        for (int c = 0; c < 8; ++c) { const v4u u = qp[c]; q[8 * c] = bf_lo(u.x); q[8 * c + 1] = bf_hi(u.x); q[8 * c + 2] = bf_lo(u.y); q[8 * c + 3] = bf_hi(u.y); q[8 * c + 4] = bf_lo(u.z); q[8 * c + 5] = bf_hi(u.z); q[8 * c + 6] = bf_lo(u.w); q[8 * c + 7] = bf_hi(u.w); } }
    float o[64];
#pragma unroll
    for (int d = 0; d < 64; ++d) o[d] = 0.f;
    float m = -INFINITY, l = 0.f;
    const int smax = (qb * 128 + wave * 16) / 64 * 64 + 63;
    for (int s = 0; s <= smax; ++s) {
        const v4u* kp = (const v4u*)(z + (rowbase + s) * AB_N + 512 + h * 128 + mm * 64);
        float dot = 0.f;
#pragma unroll
        for (int c = 0; c < 8; ++c) { const v4u u = kp[c];
            dot += q[8 * c] * bf_lo(u.x) + q[8 * c + 1] * bf_hi(u.x) + q[8 * c + 2] * bf_lo(u.y) + q[8 * c + 3] * bf_hi(u.y) + q[8 * c + 4] * bf_lo(u.z) + q[8 * c + 5] * bf_hi(u.z) + q[8 * c + 6] * bf_lo(u.w) + q[8 * c + 7] * bf_hi(u.w); }
        const float lg = dot - slope2 * fabsf((float)(t - s));
        const float mn = fmaxf(m, lg), alpha = ex2(m - mn), p = ex2(lg - mn);
        l = l * alpha + p; m = mn;
        const v4u* vp = (const v4u*)(z + (rowbase + s) * AB_N + 1024 + h * 128 + vh * 64);
#pragma unroll
        for (int c = 0; c < 8; ++c) { const v4u u = vp[c];
            o[8 * c] = o[8 * c] * alpha + p * bf_lo(u.x); o[8 * c + 1] = o[8 * c + 1] * alpha + p * bf_hi(u.x); o[8 * c + 2] = o[8 * c + 2] * alpha + p * bf_lo(u.y); o[8 * c + 3] = o[8 * c + 3] * alpha + p * bf_hi(u.y);
            o[8 * c + 4] = o[8 * c + 4] * alpha + p * bf_lo(u.z); o[8 * c + 5] = o[8 * c + 5] * alpha + p * bf_hi(u.z); o[8 * c + 6] = o[8 * c + 6] * alpha + p * bf_lo(u.w); o[8 * c + 7] = o[8 * c + 7] * alpha + p * bf_hi(u.w); }
    }
    const float il = 1.0f / l; float ss = 0.f;
#pragma unroll
    for (int d = 0; d < 64; ++d) { const float mine = o[d] * il, other = __shfl_xor(mine, 16); o[d] = mine - lam * other; ss += o[d] * o[d]; }
    ss += __shfl_xor(ss, 32);
    const float rn = (1.0f - lambda_init) / sqrtf(ss * (1.0f / 128.0f) + EPS);
    if (mm == 0) {
        v4u* yp = (v4u*)(y + (rowbase + t) * D + h * 128 + vh * 64);
#pragma unroll
        for (int c = 0; c < 8; ++c) { float e[8];
#pragma unroll
            for (int i = 0; i < 8; ++i) e[i] = o[8 * c + i] * rn * subln_g[vh * 64 + 8 * c + i];
            v4u w; w.x = pk2(e[0], e[1]); w.y = pk2(e[2], e[3]); w.z = pk2(e[4], e[5]); w.w = pk2(e[6], e[7]); yp[c] = w; }
    }
}

__device__ __forceinline__ void mlstm_naive_unit(int b, int h, const bf16* z, const float* gates, const float* conv_w, const float* conv_b, bf16* y, LAS unsigned char* lds, int tid) {
    LAS float* qs = (LAS float*)lds;
    LAS float* ks = (LAS float*)(lds + 32768);
    LAS float* pn = (LAS float*)(lds + 65536);
    LAS float* pd = (LAS float*)(lds + 65536 + 4096);
    const int dv = tid & 127, eq = tid >> 7; const size_t rowbase = (size_t)b * SEQ;
    const float* gi = gates + ((size_t)b * 4 + h) * SEQ; const float* glf = gates + (size_t)BATCH * 4 * SEQ + ((size_t)b * 4 + h) * SEQ;
    float C[32], n[32];
#pragma unroll
    for (int i = 0; i < 32; ++i) { C[i] = 0.f; n[i] = 0.f; }
    float m = 0.f;
    for (int c = 0; c < SEQ / 64; ++c) {
        for (int it = tid; it < 2048; it += NTHREADS) {
            const int isk = it >> 10, r = (it >> 4) & 63, g = it & 15; const int t = 64 * c + r;
            const int ch = isk * 512 + h * 128 + 8 * g;
            float acc[8];
#pragma unroll
            for (int i = 0; i < 8; ++i) acc[i] = conv_b[ch + i];
#pragma unroll
            for (int j = 0; j < 4; ++j) { const int tt = t - 3 + j;
                if (tt >= 0) { const v4u u = *(const v4u*)(z + (rowbase + tt) * AB_N + 1536 + ch); const float* w = conv_w + j * 1024 + ch;
                    acc[0] += bf_lo(u.x) * w[0]; acc[1] += bf_hi(u.x) * w[1]; acc[2] += bf_lo(u.y) * w[2]; acc[3] += bf_hi(u.y) * w[3];
                    acc[4] += bf_lo(u.z) * w[4]; acc[5] += bf_hi(u.z) * w[5]; acc[6] += bf_lo(u.w) * w[6]; acc[7] += bf_hi(u.w) * w[7]; } }
            LAS float* dst = (isk ? ks : qs) + r * 128 + 8 * g; const float scl = isk ? 0.08838834764831845f : 1.0f;
#pragma unroll
            for (int i = 0; i < 8; ++i) dst[i] = acc[i] / (1.0f + __expf(-acc[i])) * scl;
        }
        __syncthreads();
        for (int r = 0; r < 64; ++r) {
            const int t = 64 * c + r;
            const float lf = glf[t], ig = gi[t];
            const float mn = fmaxf(lf + m, ig), fd = __expf(lf + m - mn), ii = __expf(ig - mn); m = mn;
            const float vv = bf1(z[(rowbase + t) * AB_N + 2560 + h * 128 + dv]) * ii;
            float pnum = 0.f, pden = 0.f;
#pragma unroll
            for (int i = 0; i < 32; ++i) { const float kk = ks[r * 128 + 32 * eq + i], qq = qs[r * 128 + 32 * eq + i];
                C[i] = fd * C[i] + vv * kk; n[i] = fd * n[i] + ii * kk; pnum += C[i] * qq; pden += n[i] * qq; }
            pn[((r & 1) * 4 + eq) * 128 + dv] = pnum; if (dv == 0) pd[(r & 1) * 4 + eq] = pden;
            __syncthreads();
            if (eq == 0) {
                const float num = (pn[((r & 1) * 4 + 0) * 128 + dv] + pn[((r & 1) * 4 + 1) * 128 + dv]) + (pn[((r & 1) * 4 + 2) * 128 + dv] + pn[((r & 1) * 4 + 3) * 128 + dv]);
                const float den = (pd[(r & 1) * 4 + 0] + pd[(r & 1) * 4 + 1]) + (pd[(r & 1) * 4 + 2] + pd[(r & 1) * 4 + 3]);
                const float hh = num / fmaxf(fabsf(den), __expf(-m));
                const float og = bf1(z[(rowbase + t) * AB_N + 3072 + h * 128 + dv]);
                y[(rowbase + t) * D + 512 + h * 128 + dv] = (bf16)f2bf(hh / (1.0f + __expf(-og)));
            }
        }
        __syncthreads();
    }
}

typedef float f32x16 __attribute__((ext_vector_type(16)));
__device__ __forceinline__ int crow(int r, int hi) { return (r & 3) + 8 * (r >> 2) + 4 * hi; }
#define MFMA32(a, b, c) __builtin_amdgcn_mfma_f32_32x32x16_bf16((a), (b), (c), 0, 0, 0)
#define SCHED_FENCE() __builtin_amdgcn_sched_barrier(0)
template <int CTRL, int ROWMASK> __device__ __forceinline__ float dpp_f(float oldv, float x) {
    return __builtin_bit_cast(float, __builtin_amdgcn_update_dpp(__builtin_bit_cast(int, oldv), __builtin_bit_cast(int, x), CTRL, ROWMASK, 0xf, false)); }
__device__ __forceinline__ float scan_add(float v, int) {
    v += dpp_f<0x111, 0xf>(0.f, v); v += dpp_f<0x112, 0xf>(0.f, v); v += dpp_f<0x114, 0xf>(0.f, v); v += dpp_f<0x118, 0xf>(0.f, v);
    v += dpp_f<0x142, 0xa>(0.f, v); v += dpp_f<0x143, 0xc>(0.f, v); return v; }
__device__ __forceinline__ float scan_max(float v, int) {
    const float ninf = -INFINITY;
    v = fmaxf(v, dpp_f<0x111, 0xf>(ninf, v)); v = fmaxf(v, dpp_f<0x112, 0xf>(ninf, v)); v = fmaxf(v, dpp_f<0x114, 0xf>(ninf, v)); v = fmaxf(v, dpp_f<0x118, 0xf>(ninf, v));
    v = fmaxf(v, dpp_f<0x142, 0xa>(ninf, v)); v = fmaxf(v, dpp_f<0x143, 0xc>(ninf, v)); return v; }
__device__ __forceinline__ void swap32(unsigned& a, unsigned& b) { asm volatile("s_nop 1\n\tv_permlane32_swap_b32 %0, %1\n\ts_nop 1" : "+v"(a), "+v"(b)); }
__device__ __forceinline__ void swap16(unsigned& a, unsigned& b) { asm volatile("s_nop 1\n\tv_permlane16_swap_b32 %0, %1\n\ts_nop 1" : "+v"(a), "+v"(b)); }
__device__ __forceinline__ float xsum32(float v) { unsigned a = __builtin_bit_cast(unsigned, v), b = a; swap32(a, b); return __builtin_bit_cast(float, a) + __builtin_bit_cast(float, b); }
__device__ __forceinline__ float xsum16(float v) { unsigned a = __builtin_bit_cast(unsigned, v), b = a; swap16(a, b); return __builtin_bit_cast(float, a) + __builtin_bit_cast(float, b); }
__device__ __forceinline__ float xmax32(float v) { unsigned a = __builtin_bit_cast(unsigned, v), b = a; swap32(a, b); return fmaxf(__builtin_bit_cast(float, a), __builtin_bit_cast(float, b)); }

constexpr int FX_KSTR = 144, FX_F_OFF = 0, FX_K_OFF = 16384, FX_KBUF = 64 * FX_KSTR, FX_V_OFF = FX_K_OFF + 4 * FX_KBUF, FX_VBUF = 8192, FX_WT_OFF = FX_V_OFF + 6 * FX_VBUF;
__device__ __forceinline__ void fox_unit(int b, int h, int qb, const bf16* z, const float* lf, bf16* y, bool bounded, float skipT, LAS unsigned char* lds, int tid, int lane, int wave) {
    const int q0 = qb * 256; const size_t rowbase = (size_t)b * SEQ;
    const int r32 = lane & 31, hi = lane >> 5;
    LAS float* F2 = (LAS float*)(lds + FX_F_OFF);
    const unsigned lds0 = (unsigned)(uintptr_t)lds;
    const int qrow = q0 + 32 * wave + r32;
    bf16x8 qf[4];
    { const bf16* qp = z + (rowbase + qrow) * FX_N + h * 64 + 8 * hi;
#pragma unroll
        for (int ks = 0; ks < 4; ++ks) qf[ks] = *(const bf16x8*)(qp + 16 * ks); }
    const int srow = tid >> 3, sch = tid & 7;
    const bf16* kg = z + (rowbase + srow) * FX_N + 1024 + h * 64 + 8 * sch;
    const bf16* vg = kg + 1024;
    const unsigned kdst = lds0 + FX_K_OFF + srow * FX_KSTR + sch * 16;
    const unsigned vdst = lds0 + FX_V_OFF + (sch >> 2) * 4096 + srow * 64 + (sch & 3) * 16;
    const int NT = 4 * (qb + 1), tmax = 4 * qb + (wave >> 1);
    v4u kA, vA, kB, vB;
    {
        const int n = q0 + 256; float v[8];
        if (tid * 8 < n) { const float* p = lf + ((size_t)b * 16 + h) * SEQ + tid * 8; const f32x4 a = *(const f32x4*)p, c = *(const f32x4*)(p + 4);
            v[0] = a.x; v[1] = v[0] + a.y; v[2] = v[1] + a.z; v[3] = v[2] + a.w; v[4] = v[3] + c.x; v[5] = v[4] + c.y; v[6] = v[5] + c.z; v[7] = v[6] + c.w; }
        else {
#pragma unroll
            for (int i = 0; i < 8; ++i) v[i] = 0.f; }
        const float inc = scan_add(v[7], lane);
        LAS float* wt = (LAS float*)(lds + FX_WT_OFF);
        if (lane == 63) wt[wave] = inc;
        __syncthreads();
        float base = inc - v[7];
        for (int w = 0; w < wave; ++w) base += wt[w];
        if (tid * 8 < n) { f32x4 a, c; a.x = (base + v[0]) * LOG2E; a.y = (base + v[1]) * LOG2E; a.z = (base + v[2]) * LOG2E; a.w = (base + v[3]) * LOG2E;
            c.x = (base + v[4]) * LOG2E; c.y = (base + v[5]) * LOG2E; c.z = (base + v[6]) * LOG2E; c.w = (base + v[7]) * LOG2E;
            *(LAS f32x4*)(F2 + tid * 8) = a; *(LAS f32x4*)(F2 + tid * 8 + 4) = c; }
    }
    __syncthreads();
    int t0 = 0, tw = 0;
    if (bounded) { const float FX_SKIP = skipT;
        { const float lim = F2[q0] + FX_SKIP; int lo = 0, hi2 = NT - 1;
            while (lo < hi2) { const int mid = (lo + hi2) >> 1; if (F2[64 * mid + 63] <= lim) hi2 = mid; else lo = mid + 1; }
            t0 = lo & ~1; }
        { const float lim = F2[q0 + 32 * wave] + FX_SKIP; int lo = t0, hi2 = tmax;
            while (lo < hi2) { const int mid = (lo + hi2) >> 1; if (F2[64 * mid + 63] <= lim) hi2 = mid; else lo = mid + 1; }
            tw = lo; } }
#define FX_KSLOT(tt) ((unsigned)((((tt) >> 1) & 1) * 2 + ((tt) & 1)) * FX_KBUF)
#define FX_VSLOT(tt) ((unsigned)((((tt) >> 1) % 3) * 2 + ((tt) & 1)) * FX_VBUF)
    { const v4u k0 = *(const v4u*)(kg + (size_t)t0 * 64 * FX_N), v0 = *(const v4u*)(vg + (size_t)t0 * 64 * FX_N);
        const v4u k1 = *(const v4u*)(kg + (size_t)(t0 + 1) * 64 * FX_N), v1 = *(const v4u*)(vg + (size_t)(t0 + 1) * 64 * FX_N);
        *(LAS v4u*)(uintptr_t)(kdst + FX_KSLOT(t0)) = k0; *(LAS v4u*)(uintptr_t)(vdst + FX_VSLOT(t0)) = v0; *(LAS v4u*)(uintptr_t)(kdst + FX_KSLOT(t0 + 1)) = k1; *(LAS v4u*)(uintptr_t)(vdst + FX_VSLOT(t0 + 1)) = v1; }
    __syncthreads();
    const float Fq = F2[qrow];
    f32x16 o[2];
#pragma unroll
    for (int i = 0; i < 16; ++i) { o[0][i] = 0.f; o[1][i] = 0.f; }
    float lsum = 0.f, mref = 0.f;
    const unsigned ka = lds0 + FX_K_OFF + r32 * FX_KSTR + hi * 16;
    const unsigned va = lds0 + FX_V_OFF + (4 * hi + ((lane & 15) >> 2)) * 64 + (16 * ((lane >> 4) & 1) + 4 * (lane & 3)) * 2;
#define FX_QK(P, tt) do { const LAS float* fk_ = F2 + 64 * (tt) + 4 * hi; const float bq_ = Fq - mref; const unsigned kb_ = ka + FX_KSLOT(tt); \
        bf16x8 kf_[4][2]; f32x4 ff_[2][4]; \
        _Pragma("unroll") for (int ks = 0; ks < 4; ++ks) _Pragma("unroll") for (int hf = 0; hf < 2; ++hf) kf_[ks][hf] = *(const LAS bf16x8*)(uintptr_t)(kb_ + hf * 32 * FX_KSTR + ks * 32); \
        _Pragma("unroll") for (int hf = 0; hf < 2; ++hf) _Pragma("unroll") for (int g = 0; g < 4; ++g) ff_[hf][g] = *(const LAS f32x4*)(fk_ + 32 * hf + 8 * g); \
        SCHED_FENCE(); \
        _Pragma("unroll") for (int hf = 0; hf < 2; ++hf) _Pragma("unroll") for (int g = 0; g < 4; ++g) { const f32x4 f_ = ff_[hf][g]; \
            P[hf][4 * g] = bq_ - f_.x; P[hf][4 * g + 1] = bq_ - f_.y; P[hf][4 * g + 2] = bq_ - f_.z; P[hf][4 * g + 3] = bq_ - f_.w; } \
        _Pragma("unroll") for (int ks = 0; ks < 4; ++ks) _Pragma("unroll") for (int hf = 0; hf < 2; ++hf) P[hf] = MFMA32(kf_[ks][hf], qf[ks], P[hf]); } while (0)
#define FX_SM(P, NOMAX, tt) do { \
        if (64 * (tt) + 63 > q0 + 32 * wave) { _Pragma("unroll") for (int hf = 0; hf < 2; ++hf) _Pragma("unroll") for (int r = 0; r < 16; ++r) { const int kv_ = 64 * (tt) + 32 * hf + crow(r, hi); if (kv_ > qrow) P[hf][r] = -INFINITY; } } \
        if (!(NOMAX)) { float mx_ = fmaxf(P[0][0], P[1][0]); \
            _Pragma("unroll") for (int r = 1; r < 16; ++r) mx_ = fmaxf(mx_, fmaxf(P[0][r], P[1][r])); \
            mx_ = xmax32(mx_); \
            if (__any(mx_ > 8.0f)) { const float dl_ = fmaxf(mx_, 0.f), alpha_ = ex2(-dl_); mref += dl_; lsum *= alpha_; \
                _Pragma("unroll") for (int r = 0; r < 16; ++r) { P[0][r] -= dl_; P[1][r] -= dl_; o[0][r] *= alpha_; o[1][r] *= alpha_; } } } \
        _Pragma("unroll") for (int hf = 0; hf < 2; ++hf) { \
            _Pragma("unroll") for (int r = 0; r < 16; ++r) { P[hf][r] = ex2(P[hf][r]); lsum += P[hf][r]; } \
            _Pragma("unroll") for (int k2 = 0; k2 < 2; ++k2) { v4u w_; w_.x = cvtpk(P[hf][8 * k2], P[hf][8 * k2 + 1]); w_.y = cvtpk(P[hf][8 * k2 + 2], P[hf][8 * k2 + 3]); w_.z = cvtpk(P[hf][8 * k2 + 4], P[hf][8 * k2 + 5]); w_.w = cvtpk(P[hf][8 * k2 + 6], P[hf][8 * k2 + 7]); \
                pf[hf][k2] = __builtin_bit_cast(bf16x8, w_); } } } while (0)
#define FX_PV(tt) do { const unsigned vs_ = va + FX_VSLOT(tt); s16x4 lo_[2][2][2], hh_[2][2][2]; \
        _Pragma("unroll") for (int hf = 0; hf < 2; ++hf) _Pragma("unroll") for (int k2 = 0; k2 < 2; ++k2) _Pragma("unroll") for (int db = 0; db < 2; ++db) { const unsigned ad_ = vs_ + db * 4096 + (32 * hf + 16 * k2) * 64; \
            lo_[hf][k2][db] = ds_tr16(ad_); hh_[hf][k2][db] = ds_tr16(ad_ + 8 * 64); } \
        SCHED_FENCE(); \
        _Pragma("unroll") for (int hf = 0; hf < 2; ++hf) _Pragma("unroll") for (int k2 = 0; k2 < 2; ++k2) _Pragma("unroll") for (int db = 0; db < 2; ++db) { const s16x4 l_ = lo_[hf][k2][db], h_ = hh_[hf][k2][db]; \
            const bf16x8 a_ = {l_[0], l_[1], l_[2], l_[3], h_[0], h_[1], h_[2], h_[3]}; \
            o[db] = MFMA32(a_, pf[hf][k2], o[db]); } } while (0)
#define FX_TILE(t, NOMAX, LAG) do { \
        if (LAG) { if ((t) - 1 >= tw && (t) - 1 <= tmax) FX_PV((t) - 1); if ((t) >= tw && (t) <= tmax) { FX_QK(pc, (t)); FX_SM(pc, NOMAX, (t)); } } \
        else { if ((t) >= tw && (t) <= tmax) { FX_QK(pc, (t)); FX_SM(pc, NOMAX, (t)); FX_PV((t)); } } } while (0)
#define FX_ITER(t, NOMAX, LAG) do { \
        if ((t) + 2 < NT) { kA = *(const v4u*)(kg + (size_t)((t) + 2) * 64 * FX_N); vA = *(const v4u*)(vg + (size_t)((t) + 2) * 64 * FX_N); \
                            kB = *(const v4u*)(kg + (size_t)((t) + 3) * 64 * FX_N); vB = *(const v4u*)(vg + (size_t)((t) + 3) * 64 * FX_N); } \
        FX_TILE((t), NOMAX, LAG); FX_TILE((t) + 1, NOMAX, LAG); \
        if ((t) + 2 < NT) { *(LAS v4u*)(uintptr_t)(kdst + FX_KSLOT((t) + 2)) = kA; *(LAS v4u*)(uintptr_t)(vdst + FX_VSLOT((t) + 2)) = vA; \
                            *(LAS v4u*)(uintptr_t)(kdst + FX_KSLOT((t) + 3)) = kB; *(LAS v4u*)(uintptr_t)(vdst + FX_VSLOT((t) + 3)) = vB; } \
        __syncthreads(); } while (0)
    f32x16 pc[2]; bf16x8 pf[2][2];
    if (wave < 4) {
        if (bounded) { for (int t = t0; t < NT; t += 2) FX_ITER(t, true, false); }
        else { for (int t = t0; t < NT; t += 2) FX_ITER(t, false, false); }
    } else {
        if (bounded) { for (int t = t0; t < NT; t += 2) FX_ITER(t, true, true); }
        else { for (int t = t0; t < NT; t += 2) FX_ITER(t, false, true); }
        if (tmax == NT - 1) FX_PV(NT - 1);
    }
#undef FX_ITER
#undef FX_TILE
#undef FX_KSLOT
#undef FX_VSLOT
#undef FX_QK
#undef FX_SM
#undef FX_PV
    lsum = xsum32(lsum);
    const float il = 1.0f / lsum;
    bf16* yp = y + (rowbase + qrow) * D + h * 64 + 4 * hi;
#pragma unroll
    for (int db = 0; db < 2; ++db)
#pragma unroll
        for (int g = 0; g < 4; ++g) { const unsigned long long w = (unsigned long long)cvtpk(o[db][4 * g] * il, o[db][4 * g + 1] * il) | ((unsigned long long)cvtpk(o[db][4 * g + 2] * il, o[db][4 * g + 3] * il) << 32);
            *(unsigned long long*)(yp + 32 * db + 8 * g) = w; }
}

constexpr int DA_KSTR = 272, DA_K_OFF = 0, DA_KBUF = 64 * DA_KSTR, DA_V_OFF = 2 * DA_KBUF, DA_VBUF = 16384;
static_assert(DA_V_OFF + 2 * DA_VBUF >= 65536 && DA_V_OFF + 2 * DA_VBUF <= RING_BYTES, "DA LDS map (the exchange reuses the K/V region)");
__device__ __forceinline__ void da_unit(int b, int h, int qb, const bf16* z, bf16* y, volatile LAS unsigned* MISC, bool bounded, const float* subln_g, LAS unsigned char* lds, int tid, int lane, int wave) {
    const int q0 = qb * 128, qs = wave & 3, mm = wave >> 2; const size_t rowbase = (size_t)b * SEQ;
    const int r32 = lane & 31, hi = lane >> 5;
    const unsigned lds0 = (unsigned)(uintptr_t)lds;
    const float slope2 = exp2f(-2.0f * (float)(h + 1)) * LOG2E;
    const int qrow = q0 + 32 * qs + r32;
    float cr[16];
#pragma unroll
    for (int r = 0; r < 16; ++r) cr[r] = slope2 * (float)crow(r, hi);
#ifdef DBG_DA_SYNC
    for (int i = tid; i < 69632 / 4; i += NTHREADS) ((LAS unsigned*)lds)[i] = 0u;
    __syncthreads();
#endif
    bf16x8 qf[4];
    { const bf16* qp = z + (rowbase + qrow) * AB_N + h * 128 + mm * 64 + 8 * hi;
#pragma unroll
        for (int ks = 0; ks < 4; ++ks) qf[ks] = *(const bf16x8*)(qp + 16 * ks); }
    const bf16* kg[2]; unsigned kdst[2], vdst[2];
#pragma unroll
    for (int i = 0; i < 2; ++i) { const int c = tid + 512 * i, row = c >> 4, ch = c & 15;
        kg[i] = z + (rowbase + row) * AB_N + 512 + h * 128 + 8 * ch;
        kdst[i] = lds0 + DA_K_OFF + row * DA_KSTR + ch * 16; vdst[i] = lds0 + DA_V_OFF + (ch >> 2) * 4096 + row * 64 + (ch & 3) * 16; }
    int t0 = 0, tw = 0;
    if (bounded) { const float DA_SKIP = __builtin_bit_cast(float, (unsigned)MISC[5]); const float dist = DA_SKIP / slope2;
        const int f0 = (int)floorf(((float)(q0 - 63) - dist) * (1.0f / 64.0f)) + 1, fw = (int)floorf(((float)(q0 + 32 * qs - 63) - dist) * (1.0f / 64.0f)) + 1;
        t0 = f0 > 0 ? f0 : 0; tw = fw > 0 ? fw : 0; }
    v4u kreg[2], vreg[2];
#pragma unroll
    for (int i = 0; i < 2; ++i) { kreg[i] = *(const v4u*)(kg[i] + (size_t)t0 * 64 * AB_N); vreg[i] = *(const v4u*)(kg[i] + 512 + (size_t)t0 * 64 * AB_N); }
#pragma unroll
    for (int i = 0; i < 2; ++i) { *(LAS v4u*)(uintptr_t)(kdst[i] + (t0 & 1) * DA_KBUF) = kreg[i]; *(LAS v4u*)(uintptr_t)(vdst[i] + (t0 & 1) * DA_VBUF) = vreg[i]; }
    __syncthreads();
    f32x16 o[4];
#pragma unroll
    for (int d = 0; d < 4; ++d)
#pragma unroll
        for (int i = 0; i < 16; ++i) o[d][i] = 0.f;
    float lsum = 0.f, mref = 0.f;
    const int NT = (q0 + 128) / 64, tmax = (q0 + 32 * qs) / 64;
    const unsigned ka = lds0 + DA_K_OFF + r32 * DA_KSTR + mm * 128 + hi * 16;
    const unsigned va = lds0 + DA_V_OFF + (4 * hi + ((lane & 15) >> 2)) * 64 + (16 * ((lane >> 4) & 1) + 4 * (lane & 3)) * 2;
    auto da_loop = [&](auto nomax_tag) { constexpr bool NOMAX = decltype(nomax_tag)::value;
    for (int t = t0; t < NT; ++t) {
        const int buf = t & 1;
        if (t + 1 < NT) {
#pragma unroll
            for (int i = 0; i < 2; ++i) { kreg[i] = *(const v4u*)(kg[i] + (size_t)(t + 1) * 64 * AB_N); vreg[i] = *(const v4u*)(kg[i] + 512 + (size_t)(t + 1) * 64 * AB_N); } }
        if (t >= tw && t <= tmax) {
            f32x16 p[2];
            if (t < tmax) {
                const float b0 = -slope2 * (float)(qrow - 64 * t) - mref, b1 = b0 + 32.0f * slope2;
#pragma unroll
                for (int r = 0; r < 16; ++r) { p[0][r] = b0 + cr[r]; p[1][r] = b1 + cr[r]; }
            } else {
#pragma unroll
                for (int hf = 0; hf < 2; ++hf)
#pragma unroll
                    for (int r = 0; r < 16; ++r) p[hf][r] = -slope2 * fabsf((float)(qrow - (64 * t + 32 * hf + crow(r, hi)))) - mref;
            }
#pragma unroll
            for (int hf = 0; hf < 2; ++hf)
#pragma unroll
                for (int ks = 0; ks < 4; ++ks) { const bf16x8 a = *(const LAS bf16x8*)(uintptr_t)(ka + buf * DA_KBUF + hf * 32 * DA_KSTR + ks * 32); p[hf] = MFMA32(a, qf[ks], p[hf]); }
            if (!NOMAX) {
            float mx = fmaxf(p[0][0], p[1][0]);
#pragma unroll
            for (int r = 1; r < 16; ++r) mx = fmaxf(mx, fmaxf(p[0][r], p[1][r]));
            mx = xmax32(mx);
            if (__any(mx > 8.0f)) { const float dl = fmaxf(mx, 0.f), alpha = ex2(-dl); mref += dl; lsum *= alpha;
#pragma unroll
                for (int r = 0; r < 16; ++r) { p[0][r] -= dl; p[1][r] -= dl; }
#pragma unroll
                for (int d = 0; d < 4; ++d)
#pragma unroll
                    for (int r = 0; r < 16; ++r) o[d][r] *= alpha; }
            }
            bf16x8 pf[2][2];
#pragma unroll
            for (int hf = 0; hf < 2; ++hf) {
#pragma unroll
                for (int r = 0; r < 16; ++r) { p[hf][r] = ex2(p[hf][r]); lsum += p[hf][r]; }
#pragma unroll
                for (int k2 = 0; k2 < 2; ++k2) { v4u w; w.x = cvtpk(p[hf][8 * k2], p[hf][8 * k2 + 1]); w.y = cvtpk(p[hf][8 * k2 + 2], p[hf][8 * k2 + 3]); w.z = cvtpk(p[hf][8 * k2 + 4], p[hf][8 * k2 + 5]); w.w = cvtpk(p[hf][8 * k2 + 6], p[hf][8 * k2 + 7]);
                    pf[hf][k2] = __builtin_bit_cast(bf16x8, w); } }
#pragma unroll
            for (int db = 0; db < 4; ++db)
#pragma unroll
                for (int hf = 0; hf < 2; ++hf)
#pragma unroll
                    for (int k2 = 0; k2 < 2; ++k2) { const unsigned ad = va + buf * DA_VBUF + db * 4096 + (32 * hf + 16 * k2) * 64;
                        const s16x4 lo = ds_tr16(ad), hh = ds_tr16(ad + 8 * 64);
                        const bf16x8 a = {lo[0], lo[1], lo[2], lo[3], hh[0], hh[1], hh[2], hh[3]};
                        o[db] = MFMA32(a, pf[hf][k2], o[db]); }
        }
        if (t + 1 < NT) {
#pragma unroll
            for (int i = 0; i < 2; ++i) { *(LAS v4u*)(uintptr_t)(kdst[i] + (buf ^ 1) * DA_KBUF) = kreg[i]; *(LAS v4u*)(uintptr_t)(vdst[i] + (buf ^ 1) * DA_VBUF) = vreg[i]; } }
        __syncthreads();
    }
    };
    if (bounded) da_loop(std::true_type{}); else da_loop(std::false_type{});
    lsum = xsum32(lsum);
    const float il = 1.0f / lsum;
    LAS float* xb = (LAS float*)lds + qs * 4096 + lane;
    if (mm == 1) {
#pragma unroll
        for (int db = 0; db < 4; ++db)
#pragma unroll
            for (int r = 0; r < 16; ++r) xb[(db * 16 + r) * 64] = o[db][r] * il;
    }
    __syncthreads();
    if (mm == 0) {
        const float lam = __builtin_bit_cast(float, (unsigned)MISC[2]), lambda_init = __builtin_bit_cast(float, (unsigned)MISC[3]);
        float ss = 0.f;
#pragma unroll
        for (int db = 0; db < 4; ++db)
#pragma unroll
            for (int r = 0; r < 16; ++r) { const float dv = o[db][r] * il - lam * xb[(db * 16 + r) * 64]; o[db][r] = dv; ss += dv * dv; }
        ss += __shfl_xor(ss, 32);
        const float rn = (1.0f - lambda_init) / sqrtf(ss * (1.0f / 128.0f) + EPS);
        bf16* yp = y + (rowbase + qrow) * D + h * 128 + 4 * hi; const float* gp = subln_g + 4 * hi;
#pragma unroll
        for (int db = 0; db < 4; ++db)
#pragma unroll
            for (int g = 0; g < 4; ++g) { const f32x4 gg = *(const f32x4*)(gp + 32 * db + 8 * g);
                const unsigned long long w = (unsigned long long)cvtpk(o[db][4 * g] * rn * gg.x, o[db][4 * g + 1] * rn * gg.y) | ((unsigned long long)cvtpk(o[db][4 * g + 2] * rn * gg.z, o[db][4 * g + 3] * rn * gg.w) << 32);
                *(unsigned long long*)(yp + 32 * db + 8 * g) = w; }
    }
    __syncthreads();
}

__device__ __forceinline__ void phase_mlconv(const bf16* z, const float* conv_w, const float* conv_b, bf16* qkc, int tid, int G) {
    const int cg = tid & 127, rs = tid >> 7, ch = 8 * cg;
    const float scl = (ch >= 512) ? 0.08838834764831845f : 1.0f;
    for (int item = blockIdx.x; item < M / 16; item += G) {
        const int row0 = item * 16 + 4 * rs, t0 = row0 % SEQ;
        v4u xr[7];
#pragma unroll
        for (int j = 0; j < 7; ++j) { const int tt = t0 - 3 + j; xr[j] = (tt >= 0) ? *(const v4u*)(z + (size_t)(row0 - 3 + j) * AB_N + 1536 + ch) : (v4u){0u, 0u, 0u, 0u}; }
        float a4[4][8];
        { const f32x4 b0 = *(const f32x4*)(conv_b + ch), b1 = *(const f32x4*)(conv_b + ch + 4);
#pragma unroll
            for (int r = 0; r < 4; ++r) { a4[r][0] = b0.x; a4[r][1] = b0.y; a4[r][2] = b0.z; a4[r][3] = b0.w; a4[r][4] = b1.x; a4[r][5] = b1.y; a4[r][6] = b1.z; a4[r][7] = b1.w; } }
#pragma unroll
        for (int j = 0; j < 4; ++j) { const f32x4 w0 = *(const f32x4*)(conv_w + j * 1024 + ch), w1 = *(const f32x4*)(conv_w + j * 1024 + ch + 4);
#pragma unroll
            for (int r = 0; r < 4; ++r) { const v4u u = xr[r + j];
                a4[r][0] += bf_lo(u.x) * w0.x; a4[r][1] += bf_hi(u.x) * w0.y; a4[r][2] += bf_lo(u.y) * w0.z; a4[r][3] += bf_hi(u.y) * w0.w;
                a4[r][4] += bf_lo(u.z) * w1.x; a4[r][5] += bf_hi(u.z) * w1.y; a4[r][6] += bf_lo(u.w) * w1.z; a4[r][7] += bf_hi(u.w) * w1.w; } }
#pragma unroll
        for (int r = 0; r < 4; ++r) { float a[8];
#pragma unroll
            for (int i = 0; i < 8; ++i) a[i] = a4[r][i] * fast_sig(a4[r][i]) * scl;
            v4u w; w.x = cvtpk(a[0], a[1]); w.y = cvtpk(a[2], a[3]); w.z = cvtpk(a[4], a[5]); w.w = cvtpk(a[6], a[7]);
            *(v4u*)(qkc + (size_t)(row0 + r) * 1024 + ch) = w; }
    }
}

typedef float f32x4v __attribute__((ext_vector_type(4)));
#define MFMA16(a, b, c) __builtin_amdgcn_mfma_f32_16x16x32_bf16((a), (b), (c), 0, 0, 0)
constexpr int ML_STR = 272, ML_VSTR = 144, ML_Q = 0, ML_K = 17408, ML_KBUF = 80 * ML_STR, ML_V = ML_K + 2 * ML_KBUF, ML_VW = ML_V + 64 * ML_VSTR, ML_P = ML_VW + 64 * ML_VSTR, ML_PSTR = 144,
              ML_H = ML_P + 64 * ML_PSTR, ML_T = ML_H + 64 * ML_VSTR, ML_TPAR = 2048, ML_DENP = ML_T + 2 * ML_TPAR, ML_DN = ML_DENP + 1024, ML_DUMMY = ML_DN + 256, ML_XCH = ML_DUMMY + 512, ML_END = ML_XCH + 16384;
constexpr int ML_RS = RING_BYTES + 1024;
static_assert(ML_END <= RING_BYTES && ML_RS + 4096 <= LDS_BYTES && MISC_OFF + 128 <= RING_BYTES + 1024, "mLSTM LDS map");
__device__ __forceinline__ float bcast63(float v) { return __builtin_bit_cast(float, __builtin_amdgcn_readlane(__builtin_bit_cast(int, v), 63)); }
__device__ __forceinline__ void ml_gate_tables(float lfv, float igv, LAS float* tp, float& mprev, int lane) {
    lfv *= LOG2E; igv *= LOG2E;
    const float a = scan_add(lfv, lane), b = igv - a, cm = scan_max(b, lane);
    const float alast = bcast63(a), bmax = bcast63(cm);
    const float mnew = fmaxf(alast + mprev, alast + bmax), Mv = fmaxf(mprev, cm);
    tp[lane] = b; tp[64 + lane] = Mv; tp[128 + lane] = ex2(mprev - Mv); tp[192 + lane] = ex2(-(a + Mv)); tp[256 + lane] = ex2(alast + b - mnew);
    if (lane == 0) tp[320] = ex2(alast + mprev - mnew);
    mprev = mnew;
}
template <int STRIDE> __device__ __forceinline__ bf16x8 tr_frag(unsigned addr) {
    const s16x4 lo = ds_tr16(addr), hh = ds_tr16(addr + 4 * STRIDE);
    return (bf16x8){lo[0], lo[1], lo[2], lo[3], hh[0], hh[1], hh[2], hh[3]}; }
__device__ __forceinline__ void mlstm_unit(int b, int h, int dh, const bf16* z, const bf16* qkc, const float* gates, bf16* y, LAS unsigned char* lds, int tid, int lane, int wave) {
    const size_t rowbase = (size_t)b * SEQ;
    const unsigned lds0 = (unsigned)(uintptr_t)lds;
    const float* gi = gates + ((size_t)b * 4 + h) * SEQ; const float* glf = gates + (size_t)BATCH * 4 * SEQ + ((size_t)b * 4 + h) * SEQ;
    const int c15 = lane & 15, kq = lane >> 4;
    const int sl = wave >> 1, rr = wave & 1;
    const bf16* gq = qkc + rowbase * 1024 + h * 128;
    const bf16* zv = z + rowbase * AB_N + 2560 + h * 128 + 64 * dh + 8 * (tid & 7);
    const int vrow = tid >> 3;
    v4u qr[2], kr[2], vr;
#define ML_LOADS(cn) do { _Pragma("unroll") for (int i = 0; i < 2; ++i) { const int c_ = tid + 512 * i; const size_t r_ = (size_t)(64 * (cn) + (c_ >> 4)); \
            qr[i] = *(const v4u*)(gq + r_ * 1024 + 8 * (c_ & 15)); kr[i] = *(const v4u*)(gq + r_ * 1024 + 512 + 8 * (c_ & 15)); } \
        vr = *(const v4u*)(zv + (size_t)(64 * (cn) + vrow) * AB_N); } while (0)
#define ML_CONV_STORE(kb) do { _Pragma("unroll") for (int i = 0; i < 2; ++i) { const int c_ = tid + 512 * i; const unsigned o_ = (c_ >> 4) * ML_STR + 16 * (c_ & 15); \
            *(LAS v4u*)(uintptr_t)(lds0 + ML_Q + o_) = qr[i]; *(LAS v4u*)(uintptr_t)(lds0 + ML_K + (kb) * ML_KBUF + o_) = kr[i]; } } while (0)
#define ML_V_STORE(tp) do { const float w_ = (tp)[256 + vrow]; const v4u u = vr; const unsigned o_ = vrow * ML_VSTR + 16 * (tid & 7); \
            *(LAS v4u*)(uintptr_t)(lds0 + ML_V + o_) = u; \
            v4u x_; x_.x = cvtpk(bf_lo(u.x) * w_, bf_hi(u.x) * w_); x_.y = cvtpk(bf_lo(u.y) * w_, bf_hi(u.y) * w_); x_.z = cvtpk(bf_lo(u.z) * w_, bf_hi(u.z) * w_); x_.w = cvtpk(bf_lo(u.w) * w_, bf_hi(u.w) * w_); \
            *(LAS v4u*)(uintptr_t)(lds0 + ML_VW + o_) = x_; } while (0)
    LAS float* T0 = (LAS float*)(lds + ML_T);
    LAS float* denp = (LAS float*)(lds + ML_DENP);
    LAS float* dnr = (LAS float*)(lds + ML_DN);
    LAS float* xch = (LAS float*)(lds + ML_XCH);
    float mprev = 0.f;
    float g_lf = 0.f, g_ig = 0.f;
    if (wave == 7) { ml_gate_tables(glf[lane], gi[lane], T0, mprev, lane); g_lf = glf[64 + lane]; g_ig = gi[64 + lane]; }
    ML_LOADS(0);
    ML_CONV_STORE(0);
    if (tid < 32) *(LAS unsigned long long*)(uintptr_t)(lds0 + ML_K + 64 * ML_STR + 8 * tid) = (unsigned long long)(tid >> 20);
    __syncthreads();
    ML_V_STORE(T0);
    f32x4v C[4], nacc = {0.f, 0.f, 0.f, 0.f};
#pragma unroll
    for (int T = 0; T < 4; ++T) C[T] = (f32x4v){0.f, 0.f, 0.f, 0.f};
    const int lt_s = wave >> 1, half_s = wave & 1;
#define ML_PHASE_C(cc, OG) do { const v4u hv = *(const LAS v4u*)(uintptr_t)(lds0 + ML_H + vrow * ML_VSTR + 16 * (tid & 7)); const v4u og = OG; \
        v4u o_; o_.x = cvtpk(bf_lo(hv.x) * fast_sig(bf_lo(og.x)), bf_hi(hv.x) * fast_sig(bf_hi(og.x))); o_.y = cvtpk(bf_lo(hv.y) * fast_sig(bf_lo(og.y)), bf_hi(hv.y) * fast_sig(bf_hi(og.y))); \
        o_.z = cvtpk(bf_lo(hv.z) * fast_sig(bf_lo(og.z)), bf_hi(hv.z) * fast_sig(bf_hi(og.z))); o_.w = cvtpk(bf_lo(hv.w) * fast_sig(bf_lo(og.w)), bf_hi(hv.w) * fast_sig(bf_hi(og.w))); \
        *(v4u*)(y + (rowbase + 64 * (cc) + vrow) * D + 512 + h * 128 + 64 * dh + 8 * (tid & 7)) = o_; } while (0)
    v4u ogp = (v4u){0u, 0u, 0u, 0u};
    __syncthreads();
    for (int c = 0; c < SEQ / 64; ++c) {
        const int par = c & 1, kb = c & 1; LAS float* tp = T0 + par * (ML_TPAR / 4);
        const unsigned Kb = lds0 + ML_K + kb * ML_KBUF;
        const bool more = (c + 1 < SEQ / 64);
        const v4u vcur = vr;
        float gn_lf = 0.f, gn_ig = 0.f;
        if (more) { ML_LOADS(c + 1); if (wave == 7 && c + 2 < SEQ / 64) { gn_lf = glf[64 * (c + 2) + lane]; gn_ig = gi[64 * (c + 2) + lane]; } }
        const v4u ogr = *(const v4u*)(zv + (size_t)(64 * c + vrow) * AB_N + 512);
        {
            bf16x8 qb[4], kf[2][4], nf[4];
            const int l = 16 * lt_s + c15;
#pragma unroll
            for (int ks = 0; ks < 4; ++ks) qb[ks] = *(const LAS bf16x8*)(uintptr_t)(lds0 + ML_Q + l * ML_STR + (32 * ks + 8 * kq) * 2);
#pragma unroll
            for (int jj = 0; jj < 2; ++jj)
#pragma unroll
                for (int ks = 0; ks < 4; ++ks) kf[jj][ks] = *(const LAS bf16x8*)(uintptr_t)(Kb + (16 * (2 * half_s + jj) + c15) * ML_STR + (32 * ks + 8 * kq) * 2);
#pragma unroll
            for (int ks = 0; ks < 4; ++ks) nf[ks] = *(const LAS bf16x8*)(uintptr_t)(Kb + (64 + c15) * ML_STR + (32 * ks + 8 * kq) * 2);
            const float Ml = tp[64 + l];
            const f32x4v bs0 = *(const LAS f32x4v*)(tp + 16 * (2 * half_s) + 4 * kq), bs1 = *(const LAS f32x4v*)(tp + 16 * (2 * half_s + 1) + 4 * kq);
            if (c > 0) { ML_PHASE_C(c - 1, ogp);
                { const float w_ = tp[256 + vrow]; const v4u u = vcur; const unsigned o_ = vrow * ML_VSTR + 16 * (tid & 7);
                    *(LAS v4u*)(uintptr_t)(lds0 + ML_V + o_) = u;
                    v4u x_; x_.x = cvtpk(bf_lo(u.x) * w_, bf_hi(u.x) * w_); x_.y = cvtpk(bf_lo(u.y) * w_, bf_hi(u.y) * w_); x_.z = cvtpk(bf_lo(u.z) * w_, bf_hi(u.z) * w_); x_.w = cvtpk(bf_lo(u.w) * w_, bf_hi(u.w) * w_);
                    *(LAS v4u*)(uintptr_t)(lds0 + ML_VW + o_) = x_; } }
            if (more && wave == 7) { ml_gate_tables(g_lf, g_ig, T0 + (par ^ 1) * (ML_TPAR / 4), mprev, lane); g_lf = gn_lf; g_ig = gn_ig; }
            ogp = ogr;
            SCHED_FENCE();
            f32x4v acc[2] = {{0.f, 0.f, 0.f, 0.f}, {0.f, 0.f, 0.f, 0.f}}, accn = {0.f, 0.f, 0.f, 0.f};
#pragma unroll
            for (int ks = 0; ks < 4; ++ks) { acc[0] = MFMA16(kf[0][ks], qb[ks], acc[0]); acc[1] = MFMA16(kf[1][ks], qb[ks], acc[1]); if (half_s == 0) accn = MFMA16(nf[ks], qb[ks], accn); }
#pragma unroll
            for (int jj = 0; jj < 2; ++jj) { const int st = 2 * half_s + jj; const f32x4v bs = jj ? bs1 : bs0;
                float p[4], sum = 0.f;
#pragma unroll
                for (int r = 0; r < 4; ++r) { const int sidx = 16 * st + 4 * kq + r; p[r] = (sidx <= l) ? acc[jj][r] * ex2(bs[r] - Ml) : 0.f; sum += p[r]; }
                sum = xsum32(xsum16(sum));
                denp[st * 64 + l] = sum;
                *(LAS unsigned long long*)(uintptr_t)(lds0 + ML_P + l * ML_PSTR + (16 * st + 4 * kq) * 2) = (unsigned long long)cvtpk(p[0], p[1]) | ((unsigned long long)cvtpk(p[2], p[3]) << 32);
            }
            if (half_s == 0) *(LAS float*)(uintptr_t)(kq == 0 ? lds0 + ML_DN + 4 * l : lds0 + ML_DUMMY + 8 * lane) = accn[0];
        }
        f32x4v hp[4];
        {
            bf16x8 cbf[2];
#pragma unroll
            for (int j = 0; j < 2; ++j) { v4u w_; w_.x = cvtpk(C[2 * j][0], C[2 * j][1]); w_.y = cvtpk(C[2 * j][2], C[2 * j][3]); w_.z = cvtpk(C[2 * j + 1][0], C[2 * j + 1][1]); w_.w = cvtpk(C[2 * j + 1][2], C[2 * j + 1][3]);
                cbf[j] = __builtin_bit_cast(bf16x8, w_); }
            unsigned long long qlo[4][2], qhi[4][2];
#pragma unroll
            for (int lt = 0; lt < 4; ++lt)
#pragma unroll
                for (int j = 0; j < 2; ++j) { const unsigned qa = lds0 + ML_Q + (16 * lt + c15) * ML_STR + (32 * (2 * rr + j) + 4 * kq) * 2;
                    qlo[lt][j] = *(const LAS unsigned long long*)(uintptr_t)qa; qhi[lt][j] = *(const LAS unsigned long long*)(uintptr_t)(qa + 32); }
            SCHED_FENCE();
#pragma unroll
            for (int lt = 0; lt < 4; ++lt) { hp[lt] = (f32x4v){0.f, 0.f, 0.f, 0.f};
#pragma unroll
                for (int j = 0; j < 2; ++j) { v4u w_; w_.x = (unsigned)qlo[lt][j]; w_.y = (unsigned)(qlo[lt][j] >> 32); w_.z = (unsigned)qhi[lt][j]; w_.w = (unsigned)(qhi[lt][j] >> 32);
                    hp[lt] = MFMA16(__builtin_bit_cast(bf16x8, w_), cbf[j], hp[lt]); } }
#pragma unroll
            for (int i = 0; i < 2; ++i)
#pragma unroll
                for (int r = 0; r < 4; ++r) xch[((wave * 2 + i) * 4 + r) * 64 + lane] = rr ? hp[i][r] : hp[2 + i][r];
        }
        __syncthreads();
        const float decay = tp[320];
        bf16x8 vb[2], pfr[2][2], vwb[2], wb[2], an[2], af[4][2]; float xp[2][4];
#pragma unroll
        for (int k2 = 0; k2 < 2; ++k2) { vb[k2] = tr_frag<ML_VSTR>(lds0 + ML_V + (32 * k2 + 8 * kq + ((lane & 15) >> 2)) * ML_VSTR + (16 * sl + 4 * (lane & 3)) * 2);
            vwb[k2] = tr_frag<ML_VSTR>(lds0 + ML_VW + (32 * k2 + 8 * kq + ((lane & 15) >> 2)) * ML_VSTR + (16 * sl + 4 * (lane & 3)) * 2);
            an[k2] = tr_frag<ML_STR>(Kb + (32 * k2 + 8 * kq + ((lane & 15) >> 2)) * ML_STR + (16 * wave + 4 * (lane & 3)) * 2);
            const f32x4v w0 = *(const LAS f32x4v*)(tp + 256 + 32 * k2 + 8 * kq), w1 = *(const LAS f32x4v*)(tp + 256 + 32 * k2 + 8 * kq + 4);
            v4u w_; w_.x = cvtpk(w0[0], w0[1]); w_.y = cvtpk(w0[2], w0[3]); w_.z = cvtpk(w1[0], w1[1]); w_.w = cvtpk(w1[2], w1[3]);
            if (c15 != 0) w_ = (v4u){0u, 0u, 0u, 0u};
            wb[k2] = __builtin_bit_cast(bf16x8, w_); }
#pragma unroll
        for (int i = 0; i < 2; ++i) {
#pragma unroll
            for (int r = 0; r < 4; ++r) xp[i][r] = xch[(((wave ^ 1) * 2 + i) * 4 + r) * 64 + lane];
#pragma unroll
            for (int k2 = 0; k2 < 2; ++k2) pfr[i][k2] = *(const LAS bf16x8*)(uintptr_t)(lds0 + ML_P + (16 * (2 * rr + i) + c15) * ML_PSTR + (32 * k2 + 8 * kq) * 2); }
#pragma unroll
        for (int Ti = 0; Ti < 4; ++Ti)
#pragma unroll
            for (int k2 = 0; k2 < 2; ++k2) af[Ti][k2] = tr_frag<ML_STR>(Kb + (32 * k2 + 8 * kq + ((lane & 15) >> 2)) * ML_STR + (16 * (4 * rr + Ti) + 4 * (lane & 3)) * 2);
        LAS float* rsw = (LAS float*)(lds + ML_RS) + wave * 128;
        { const float iwl = tp[128 + lane], fll = tp[192 + lane];
            const float den = iwl * dnr[lane] + ((denp[lane] + denp[64 + lane]) + (denp[128 + lane] + denp[192 + lane]));
            rsw[lane] = iwl; rsw[64 + lane] = __builtin_amdgcn_rcpf(fmaxf(fabsf(den), fll)); }
        f32x4v iw4[2], rs4[2];
#pragma unroll
        for (int i = 0; i < 2; ++i) { iw4[i] = *(const LAS f32x4v*)(rsw + 16 * (2 * rr + i) + 4 * kq); rs4[i] = *(const LAS f32x4v*)(rsw + 64 + 16 * (2 * rr + i) + 4 * kq); }
        SCHED_FENCE();
        {
            f32x4v hacc[2];
#pragma unroll
            for (int i = 0; i < 2; ++i) {
#pragma unroll
                for (int r = 0; r < 4; ++r) hacc[i][r] = ((rr ? hp[2 + i][r] : hp[i][r]) + xp[i][r]) * iw4[i][r];
#pragma unroll
                for (int k2 = 0; k2 < 2; ++k2) hacc[i] = MFMA16(pfr[i][k2], vb[k2], hacc[i]); }
#pragma unroll
            for (int i = 0; i < 2; ++i)
#pragma unroll
                for (int r = 0; r < 4; ++r) { const float hv = hacc[i][r] * rs4[i][r];
                    *(LAS bf16*)(uintptr_t)(lds0 + ML_H + (16 * (2 * rr + i) + 4 * kq + r) * ML_VSTR + (16 * sl + c15) * 2) = (bf16)(cvtpk(hv, 0.f) & 0xffffu); }
        }
        {
#pragma unroll
            for (int r = 0; r < 4; ++r) nacc[r] *= decay;
#pragma unroll
            for (int Ti = 0; Ti < 4; ++Ti) {
#pragma unroll
                for (int r = 0; r < 4; ++r) C[Ti][r] *= decay;
#pragma unroll
                for (int k2 = 0; k2 < 2; ++k2) C[Ti] = MFMA16(af[Ti][k2], vwb[k2], C[Ti]); }
#pragma unroll
            for (int k2 = 0; k2 < 2; ++k2) nacc = MFMA16(an[k2], wb[k2], nacc);
            *(LAS unsigned long long*)(uintptr_t)(c15 == 0 ? lds0 + ML_K + (kb ^ 1) * ML_KBUF + 64 * ML_STR + (16 * wave + 4 * kq) * 2 : lds0 + ML_DUMMY + 8 * lane) = (unsigned long long)cvtpk(nacc[0], nacc[1]) | ((unsigned long long)cvtpk(nacc[2], nacc[3]) << 32);
        }
        if (more) ML_CONV_STORE(kb ^ 1);
        __syncthreads();
    }
    ML_PHASE_C(SEQ / 64 - 1, ogp);
    __syncthreads();
#undef ML_PHASE_C
#undef ML_LOADS
#undef ML_CONV_STORE
#undef ML_V_STORE
}

constexpr int N_PHASES = 1 + 7 * DEPTH;
__global__ void __launch_bounds__(NTHREADS, 2) fwd_kernel(Args args) {
    extern __shared__ __attribute__((aligned(16))) unsigned char lds_raw[];
    LAS unsigned char* lds = (LAS unsigned char*)lds_raw;
    volatile LAS unsigned* MISC = (volatile LAS unsigned*)(lds + MISC_OFF);
    const int tid0 = threadIdx.x;
    const int G = gridDim.x;
    unsigned char* ws = args.ws;
    gu32* ctl = (gu32*)(ws + WS_CTL);
    for (int u = tid0; u < (LDS_BYTES - LDSCTL_OFF) / 4; u += NTHREADS) ((LAS unsigned*)(lds + LDSCTL_OFF))[u] = 0u;
    __syncthreads();
    XcdBarrier bar; bar.bar = (unsigned*)(ctl + CW_BAR); bar.x = 0; bar.st = nullptr;
    const int lo = args.ph_lo, hi = args.ph_hi;
    if (hi - lo > 1) bar = xcd_barrier_post((unsigned*)(ctl + CW_BAR), MISC + 8);
#define IN(k) (lo <= (k) && (k) < hi)
#define FRESH_TID() int tid = tid0; asm volatile("" : "+v"(tid)); const int lane = tid & 63, wave = __builtin_amdgcn_readfirstlane(tid >> 6); (void)lane; (void)wave
#define SEAM(k) do { if (IN(k) && IN((k) + 1)) xcd_barrier(bar); } while (0)

    float* mod = (float*)(ws + WS_MOD);
    float* gates = (float*)(ws + WS_GATE);
    bf16* A1 = (bf16*)(ws + WS_A1);
    bf16* Z = (bf16*)(ws + WS_Z);

    if (IN(0)) for (int rp = 0; rp < REP_PRO; ++rp) { const int tid = tid0, lane = tid & 63, wave = __builtin_amdgcn_readfirstlane(tid >> 6); if (rp) xcd_barrier(bar); phase_prologue(args, lds, tid, lane, wave, G); }
    SEAM(0);

    for (int l = 0; l < DEPTH; ++l) {
        const int base = 1 + 7 * l, j = l >> 1; const bool odd = (l & 1) != 0;
        bf16* XB = (bf16*)args.out;
        bf16* XB2 = (bf16*)(ws + WS_XB2);
        const float* modl = mod + (size_t)l * BATCH * MODW;
        if (IN(base + 0)) for (int rp = 0; rp < REP_NORM; ++rp) { FRESH_TID(); if (rp) xcd_barrier(bar);
            if (l == 0) phase_norm<8, false>(args.in[0], args.in[4] + l * D, modl + 0 * D, modl + 1 * D, A1, args.in[6] + (size_t)j * D * AB_LD, AB_LD, AB_N, args.in[7] + j * 4, args.in[8] + j * 4, gates, lds, tid, lane, wave, G);
            else if (!odd) phase_norm<8, true>(XB, args.in[4] + l * D, modl + 0 * D, modl + 1 * D, A1, args.in[6] + (size_t)j * D * AB_LD, AB_LD, AB_N, args.in[7] + j * 4, args.in[8] + j * 4, gates, lds, tid, lane, wave, G);
            else phase_norm<16, true>(XB, args.in[4] + l * D, modl + 0 * D, modl + 1 * D, A1, args.in[16] + (size_t)j * D * FX_LD, FX_LD, FX_N, nullptr, args.in[17] + j * 16, gates, lds, tid, lane, wave, G);
        }
        SEAM(base + 0);
        if (IN(base + 1)) for (int rp = 0; rp < REP_GIN; ++rp) { if (rp) xcd_barrier(bar);
            const int N = odd ? FX_N : AB_N;
            pg8::Gemm g{A1, odd ? (const bf16*)(ws + WS_WIN_O) + (size_t)j * FX_N * D : (const bf16*)(ws + WS_WIN_E) + (size_t)j * AB_N * D, M, N, D};
            pg8::StaticOrder S; S.init(M, N, G, (int)blockIdx.x);
            pg8::EpiIn E{Z, N, odd ? 1024 : 512, odd ? 2048 : 1024, odd ? args.in[18] + j * 64 : args.in[11] + j * 64, odd ? args.in[19] + j * 64 : args.in[12] + j * 64, 0.125f * LOG2E};
            pg8::gemm_phase<pg8::EpiIn, pg8::StaticOrder, true, true>(lds + RING_OFF, g, S, E);
        }
        SEAM(base + 1);
        if (IN(base + 2)) for (int rp = 0; rp < (odd ? REP_MIX_O : REP_MIX_E); ++rp) { FRESH_TID(); if (rp) xcd_barrier(bar);
            gu32* head = ctl + CW_QUEUE + 64 * (l + 4 * rp);
            if (!odd) {
#if USE_ML_MFMA
                phase_mlconv(Z, args.in[9] + (size_t)j * 4 * 1024, args.in[10] + (size_t)j * 1024, (bf16*)(ws + WS_QKC), tid, G);
                if (hi - lo > 1) xcd_barrier(bar);
#endif
                if (tid0 == 0) { const float lambda_init = 0.8f - 0.6f * expf(-0.3f * (float)l);
                    const float* lp = args.in[13] + j * 256; float s0 = 0.f, s1 = 0.f; for (int d = 0; d < 64; ++d) { s0 += lp[d] * lp[64 + d]; s1 += lp[128 + d] * lp[192 + d]; }
                    MISC[2] = __builtin_bit_cast(unsigned, expf(s0) - expf(s1) + lambda_init); MISC[3] = __builtin_bit_cast(unsigned, lambda_init);
                    const float* gq = args.in[11] + j * 64; const float* gk = args.in[12] + j * 64; float gm = 0.f; for (int d = 0; d < 64; ++d) gm = fmaxf(gm, fabsf(gq[d] * gk[d]));
                    MISC[4] = (8.0f * LOG2E * gm < 64.0f) ? 1u : 0u;
                    MISC[5] = __builtin_bit_cast(unsigned, 54.0f + 16.0f * LOG2E * gm); }
                for (;;) { int idx = queue_next(head, MISC, tid0); if (idx >= 64 * REP_ML + 1024 * REP_DA) break;
                    if (idx < 64 * REP_ML) idx &= 63; else idx = 64 + ((idx - 64 * REP_ML) & 1023);
                    int tid = tid0; asm volatile("" : "+v"(tid)); const int lane = tid & 63, wave = __builtin_amdgcn_readfirstlane(tid >> 6);
#if USE_ML_MFMA
                    if (idx < 64) mlstm_unit(idx >> 3, (idx >> 1) & 3, idx & 1, Z, (const bf16*)(ws + WS_QKC), gates, A1, lds, tid, lane, wave);
#else
                    if (idx < 32) mlstm_naive_unit(idx >> 2, idx & 3, Z, gates, args.in[9] + (size_t)j * 4 * 1024, args.in[10] + (size_t)j * 1024, A1, lds, tid);
#endif
                    else { const int u = idx - 64, qb = 31 - u / 32, bh = u % 32;
#if USE_DA_MFMA
                        da_unit(bh >> 2, bh & 3, qb, Z, A1, MISC, MISC[4] != 0u, args.in[14] + j * 128, lds, tid, lane, wave);
#ifdef DBG_DA_BOTH
                        da_naive_unit(bh >> 2, bh & 3, qb, Z, A1, args.in[13] + j * 256, args.in[14] + j * 128, l, lane, wave);
#endif
#else
                        da_naive_unit(bh >> 2, bh & 3, qb, Z, A1, args.in[13] + j * 256, args.in[14] + j * 128, l, lane, wave);
#endif
                    } }
            } else {
#if USE_FOX_MFMA
                if (tid0 == 0) { const float* gq = args.in[18] + j * 64; const float* gk = args.in[19] + j * 64; float gm = 0.f; for (int d = 0; d < 64; ++d) gm = fmaxf(gm, fabsf(gq[d] * gk[d]));
                    MISC[4] = (8.0f * LOG2E * gm < 64.0f) ? 1u : 0u;
                    MISC[5] = __builtin_bit_cast(unsigned, 54.0f + 16.0f * LOG2E * gm); }
                for (;;) { const int idx = queue_next(head, MISC, tid0); if (idx >= 2048) break;
                    int tid = tid0; asm volatile("" : "+v"(tid)); const int lane = tid & 63, wave = __builtin_amdgcn_readfirstlane(tid >> 6);
                    const int qb = 15 - idx / 128, bh = idx % 128; fox_unit(bh >> 4, bh & 15, qb, Z, gates, A1, MISC[4] != 0u, __builtin_bit_cast(float, (unsigned)MISC[5]), lds, tid, lane, wave); }
#else
                for (;;) { const int idx = queue_next(head, MISC, tid); if (idx >= 1024) break;
                    const int qb = 7 - idx / 128, bh = idx % 128; fox_naive_unit(bh >> 4, bh & 15, qb, Z, gates, A1, lds, tid, lane, wave); }
#endif
            }
        }
        SEAM(base + 2);
        if (IN(base + 3)) for (int rp = 0; rp < REP_GOUT; ++rp) { if (rp) xcd_barrier(bar);
            pg8::Gemm g{A1, (const bf16*)(ws + WS_WOUT) + (size_t)l * D * D, M, D, D};
            pg8::StaticOrder S; S.init(M, D, G, (int)blockIdx.x);
            const bool dry = (rp + 1 < REP_GOUT);
            const bool last = (l == DEPTH - 1); bf16* xo = last ? XB2 : XB;
            pg8::EpiRes E{args.in[0], (l == 0 && !dry) ? nullptr : (dry ? xo : XB), nullptr, xo, dry ? (const float*)(ws + WS_CTL + 512 * 1024) : modl + 2 * D, dry ? 0 : MODW};
            pg8::gemm_phase<pg8::EpiRes, pg8::StaticOrder, true, true>(lds + RING_OFF, g, S, E);
        }
        SEAM(base + 3);
        if (IN(base + 4)) for (int rp = 0; rp < REP_NORM; ++rp) { FRESH_TID(); if (rp) xcd_barrier(bar); phase_norm<0, true>((l == DEPTH - 1) ? XB2 : XB, args.in[5] + l * D, modl + 3 * D, modl + 4 * D, A1, nullptr, 0, 0, nullptr, nullptr, nullptr, lds, tid, lane, wave, G); }
        SEAM(base + 4);
        if (IN(base + 5)) for (int rp = 0; rp < REP_GUP; ++rp) { if (rp) xcd_barrier(bar);
            pg8::Gemm g{A1, (const bf16*)(ws + WS_WUP) + (size_t)l * NUP * D, M, NUP, D};
            pg8::StaticOrder S; S.init(M, NUP, G, (int)blockIdx.x);
            pg8::EpiSwiglu E{Z, FFH};
            pg8::gemm_phase<pg8::EpiSwiglu, pg8::StaticOrder, true, true>(lds + RING_OFF, g, S, E);
        }
        SEAM(base + 5);
        if (IN(base + 6)) for (int rp = 0; rp < REP_GDN; ++rp) { if (rp) xcd_barrier(bar);
            pg8::Gemm g{Z, (const bf16*)(ws + WS_WDN) + (size_t)l * D * FFH, M, D, FFH};
            pg8::StaticOrder S; S.init(M, D, G, (int)blockIdx.x);
            const bool dry = (rp + 1 < REP_GDN);
            const bool last = (l == DEPTH - 1);
            pg8::EpiRes E{nullptr, last ? XB2 : XB, (last && !dry) ? args.out : nullptr, (last && !dry) ? nullptr : (last ? XB2 : XB), dry ? (const float*)(ws + WS_CTL + 512 * 1024) : modl + 5 * D, dry ? 0 : MODW};
            pg8::gemm_phase<pg8::EpiRes, pg8::StaticOrder, true, true>(lds + RING_OFF, g, S, E);
        }
        SEAM(base + 6);
    }
    for (int rp = 0; rp < REP_BAR; ++rp) xcd_barrier(bar);
#undef IN
#undef SEAM
}

extern "C" void kernel_launch(void* const* d_in, const int* in_sizes, int n_in, void* d_out, int out_size, void* d_ws, size_t ws_size, hipStream_t stream) {
    static int grid = 0;
    if (grid == 0) {
        if (n_in != 24 || out_size != M * D || ws_size < WS_END) { fprintf(stderr, "kernel_launch: unexpected shapes (n_in %d, out %d, ws %zu); nothing launched\n", n_in, out_size, ws_size); grid = -1; return; }
        int dev = 0, cus = 0, per_cu = 0;
        if (hipGetDevice(&dev) != hipSuccess || hipDeviceGetAttribute(&cus, hipDeviceAttributeMultiprocessorCount, dev) != hipSuccess) { grid = -1; return; }
        if (hipFuncSetAttribute((const void*)fwd_kernel, hipFuncAttributeMaxDynamicSharedMemorySize, LDS_BYTES) != hipSuccess) { fprintf(stderr, "kernel_launch: hipFuncSetAttribute failed\n"); grid = -1; return; }
        if (hipOccupancyMaxActiveBlocksPerMultiprocessor(&per_cu, (const void*)fwd_kernel, NTHREADS, LDS_BYTES) != hipSuccess || per_cu < 1) { fprintf(stderr, "kernel_launch: occupancy query reports %d blocks per CU\n", per_cu); }
        (void)hipGetLastError();
        grid = cus;
    }
    if (grid < 0) return;
    if (hipMemsetAsync((char*)d_ws + WS_CTL, 0, CTL_ZERO_BYTES, stream) != hipSuccess) return;
    Args a{};
    for (int i = 0; i < 24; ++i) a.in[i] = (const float*)d_in[i];
    a.out = (float*)d_out; a.ws = (unsigned char*)d_ws;
#if MK_SINGLE
    a.ph_lo = 0; a.ph_hi = N_PHASES;
    hipLaunchKernelGGL(fwd_kernel, dim3(grid), dim3(NTHREADS), LDS_BYTES, stream, a);
#else
    for (int p = 0; p < N_PHASES; ++p) { a.ph_lo = p; a.ph_hi = p + 1; hipLaunchKernelGGL(fwd_kernel, dim3(grid), dim3(NTHREADS), LDS_BYTES, stream, a); }
#endif
}
```

```cpp
#include <hip/hip_runtime.h>
#include <cstdio>
#include <cstdint>
#include <cmath>
#ifndef MK_SINGLE
#define MK_SINGLE 1
#endif
#ifndef USE_FOX_MFMA
#define USE_FOX_MFMA 1
#endif
#ifndef USE_DA_MFMA
#define USE_DA_MFMA 1
#endif
#ifndef USE_ML_MFMA
#define USE_ML_MFMA 1
#endif
#ifndef REP_NORM
#define REP_NORM 1
#endif
#ifndef REP_GIN
#define REP_GIN 1
#endif
#ifndef REP_MIX_E
#define REP_MIX_E 1
#endif
#ifndef REP_MIX_O
#define REP_MIX_O 1
#endif
#ifndef REP_GOUT
#define REP_GOUT 1
#endif
#ifndef REP_GUP
#define REP_GUP 1
#endif
#ifndef REP_GDN
#define REP_GDN 1
#endif
#ifndef REP_ML
#define REP_ML 1
#endif
#ifndef REP_DA
#define REP_DA 1
#endif
#ifndef REP_PRO
#define REP_PRO 1
#endif
#ifndef REP_BAR
#define REP_BAR 0
#endif
#ifndef PROBE_V2
#define PROBE_V2 0
#endif
#ifndef PROBE_M2
#define PROBE_M2 0
#endif
#ifndef PROBE_SEL
#define PROBE_SEL 0
#endif
#ifndef PROBE_BLK
#define PROBE_BLK 0
#endif
#ifndef PROBE_L
#define PROBE_L 1
#endif
#ifndef PROBE_UNIT
#define PROBE_UNIT 5
#endif
#ifndef PROBE_PH
#define PROBE_PH -1
#endif
#ifndef PROBE_LMASK
#define PROBE_LMASK 15
#endif
#ifndef PROBE_INCL
#define PROBE_INCL 1
#endif
#ifndef PROBE_SCALE
#define PROBE_SCALE 2
#endif
#ifndef PROBE_REST
#define PROBE_REST 0
#endif
#ifndef PROBE_GMODE
#define PROBE_GMODE 0
#endif
#ifndef PROBE_CLK
#define PROBE_CLK 0
#endif
#ifndef PROBE_CNT
#define PROBE_CNT 0
#endif
namespace pg8 {
#define PG8_LAS __attribute__((address_space(3)))
typedef unsigned short bf16_t;
typedef short bf16x8 __attribute__((ext_vector_type(8)));
typedef float f32x4 __attribute__((ext_vector_type(4)));
typedef unsigned u32x4 __attribute__((ext_vector_type(4)));
constexpr int BM = 256, BK = 64, HALF = 128, HTB = HALF * BK * 2  , STAGE_BYTES = 8 * HTB, NXCD = 8, WGM = 8;

__host__ __device__ __forceinline__ int lds_byte(int r, int c) { const int st = (r >> 4) * 2 + (c >> 5), rr = r & 15, cc = c & 31, ob = rr * 64 + cc * 2; return st * 1024 + (ob ^ (((ob >> 9) & 1) << 5)); }
__host__ __device__ __forceinline__ void stage_rc(int b, int& R, int& C) { const int st = b / 1024, sb = b % 1024, swz = sb ^ (((sb >> 9) & 1) << 5); R = (st >> 1) * 16 + swz / 64; C = (st & 1) * 32 + (swz % 64) / 2; }
__host__ __device__ __forceinline__ int perm32(int rho) { const int n = rho >> 4, i = rho & 15; return 8 * (i >> 2) + 4 * n + (i & 3); }

struct Unit { int pm, pn; };
struct Gemm { const bf16_t* A; const bf16_t* Bt; int M, N, K; };

struct StaticOrder {
    int nM, nN, nwg, G, c;
    __host__ __device__ void init(int M, int N, int G_, int c_) { nM = M / BM; nN = N / BM; nwg = nM * nN; G = G_; c = c_; }
    __host__ __device__ bool next(int i, Unit& u) const {
        const long L = (long)i * G + c; if (L >= nwg) return false;
        int wgid = (int)L; { const int q = nwg / NXCD, r = nwg % NXCD, xcd = wgid % NXCD, off = wgid / NXCD; wgid = (xcd < r ? xcd * (q + 1) : r * (q + 1) + (xcd - r) * q) + off; }
        const int nig = WGM * nN, gid = wgid / nig, fm = gid * WGM, gsz = (nM - fm) < WGM ? (nM - fm) : WGM;
        u.pm = fm + ((wgid % nig) % gsz); u.pn = (wgid % nig) / gsz; return true;
    }
    __device__ __forceinline__ void a_ready(const Unit&) const {}
    __device__ __forceinline__ void done(const Unit&) const {}
};

__device__ __forceinline__ unsigned cvt_pk_bf16(float lo, float hi) { unsigned r; asm volatile("v_cvt_pk_bf16_f32 %0, %1, %2" : "=v"(r) : "v"(lo), "v"(hi)); return r; }
typedef float f32x2 __attribute__((ext_vector_type(2)));
constexpr int SEQ_ROWS = 4096;
__device__ __forceinline__ float fast_sigmoid(float x) { return __builtin_amdgcn_rcpf(1.0f + __builtin_amdgcn_exp2f(-1.4426950408889634f * x)); }
struct EpiIn {
    static constexpr bool PERM = true, AFTER_DRAIN = false;
    bf16_t* Z; int ldz; int nq_end, nk_end; const float* gq; const float* gk; float qscale;
    __device__ __forceinline__ void operator()(const f32x4 (&acc)[2][2][4][2], const Unit& u, int wr, int wc, int fr, int fq) const {
        const int c0 = u.pn * BM + 64 * wc;
        const int mode = c0 < nq_end ? 1 : (c0 < nk_end ? 2 : 0);
        const int row0 = u.pm * BM + wr * 64 + fr;
        if (mode != 0) {
            const float* gp = (mode == 1 ? gq : gk) + 8 * fq;
            const float sc = (mode == 1) ? qscale : 1.0f;
            f32x4 gv[2][2];
#pragma unroll
            for (int bj = 0; bj < 2; ++bj)
#pragma unroll
                for (int n = 0; n < 2; ++n) gv[bj][n] = *(const f32x4*)(gp + 32 * bj + 4 * n);
#pragma unroll
            for (int ai = 0; ai < 2; ++ai)
#pragma unroll
                for (int m = 0; m < 4; ++m) {
                    float ss = 0.f;
#pragma unroll
                    for (int bj = 0; bj < 2; ++bj)
#pragma unroll
                        for (int n = 0; n < 2; ++n) { const f32x4 x = acc[ai][bj][m][n]; ss += (x[0] * x[0] + x[1] * x[1]) + (x[2] * x[2] + x[3] * x[3]); }
                    ss += __shfl_xor(ss, 16); ss += __shfl_xor(ss, 32);
                    const float r = sc / sqrtf(ss * (1.0f / 64.0f) + 1e-6f);
                    bf16_t* rowp = Z + (size_t)(row0 + ai * HALF + m * 16) * ldz + c0 + 8 * fq;
#pragma unroll
                    for (int bj = 0; bj < 2; ++bj) { const f32x4 v0 = acc[ai][bj][m][0] * r * gv[bj][0], v1 = acc[ai][bj][m][1] * r * gv[bj][1];
                        u32x4 w; w.x = cvt_pk_bf16(v0[0], v0[1]); w.y = cvt_pk_bf16(v0[2], v0[3]); w.z = cvt_pk_bf16(v1[0], v1[1]); w.w = cvt_pk_bf16(v1[2], v1[3]);
                        *(u32x4*)(rowp + 32 * bj) = w; }
                }
        } else {
#pragma unroll
            for (int ai = 0; ai < 2; ++ai)
#pragma unroll
                for (int m = 0; m < 4; ++m) {
                    bf16_t* rowp = Z + (size_t)(row0 + ai * HALF + m * 16) * ldz + c0 + 8 * fq;
#pragma unroll
                    for (int bj = 0; bj < 2; ++bj) { const f32x4 v0 = acc[ai][bj][m][0], v1 = acc[ai][bj][m][1];
                        u32x4 w; w.x = cvt_pk_bf16(v0[0], v0[1]); w.y = cvt_pk_bf16(v0[2], v0[3]); w.z = cvt_pk_bf16(v1[0], v1[1]); w.w = cvt_pk_bf16(v1[2], v1[3]);
                        *(u32x4*)(rowp + 32 * bj) = w; }
                }
        }
    }
};
struct EpiRes {
    static constexpr bool PERM = true, AFTER_DRAIN = false;
    const float* xin; const bf16_t* xin_bf; float* out; bf16_t* out_bf; const float* gate; int gstride;
    __device__ __forceinline__ void operator()(const f32x4 (&acc)[2][2][4][2], const Unit& u, int wr, int wc, int fr, int fq) const {
        const int b = (u.pm * BM) / SEQ_ROWS;
        const int col0 = u.pn * BM + wc * 32 + 8 * fq;
        const float* gb = gate + (size_t)b * gstride + col0;
        f32x4 gv[2][2];
#pragma unroll
        for (int bj = 0; bj < 2; ++bj)
#pragma unroll
            for (int n = 0; n < 2; ++n) gv[bj][n] = *(const f32x4*)(gb + bj * HALF + 4 * n);
        const int row0 = u.pm * BM + wr * 64 + fr;
#pragma unroll
        for (int ai = 0; ai < 2; ++ai) {
            u32x4 xb[4][2];
            if (xin_bf) {
#pragma unroll
                for (int m = 0; m < 4; ++m) { const size_t off = (size_t)(row0 + ai * HALF + m * 16) * 1024 + col0;
#pragma unroll
                    for (int bj = 0; bj < 2; ++bj) xb[m][bj] = *(const u32x4*)(xin_bf + off + bj * HALF); } }
#pragma unroll
            for (int m = 0; m < 4; ++m) { const size_t off = (size_t)(row0 + ai * HALF + m * 16) * 1024 + col0;
#pragma unroll
                for (int bj = 0; bj < 2; ++bj) {
                    f32x4 x0, x1;
                    if (xin_bf) { const u32x4 w = xb[m][bj];
                        x0 = (f32x4){__builtin_bit_cast(float, w.x << 16), __builtin_bit_cast(float, w.x & 0xffff0000u), __builtin_bit_cast(float, w.y << 16), __builtin_bit_cast(float, w.y & 0xffff0000u)};
                        x1 = (f32x4){__builtin_bit_cast(float, w.z << 16), __builtin_bit_cast(float, w.z & 0xffff0000u), __builtin_bit_cast(float, w.w << 16), __builtin_bit_cast(float, w.w & 0xffff0000u)}; }
                    else { x0 = *(const f32x4*)(xin + off + bj * HALF); x1 = *(const f32x4*)(xin + off + bj * HALF + 4); }
                    const f32x4 v0 = x0 + gv[bj][0] * acc[ai][bj][m][0], v1 = x1 + gv[bj][1] * acc[ai][bj][m][1];
                    if (out_bf) { u32x4 w; w.x = cvt_pk_bf16(v0[0], v0[1]); w.y = cvt_pk_bf16(v0[2], v0[3]); w.z = cvt_pk_bf16(v1[0], v1[1]); w.w = cvt_pk_bf16(v1[2], v1[3]); *(u32x4*)(out_bf + off + bj * HALF) = w; }
                    else { *(f32x4*)(out + off + bj * HALF) = v0; *(f32x4*)(out + off + bj * HALF + 4) = v1; }
                } }
            asm volatile("" ::: "memory"); }
    }
};
struct EpiSwiglu {
    static constexpr bool PERM = true, AFTER_DRAIN = false;
    bf16_t* H; int ldh;
    __device__ __forceinline__ void operator()(const f32x4 (&acc)[2][2][4][2], const Unit& u, int wr, int wc, int fr, int fq) const {
        const int row0 = u.pm * BM + wr * 64 + fr, col0 = u.pn * HALF + wc * 32 + 8 * fq;
#pragma unroll
        for (int ai = 0; ai < 2; ++ai)
#pragma unroll
            for (int m = 0; m < 4; ++m) {
                f32x4 v[2];
#pragma unroll
                for (int n = 0; n < 2; ++n) { const f32x4 a = acc[ai][0][m][n], g = acc[ai][1][m][n];
#pragma unroll
                    for (int i = 0; i < 4; ++i) v[n][i] = a[i] * fast_sigmoid(a[i]) * g[i]; }
                u32x4 w; w.x = cvt_pk_bf16(v[0][0], v[0][1]); w.y = cvt_pk_bf16(v[0][2], v[0][3]); w.z = cvt_pk_bf16(v[1][0], v[1][1]); w.w = cvt_pk_bf16(v[1][2], v[1][3]);
                *(u32x4*)(H + (size_t)(row0 + ai * HALF + m * 16) * ldh + col0) = w;
            }
    }
};
template <class Epi, class Sched, bool ALIGN_EPI = false, bool SP2 = false, int MODE = 0>
__device__ __forceinline__ void gemm_phase(PG8_LAS unsigned char* lds, const Gemm g, const Sched& S, const Epi& E, unsigned long long* stamps = nullptr) {
    int tid = threadIdx.x; asm volatile("" : "+v"(tid));
    const int wid = __builtin_amdgcn_readfirstlane(tid >> 6), lane = tid & 63, wr = wid >> 2, wc = wid & 3, fr = lane & 15, fq = lane >> 4;
    const int K = g.K, nt = K / BK;
    unsigned voffA[2], voffB[2];
#pragma unroll
    for (int i = 0; i < 2; ++i) { int R, C; stage_rc(tid * 16 + i * 8192, R, C); const int Rb = Epi::PERM ? ((R & ~31) + perm32(R & 31)) : R;
        voffA[i] = (unsigned)(R * K + C) * 2u; voffB[i] = (unsigned)(Rb * K + C) * 2u; }
    const size_t kstep = (size_t)(BK * 2);
    const size_t hstep = (size_t)HALF * K * 2;
    const size_t tstep = 2 * hstep;
    const unsigned ldsw = (unsigned)wid * 1024u;
    const int aoff = lds_byte(wr * 64 + fr, fq * 8), boff = lds_byte(wc * 32 + fr, fq * 8);
#define PG8_SA(b, h) (((b) * 2 + (h)) * HTB)
#define PG8_SB(b, h) ((4 + (b) * 2 + (h)) * HTB)
#define PG8_STAGE(bufoff, gbase, voff) do { if constexpr (MODE != 2) _Pragma("unroll") for (int _i = 0; _i < 2; ++_i) \
        __builtin_amdgcn_global_load_lds((const unsigned*)((const char*)(gbase) + (voff)[_i]), (PG8_LAS unsigned*)(lds + (bufoff) + ldsw + _i * 8192), 16, 0, 0); } while (0)
#define PG8_LDA(dst, b, h) do { _Pragma("unroll") for (int m = 0; m < 4; ++m) _Pragma("unroll") for (int k = 0; k < 2; ++k) dst[m][k] = *(const PG8_LAS bf16x8*)(lds + PG8_SA(b, h) + aoff + m * 2048 + k * 1024); } while (0)
#define PG8_LDB(dst, b, h) do { _Pragma("unroll") for (int n = 0; n < 2; ++n) _Pragma("unroll") for (int k = 0; k < 2; ++k) dst[n][k] = *(const PG8_LAS bf16x8*)(lds + PG8_SB(b, h) + boff + n * 2048 + k * 1024); } while (0)
#define PG8_MMA(ai, bj, At, Bt) do { __builtin_amdgcn_s_setprio(1); if constexpr (MODE != 1) _Pragma("unroll") for (int m = 0; m < 4; ++m) _Pragma("unroll") for (int n = 0; n < 2; ++n) _Pragma("unroll") for (int k = 0; k < 2; ++k) \
        acc[ai][bj][m][n] = __builtin_amdgcn_mfma_f32_16x16x32_bf16(Bt[n][k], At[m][k], acc[ai][bj][m][n], 0, 0, 0); __builtin_amdgcn_s_setprio(0); } while (0)
#define PG8_WAIT_V(n) asm volatile("s_waitcnt vmcnt(" #n ")" ::: "memory")
#define PG8_WAIT_L(n) asm volatile("s_waitcnt lgkmcnt(" #n ")" ::: "memory")
#define PG8_BAR __builtin_amdgcn_s_barrier()
#define PG8_SCHED __builtin_amdgcn_sched_barrier(0)
#if PROBE_SEL
#define PG8_STAMP(i) do { if (stamps && wid == 0) { unsigned long long t_; asm volatile("s_memtime %0\n\ts_waitcnt lgkmcnt(0)" : "=s"(t_) :: "memory"); if (lane == 0) __hip_atomic_store(stamps + (i), t_, __ATOMIC_RELAXED, __HIP_MEMORY_SCOPE_AGENT); } } while (0)
#else
#define PG8_STAMP(i) do { } while (0)
#endif
    Unit cur, nxt; int ui = 0;
    if (!S.next(0, cur)) return;
    f32x4 acc[2][2][4][2];
#pragma unroll
    for (int a = 0; a < 2; ++a)
#pragma unroll
        for (int b = 0; b < 2; ++b)
#pragma unroll
            for (int m = 0; m < 4; ++m)
#pragma unroll
                for (int n = 0; n < 2; ++n) acc[a][b][m][n] = (f32x4){0.f, 0.f, 0.f, 0.f};
    bf16x8 At[4][2], B0[2][2], B1[2][2];
    const char* cA = (const char*)g.A + (size_t)cur.pm * tstep; const char* cB = (const char*)g.Bt + (size_t)cur.pn * tstep;
    S.a_ready(cur);
    if constexpr (SP2) {
        PG8_STAGE(PG8_SB(0, 0), cB, voffB); PG8_STAGE(PG8_SB(0, 1), cB + hstep, voffB); PG8_STAGE(PG8_SA(0, 0), cA, voffA); PG8_STAGE(PG8_SA(0, 1), cA + hstep, voffA);
        if (wr == 1) PG8_BAR;
        PG8_WAIT_V(2); PG8_BAR;
        PG8_STAGE(PG8_SB(1, 0), cB + kstep, voffB); PG8_STAGE(PG8_SA(1, 0), cA + kstep, voffA); PG8_STAGE(PG8_SB(1, 1), cB + hstep + kstep, voffB);
        PG8_WAIT_V(6); PG8_BAR;
    } else {
        PG8_STAGE(PG8_SB(0, 0), cB, voffB); PG8_STAGE(PG8_SA(0, 0), cA, voffA); PG8_STAGE(PG8_SB(0, 1), cB + hstep, voffB); PG8_STAGE(PG8_SA(0, 1), cA + hstep, voffA);
        if (wr == 1) PG8_BAR;
        PG8_WAIT_V(4); PG8_BAR;
        PG8_STAGE(PG8_SB(1, 0), cB + kstep, voffB); PG8_STAGE(PG8_SA(1, 0), cA + kstep, voffA); PG8_STAGE(PG8_SB(1, 1), cB + hstep + kstep, voffB);
        PG8_WAIT_V(6); PG8_BAR;
    }
    for (;;) {
        const bool has_next = S.next(ui + 1, nxt);
        const char* nA = has_next ? (const char*)g.A + (size_t)nxt.pm * tstep : cA; const char* nB = has_next ? (const char*)g.Bt + (size_t)nxt.pn * tstep : cB;
        for (int t = 0; t < nt; t += 2) {
            const bool last = (t == nt - 2);
            const char* a1 = cA + (size_t)(t + 1) * kstep;
            const char* a2 = last ? nA : cA + (size_t)(t + 2) * kstep; const char* b2 = last ? nB : cB + (size_t)(t + 2) * kstep;
            const char* a3 = a2 + kstep; const char* b3 = b2 + kstep;
            if (last && has_next) S.a_ready(nxt);
            if constexpr (SP2) {
            PG8_LDB(B0, 0, 0); PG8_LDB(B1, 0, 1); PG8_SCHED; PG8_LDA(At, 0, 0); PG8_STAGE(PG8_SA(1, 1), a1 + hstep, voffA);
            PG8_WAIT_V(8); PG8_WAIT_L(0); PG8_BAR; PG8_MMA(0, 0, At, B0); PG8_MMA(0, 1, At, B1); PG8_BAR; PG8_SCHED;
            PG8_LDA(At, 0, 1); PG8_STAGE(PG8_SB(0, 0), b2, voffB); PG8_STAGE(PG8_SB(0, 1), b2 + hstep, voffB); PG8_STAGE(PG8_SA(0, 0), a2, voffA);
            PG8_WAIT_V(8); PG8_WAIT_L(0); PG8_BAR; PG8_MMA(1, 0, At, B0); PG8_MMA(1, 1, At, B1); PG8_BAR; PG8_SCHED;
            PG8_LDB(B0, 1, 0); PG8_LDB(B1, 1, 1); PG8_SCHED; PG8_LDA(At, 1, 0); PG8_STAGE(PG8_SA(0, 1), a2 + hstep, voffA);
            PG8_WAIT_V(8); PG8_WAIT_L(0); PG8_BAR; PG8_MMA(0, 0, At, B0); PG8_MMA(0, 1, At, B1); PG8_BAR; PG8_SCHED;
            PG8_LDA(At, 1, 1); PG8_STAGE(PG8_SB(1, 0), b3, voffB); PG8_STAGE(PG8_SB(1, 1), b3 + hstep, voffB); PG8_STAGE(PG8_SA(1, 0), a3, voffA);
            PG8_WAIT_V(8); PG8_WAIT_L(0); PG8_BAR; PG8_MMA(1, 0, At, B0); PG8_MMA(1, 1, At, B1); PG8_BAR; PG8_SCHED;
            } else {
            PG8_LDB(B0, 0, 0); PG8_SCHED; PG8_LDA(At, 0, 0); PG8_STAGE(PG8_SA(1, 1), a1 + hstep, voffA);
            PG8_WAIT_L(8); PG8_BAR; PG8_WAIT_L(0); PG8_MMA(0, 0, At, B0); PG8_BAR; PG8_SCHED;
            PG8_LDB(B1, 0, 1); PG8_STAGE(PG8_SB(0, 0), b2, voffB);
            PG8_BAR; PG8_WAIT_L(0); PG8_MMA(0, 1, At, B1); PG8_BAR;
            PG8_LDA(At, 0, 1); PG8_STAGE(PG8_SA(0, 0), a2, voffA);
            PG8_BAR; PG8_WAIT_L(0); PG8_MMA(1, 0, At, B0); PG8_BAR; PG8_SCHED;
            PG8_STAGE(PG8_SB(0, 1), b2 + hstep, voffB);
            PG8_WAIT_V(6); PG8_BAR; PG8_MMA(1, 1, At, B1); PG8_BAR;
            PG8_LDB(B0, 1, 0); PG8_SCHED; PG8_LDA(At, 1, 0); PG8_STAGE(PG8_SA(0, 1), a2 + hstep, voffA);
            PG8_WAIT_L(8); PG8_BAR; PG8_WAIT_L(0); PG8_MMA(0, 0, At, B0); PG8_BAR; PG8_SCHED;
            PG8_LDB(B1, 1, 1); PG8_STAGE(PG8_SB(1, 0), b3, voffB);
            PG8_BAR; PG8_WAIT_L(0); PG8_MMA(0, 1, At, B1); PG8_BAR;
            PG8_LDA(At, 1, 1); PG8_STAGE(PG8_SA(1, 0), a3, voffA);
            PG8_BAR; PG8_WAIT_L(0); PG8_MMA(1, 0, At, B0); PG8_BAR; PG8_SCHED;
            PG8_STAGE(PG8_SB(1, 1), b3 + hstep, voffB);
            PG8_WAIT_V(6); PG8_BAR; PG8_MMA(1, 1, At, B1); PG8_BAR;
            }
        }
        if constexpr (ALIGN_EPI) { if (wr == 0) PG8_BAR; }
        PG8_STAMP(1 + 2 * ui);
        if constexpr (!Epi::AFTER_DRAIN) { E(acc, cur, wr, wc, fr, fq); S.done(cur); }
        PG8_STAMP(2 + 2 * ui);
        if (!has_next) break;
#pragma unroll
        for (int a = 0; a < 2; ++a)
#pragma unroll
            for (int b = 0; b < 2; ++b)
#pragma unroll
                for (int m = 0; m < 4; ++m)
#pragma unroll
                    for (int n = 0; n < 2; ++n) acc[a][b][m][n] = (f32x4){0.f, 0.f, 0.f, 0.f};
        cur = nxt; cA = nA; cB = nB; ++ui;
        if constexpr (ALIGN_EPI) { if (wr == 1) PG8_BAR; }
    }
    PG8_WAIT_V(0);
    if constexpr (!ALIGN_EPI) { if (wr == 0) PG8_BAR; }
    PG8_BAR;
    if constexpr (Epi::AFTER_DRAIN) { E.fused(acc, cur, wr, wc, fr, fq, lds, wid, lane); S.done(cur); }
#undef PG8_SA
#undef PG8_SB
#undef PG8_STAGE
#undef PG8_LDA
#undef PG8_LDB
#undef PG8_MMA
#undef PG8_WAIT_V
#undef PG8_WAIT_L
#undef PG8_BAR
#undef PG8_SCHED
}
}
#include <type_traits>
constexpr int NWAVES = 8, NTHREADS = NWAVES * 64;
constexpr int D = 1024, BATCH = 8, SEQ = 4096, DEPTH = 4, M = BATCH * SEQ;
constexpr int FFH = 2816, NUP = 2 * FFH;
constexpr int AB_LD = 3592, AB_N = 3584;
constexpr int FX_LD = 3088, FX_N = 3072;
constexpr int MODW = 6 * D;
constexpr float EPS = 1e-6f, LOG2E = 1.4426950408889634f;
static_assert(pg8::SEQ_ROWS == SEQ, "row -> batch");

constexpr size_t MiB = 1u << 20;
constexpr size_t WS_CTL = 0, CTL_ZERO_BYTES = 1 * MiB;
constexpr size_t WS_MOD = 1 * MiB;
constexpr size_t WS_GATE = 2 * MiB;
constexpr size_t WS_WIN_E = 4 * MiB;
constexpr size_t WS_WIN_O = 18 * MiB;
constexpr size_t WS_WOUT = 30 * MiB;
constexpr size_t WS_WUP = 38 * MiB;
constexpr size_t WS_WDN = 82 * MiB;
constexpr size_t WS_A1 = 104 * MiB;
constexpr size_t WS_Z = 168 * MiB;
constexpr size_t WS_XB2 = 344 * MiB;
constexpr size_t WS_QKC = 392 * MiB;
constexpr size_t WS_END = 456 * MiB;
constexpr int CW_BAR = 4096;
constexpr int CW_QUEUE = 16384;

constexpr int RING_OFF = 0, RING_BYTES = 131072;
constexpr int LDSCTL_OFF = RING_BYTES, MISC_OFF = LDSCTL_OFF + 320;
constexpr int LDS_BYTES = 147456;

#define GAS __attribute__((address_space(1)))
#define LAS __attribute__((address_space(3)))
typedef unsigned short bf16;
typedef unsigned v4u __attribute__((ext_vector_type(4)));
typedef float f32x4 __attribute__((ext_vector_type(4)));
typedef short bf16x8 __attribute__((ext_vector_type(8)));
typedef GAS unsigned gu32;
typedef GAS unsigned long long gu64;
#define RLX_AGENT __ATOMIC_RELAXED, __HIP_MEMORY_SCOPE_AGENT
#define LDS_WAIT() asm volatile("s_waitcnt lgkmcnt(0)" ::: "memory")
#define VM_WAIT() asm volatile("s_waitcnt vmcnt(0)" ::: "memory")
__device__ __forceinline__ unsigned long long rt() { return __builtin_amdgcn_s_memrealtime(); }
__device__ __forceinline__ unsigned f2bf(float f) { unsigned u = __builtin_bit_cast(unsigned, f); return (u + 0x7fffu + ((u >> 16) & 1u)) >> 16; }
__device__ __forceinline__ unsigned pk2(float lo, float hi) { return f2bf(lo) | (f2bf(hi) << 16); }

#define XB_TMO      128
#define XB_XCNT(j)  (256  + 64 * (j))
#define XB_XSUB(j)  (1280 + 64 * (j))
#define XB_XGEN(j)  (2304 + 64 * (j))
#define XB_TOP      3328
#define XB_TOPGEN   3392
#define XCD_BAR_WORDS 3456
#define XB_SPIN_CAP (1u << 24)

__device__ __forceinline__ unsigned xb_ld(unsigned* p)              { return __hip_atomic_load(p, __ATOMIC_RELAXED, __HIP_MEMORY_SCOPE_AGENT); }
__device__ __forceinline__ unsigned xb_add(unsigned* p, unsigned v) { return __hip_atomic_fetch_add(p, v, __ATOMIC_RELAXED, __HIP_MEMORY_SCOPE_AGENT); }
__device__ __forceinline__ unsigned xb_xcc_id() { return (unsigned)__builtin_amdgcn_s_getreg((3 << 11) | 20) & 0xFu; }
#define XB_SPIN(cond, bar) do { unsigned _sp = 0; while (cond) { __builtin_amdgcn_s_sleep(1); \
    if ((++_sp & 255u) == 0u) { if (xb_ld(&(bar)[XB_TMO])) break; if (_sp > XB_SPIN_CAP) { atomicAdd(&(bar)[XB_TMO], 1u); break; } } } } while (0)

struct XcdBarrier {
    unsigned* bar; unsigned x;
    volatile LAS unsigned* st;
};

__device__ __forceinline__ XcdBarrier xcd_barrier_post(unsigned* bar, volatile LAS unsigned* st) {
    XcdBarrier b; b.bar = bar; b.x = xb_xcc_id(); b.st = st;
    if (threadIdx.x == 0) st[3] = xb_add(&bar[XB_XCNT(b.x)], 1u);
    return b;
}
__device__ __forceinline__ void xcd_barrier_complete(unsigned* bar, unsigned x, unsigned& nloc, unsigned& nx) {
    const unsigned G = gridDim.x * gridDim.y * gridDim.z;
    unsigned sum, cnt, mine, sp = 0u;
    for (;;) {
        sum = 0u; cnt = 0u; mine = 0u;
#pragma unroll
        for (unsigned j = 0; j < 16; ++j) { const unsigned c = xb_ld(&bar[XB_XCNT(j)]); sum += c; cnt += (c > 0u) ? 1u : 0u; mine = (j == x) ? c : mine; }
        if (sum == G) break;
        __builtin_amdgcn_s_sleep(1);
        if ((++sp & 255u) == 0u) { if (xb_ld(&bar[XB_TMO])) break; if (sp > XB_SPIN_CAP) { atomicAdd(&bar[XB_TMO], 1u); break; } }
    }
    nloc = mine > 0u ? mine : 1u; nx = cnt > 0u ? cnt : 1u;
}

__device__ __forceinline__ void xcd_barrier(const XcdBarrier& b) {
    asm volatile("s_waitcnt vmcnt(0)" ::: "memory");
    __syncthreads();
    if (threadIdx.x == 0) {
        unsigned* bar = b.bar;
        __builtin_amdgcn_s_waitcnt(0);
        unsigned nloc = b.st[0], nx = b.st[1];
        if (nloc == 0u) { xcd_barrier_complete(bar, b.x, nloc, nx); b.st[0] = nloc; b.st[1] = nx; }
        const unsigned old = xb_add(&bar[XB_XSUB(b.x)], 1u);
        const unsigned gen = old / nloc;
        if (old + 1u == (gen + 1u) * nloc) {
            __builtin_amdgcn_fence(__ATOMIC_RELEASE, "agent");
            asm volatile("s_waitcnt vmcnt(0)" ::: "memory");
            const unsigned og = xb_add(&bar[XB_TOP], 1u);
            const unsigned tg = og / nx;
            if (og + 1u == (tg + 1u) * nx) xb_add(&bar[XB_TOPGEN], 1u);
            else XB_SPIN(xb_ld(&bar[XB_TOPGEN]) == tg, bar);
            __builtin_amdgcn_fence(__ATOMIC_ACQUIRE, "agent");
            xb_add(&bar[XB_XGEN(b.x)], 1u);
            asm volatile("s_waitcnt vmcnt(0)" ::: "memory");
        } else {
            XB_SPIN(xb_ld(&bar[XB_XGEN(b.x)]) == gen, bar);
            __builtin_amdgcn_fence(__ATOMIC_ACQUIRE, "agent");
            asm volatile("s_waitcnt vmcnt(0)" ::: "memory");
        }
    }
    __syncthreads();
}

__device__ __forceinline__ float bf_lo(unsigned u) { return __builtin_bit_cast(float, u << 16); }
__device__ __forceinline__ float bf_hi(unsigned u) { return __builtin_bit_cast(float, u & 0xffff0000u); }
__device__ __forceinline__ float bf1(bf16 u) { return __builtin_bit_cast(float, (unsigned)u << 16); }
__device__ __forceinline__ float ex2(float x) { return __builtin_amdgcn_exp2f(x); }
__device__ __forceinline__ float wave_sum(float v) {
#pragma unroll
    for (int o = 1; o < 64; o <<= 1) v += __shfl_xor(v, o);
    return v;
}
__device__ __forceinline__ float fast_sig(float x) { return __builtin_amdgcn_rcpf(1.0f + __builtin_amdgcn_exp2f(-1.4426950408889634f * x)); }
__device__ __forceinline__ float log_sigmoid(float x) { return fminf(x, 0.f) - log1pf(__expf(-fabsf(x))); }

struct Args { const float* in[24]; float* out; unsigned char* ws; int ph_lo, ph_hi; };

typedef short s16x4 __attribute__((ext_vector_type(4)));
__device__ __forceinline__ s16x4 ds_tr16(unsigned addr) { return __builtin_bit_cast(s16x4, __builtin_amdgcn_ds_read_tr16_b64_v4i16((LAS s16x4*)(uintptr_t)addr)); }
typedef float f32x2_t __attribute__((ext_vector_type(2))); typedef __bf16 bf16x2_t __attribute__((ext_vector_type(2)));
__device__ __forceinline__ unsigned cvtpk(float lo, float hi) { const f32x2_t v = {lo, hi}; return __builtin_bit_cast(unsigned, __builtin_convertvector(v, bf16x2_t)); }

constexpr int CV_TS = 528;
__device__ __forceinline__ int cv_dst_row(int map, int n) {
    if (map == 1) { const int q = (n >> 5) & 7; return (n & ~255) + ((q & 1) * 4 + (q >> 1)) * 32 + (n & 31); }
    if (map >= 2) return (n >> 7) * 256 + (map - 2) * 128 + (n & 127);
    return n; }
struct CvTile { const float* W; bf16* WT; int ld, Kd, k0, n0, map; };
__device__ __forceinline__ CvTile cv_decode(const Args& a, unsigned char* ws, int t) {
    constexpr int T_E = 16 * (AB_N / 256), T_O = 16 * (FX_N / 256), T_OUT = 16 * 4, T_UP = 16 * (FFH / 256), T_DN = (FFH / 64) * 4;
    CvTile c;
    if (t < 2 * T_E) { const int j = t / T_E, r = t % T_E, nb = AB_N / 256; c = {a.in[6] + (size_t)j * D * AB_LD, (bf16*)(ws + WS_WIN_E) + (size_t)j * AB_N * D, AB_LD, D, 64 * (r / nb), 256 * (r % nb), 1}; return c; }
    t -= 2 * T_E;
    if (t < 2 * T_O) { const int j = t / T_O, r = t % T_O, nb = FX_N / 256; c = {a.in[16] + (size_t)j * D * FX_LD, (bf16*)(ws + WS_WIN_O) + (size_t)j * FX_N * D, FX_LD, D, 64 * (r / nb), 256 * (r % nb), 1}; return c; }
    t -= 2 * T_O;
    if (t < 4 * T_OUT) { const int l = t / T_OUT, r = t % T_OUT; c = {((l & 1) ? a.in[20] : a.in[15]) + (size_t)(l >> 1) * D * D, (bf16*)(ws + WS_WOUT) + (size_t)l * D * D, D, D, 64 * (r / 4), 256 * (r % 4), 0}; return c; }
    t -= 4 * T_OUT;
    if (t < 8 * T_UP) { const int lw = t / T_UP, r = t % T_UP, l = lw >> 1, w3 = lw & 1, nb = FFH / 256; c = {(w3 ? a.in[22] : a.in[21]) + (size_t)l * D * FFH, (bf16*)(ws + WS_WUP) + (size_t)l * NUP * D, FFH, D, 64 * (r / nb), 256 * (r % nb), 2 + w3}; return c; }
    t -= 8 * T_UP;
    { const int l = t / T_DN, r = t % T_DN; c = {a.in[23] + (size_t)l * FFH * D, (bf16*)(ws + WS_WDN) + (size_t)l * D * FFH, D, FFH, 64 * (r / 4), 256 * (r % 4), 0}; return c; }
}
constexpr int CV_TILES = 2 * 16 * (AB_N / 256) + 2 * 16 * (FX_N / 256) + 4 * 64 + 8 * 16 * (FFH / 256) + 4 * (FFH / 64) * 4;

__device__ __forceinline__ void phase_prologue(const Args& a, LAS unsigned char* lds, int tid, int lane, int wave, int G) {
    unsigned char* ws = a.ws;
    {
        const unsigned lds0 = (unsigned)(uintptr_t)lds;
        const int lr = tid >> 6, lc = tid & 63;
        const int c15 = lane & 15, kq = lane >> 4;
        f32x4 v[8];
        int t = blockIdx.x;
        CvTile cur = cv_decode(a, ws, t < CV_TILES ? t : 0);
        if (t < CV_TILES) {
#pragma unroll
            for (int i = 0; i < 8; ++i) v[i] = *(const f32x4*)(cur.W + (size_t)(cur.k0 + lr + 8 * i) * cur.ld + cur.n0 + 4 * lc); }
        for (; t < CV_TILES; t += G) {
#pragma unroll
            for (int i = 0; i < 8; ++i) *(LAS unsigned long long*)(uintptr_t)(lds0 + (lr + 8 * i) * CV_TS + 8 * lc) = (unsigned long long)cvtpk(v[i].x, v[i].y) | ((unsigned long long)cvtpk(v[i].z, v[i].w) << 32);
            const CvTile nxt = cv_decode(a, ws, t + G < CV_TILES ? t + G : 0);
            if (t + G < CV_TILES) {
#pragma unroll
                for (int i = 0; i < 8; ++i) v[i] = *(const f32x4*)(nxt.W + (size_t)(nxt.k0 + lr + 8 * i) * nxt.ld + nxt.n0 + 4 * lc); }
            __syncthreads();
#pragma unroll
            for (int j = 0; j < 2; ++j) { const int nb = 2 * wave + j, n = cur.n0 + 16 * nb + c15;
                bf16* drow = cur.WT + (size_t)cv_dst_row(cur.map, n) * cur.Kd + cur.k0 + 8 * kq;
#pragma unroll
                for (int ks = 0; ks < 2; ++ks) { const unsigned ad = lds0 + (32 * ks + 8 * kq + ((lane & 15) >> 2)) * CV_TS + (16 * nb + 4 * (lane & 3)) * 2;
                    const s16x4 lo = ds_tr16(ad), hh = ds_tr16(ad + 4 * CV_TS);
                    v4u w; w.x = (unsigned)(unsigned short)lo[0] | ((unsigned)(unsigned short)lo[1] << 16); w.y = (unsigned)(unsigned short)lo[2] | ((unsigned)(unsigned short)lo[3] << 16);
                    w.z = (unsigned)(unsigned short)hh[0] | ((unsigned)(unsigned short)hh[1] << 16); w.w = (unsigned)(unsigned short)hh[2] | ((unsigned)(unsigned short)hh[3] << 16);
                    *(GAS v4u*)(drow + 32 * ks) = w; } }
            __syncthreads();
            cur = nxt;
        }
    }
    __syncthreads();
    {
        LAS float* cact = (LAS float*)lds;
        LAS float* red = (LAS float*)(lds + 32768);
        const float* c = a.in[1];
        for (int i = tid; i < BATCH * D; i += NTHREADS) { const float v = c[i]; cact[i] = v / (1.0f + __expf(-v)); }
        __syncthreads();
        float* mod = (float*)(ws + WS_MOD);
        for (int it = blockIdx.x; it < DEPTH * (MODW / 64); it += G) {
            const int l = it / (MODW / 64), cg = it % (MODW / 64);
            const float* wp = a.in[2] + ((size_t)l * D + 128 * wave) * MODW + 64 * cg + lane;
            float acc[BATCH];
#pragma unroll
            for (int b = 0; b < BATCH; ++b) acc[b] = 0.f;
#pragma unroll 8
            for (int kk = 0; kk < 128; ++kk) { const float wv = wp[(size_t)kk * MODW];
#pragma unroll
                for (int b = 0; b < BATCH; ++b) acc[b] += cact[b * D + 128 * wave + kk] * wv; }
#pragma unroll
            for (int b = 0; b < BATCH; ++b) red[(wave * BATCH + b) * 64 + lane] = acc[b];
            __syncthreads();
            { const int b = tid >> 6; float s = 0.f;
#pragma unroll
                for (int w = 0; w < NWAVES; ++w) s += red[(w * BATCH + b) * 64 + lane];
                mod[((size_t)l * BATCH + b) * MODW + 64 * cg + lane] = s + a.in[3][(size_t)l * MODW + 64 * cg + lane]; }
            __syncthreads();
        }
    }
}

template <int NG, bool XBF>
__device__ __forceinline__ void phase_norm(const void* xin_v, const float* gain, const float* shift, const float* scale  , bf16* hout,
                                           const float* Wg, int ldw, int gcol0, const float* bias_a, const float* bias_b, float* gate_out,
                                           LAS unsigned char* lds, int tid, int lane, int wave, int G) {
    LAS float* wgt = (LAS float*)lds;
    if constexpr (NG > 0) {
        for (int i = tid; i < NG * D; i += NTHREADS) { const int k = i / NG, g = i % NG; wgt[g * D + k] = Wg[(size_t)k * ldw + gcol0 + g]; }
        __syncthreads();
    }
    const int gw = blockIdx.x * NWAVES + wave, NGW = G * NWAVES;
    for (int item = gw; item < M / 16; item += NGW) {
        const int row0 = item * 16, b = row0 / SEQ;
        f32x4 A[4], S[4];
#pragma unroll
        for (int j = 0; j < 4; ++j) { const int c = 4 * lane + 256 * j;
            const f32x4 g4 = *(const f32x4*)(gain + c), sc4 = *(const f32x4*)(scale + (size_t)b * MODW + c);
            A[j] = g4 * (sc4 + 1.0f); S[j] = *(const f32x4*)(shift + (size_t)b * MODW + c); }
        for (int r = 0; r < 16; ++r) {
            asm volatile("" ::: "memory");
            const int row = row0 + r;
            f32x4 v[4]; float ss = 0.f;
            if constexpr (XBF) { const GAS unsigned long long* xr = (const GAS unsigned long long*)((const bf16*)xin_v + (size_t)row * D) + lane;
#pragma unroll
                for (int j = 0; j < 4; ++j) { const unsigned long long w = xr[64 * j]; const unsigned lo = (unsigned)w, hh = (unsigned)(w >> 32); v[j] = (f32x4){bf_lo(lo), bf_hi(lo), bf_lo(hh), bf_hi(hh)}; } }
            else { const GAS f32x4* xr = (const GAS f32x4*)((const float*)xin_v + (size_t)row * D) + lane;
#pragma unroll
                for (int j = 0; j < 4; ++j) v[j] = xr[64 * j]; }
#pragma unroll
            for (int j = 0; j < 4; ++j) ss += (v[j].x * v[j].x + v[j].y * v[j].y) + (v[j].z * v[j].z + v[j].w * v[j].w);
            const float rinv = 1.0f / sqrtf(wave_sum(ss) * (1.0f / D) + EPS);
#pragma unroll
            for (int j = 0; j < 4; ++j) v[j] = v[j] * rinv * A[j] + S[j];
            GAS unsigned long long* o8 = (GAS unsigned long long*)(hout + (size_t)row * D) + lane;
#pragma unroll
            for (int j = 0; j < 4; ++j) o8[64 * j] = (unsigned long long)pk2(v[j].x, v[j].y) | ((unsigned long long)pk2(v[j].z, v[j].w) << 32);
            if constexpr (NG > 0) {
                float p[NG];
#pragma unroll
                for (int g = 0; g < NG; ++g) { float s = 0.f;
#pragma unroll
                    for (int j = 0; j < 4; ++j) { const f32x4 w4 = *(const LAS f32x4*)(wgt + g * D + 4 * lane + 256 * j); s += (v[j].x * w4.x + v[j].y * w4.y) + (v[j].z * w4.z + v[j].w * w4.w); }
                    p[g] = s; }
#define HALVE(NV, OFF) do { const bool up = (lane & (OFF)) != 0; _Pragma("unroll") for (int i = 0; i < (NV); ++i) { const float keep = up ? p[i + (NV)] : p[i], send = up ? p[i] : p[i + (NV)]; p[i] = keep + __shfl_xor(send, (OFF)); } } while (0)
                if constexpr (NG == 16) { HALVE(8, 32); HALVE(4, 16); HALVE(2, 8); HALVE(1, 4); } else { HALVE(4, 32); HALVE(2, 16); HALVE(1, 8); }
#undef HALVE
                float val = p[0];
                constexpr int REM = (NG == 16) ? 2 : 4;
#pragma unroll
                for (int off = REM; off >= 1; off >>= 1) val += __shfl_xor(val, off);
                const int t = row % SEQ;
                if constexpr (NG == 16) { if ((lane & 3) == 0) { const int g = lane >> 2; gate_out[((size_t)b * 16 + g) * SEQ + t] = log_sigmoid(val + bias_b[g]); } }
                else { if ((lane & 7) == 0) { const int g = lane >> 3;
                        if (g < 4) gate_out[((size_t)b * 4 + g) * SEQ + t] = val + bias_a[g];
                        else gate_out[(size_t)BATCH * 4 * SEQ + ((size_t)b * 4 + (g - 4)) * SEQ + t] = log_sigmoid(val + bias_b[g - 4]); } }
            }
        }
    }
}

__device__ __forceinline__ int queue_next(gu32* head, volatile LAS unsigned* MISC, int tid) {
    __syncthreads();
    if (tid == 0) MISC[0] = __hip_atomic_fetch_add(head, 1u, RLX_AGENT);
    __syncthreads();
    return (int)MISC[0];
}

__device__ __forceinline__ void fox_naive_unit(int b, int h, int qb, const bf16* z, const float* lf, bf16* y, LAS unsigned char* lds, int tid, int lane, int wave) {
    LAS float* F = (LAS float*)lds;
    if (wave == 0) { const int seg = 8 * (qb + 1); const float* p = lf + ((size_t)b * 16 + h) * SEQ + lane * seg; float s = 0.f;
        for (int i = 0; i < seg; ++i) s += p[i];
        float inc = s;
#pragma unroll
        for (int off = 1; off < 64; off <<= 1) { const float t = __shfl_up(inc, off); if (lane >= off) inc += t; }
        float run = inc - s;
        for (int i = 0; i < seg; ++i) { run += p[i]; F[lane * seg + i] = run * LOG2E; } }
    __syncthreads();
    const int t = qb * 512 + tid; const size_t rowbase = (size_t)b * SEQ;
    float q[64];
    { const v4u* qp = (const v4u*)(z + (rowbase + t) * FX_N + h * 64);
#pragma unroll
        for (int c = 0; c < 8; ++c) { const v4u u = qp[c]; q[8 * c] = bf_lo(u.x); q[8 * c + 1] = bf_hi(u.x); q[8 * c + 2] = bf_lo(u.y); q[8 * c + 3] = bf_hi(u.y); q[8 * c + 4] = bf_lo(u.z); q[8 * c + 5] = bf_hi(u.z); q[8 * c + 6] = bf_lo(u.w); q[8 * c + 7] = bf_hi(u.w); } }
    float o[64];
#pragma unroll
    for (int d = 0; d < 64; ++d) o[d] = 0.f;
    float m = -INFINITY, l = 0.f; const float Ft = F[t];
    const int smax = qb * 512 + wave * 64 + 63;
    for (int s = 0; s <= smax; ++s) {
        const v4u* kp = (const v4u*)(z + (rowbase + s) * FX_N + 1024 + h * 64);
        float dot = 0.f;
#pragma unroll
        for (int c = 0; c < 8; ++c) { const v4u u = kp[c];
            dot += q[8 * c] * bf_lo(u.x) + q[8 * c + 1] * bf_hi(u.x) + q[8 * c + 2] * bf_lo(u.y) + q[8 * c + 3] * bf_hi(u.y) + q[8 * c + 4] * bf_lo(u.z) + q[8 * c + 5] * bf_hi(u.z) + q[8 * c + 6] * bf_lo(u.w) + q[8 * c + 7] * bf_hi(u.w); }
        float lg = dot + (Ft - F[s]);
        lg = (s <= t) ? lg : -INFINITY;
        const float mn = fmaxf(m, lg), alpha = ex2(m - mn), p = ex2(lg - mn);
        l = l * alpha + p; m = mn;
        const v4u* vp = (const v4u*)(z + (rowbase + s) * FX_N + 2048 + h * 64);
#pragma unroll
        for (int c = 0; c < 8; ++c) { const v4u u = vp[c];
            o[8 * c] = o[8 * c] * alpha + p * bf_lo(u.x); o[8 * c + 1] = o[8 * c + 1] * alpha + p * bf_hi(u.x); o[8 * c + 2] = o[8 * c + 2] * alpha + p * bf_lo(u.y); o[8 * c + 3] = o[8 * c + 3] * alpha + p * bf_hi(u.y);
            o[8 * c + 4] = o[8 * c + 4] * alpha + p * bf_lo(u.z); o[8 * c + 5] = o[8 * c + 5] * alpha + p * bf_hi(u.z); o[8 * c + 6] = o[8 * c + 6] * alpha + p * bf_lo(u.w); o[8 * c + 7] = o[8 * c + 7] * alpha + p * bf_hi(u.w); }
    }
    const float il = 1.0f / l;
    v4u* yp = (v4u*)(y + (rowbase + t) * D + h * 64);
#pragma unroll
    for (int c = 0; c < 8; ++c) { v4u w; w.x = pk2(o[8 * c] * il, o[8 * c + 1] * il); w.y = pk2(o[8 * c + 2] * il, o[8 * c + 3] * il); w.z = pk2(o[8 * c + 4] * il, o[8 * c + 5] * il); w.w = pk2(o[8 * c + 6] * il, o[8 * c + 7] * il); yp[c] = w; }
}

__device__ __forceinline__ void da_naive_unit(int b, int h, int qb, const bf16* z, bf16* y, const float* lam_p, const float* subln_g, int layer, int lane, int wave) {
    const int r = lane & 15, mm = (lane >> 4) & 1, vh = lane >> 5;
    const int t = qb * 128 + wave * 16 + r; const size_t rowbase = (size_t)b * SEQ;
    const float lambda_init = 0.8f - 0.6f * expf(-0.3f * (float)layer);
    float lam;
    { float s0 = 0.f, s1 = 0.f; for (int d = 0; d < 64; ++d) { s0 += lam_p[d] * lam_p[64 + d]; s1 += lam_p[128 + d] * lam_p[192 + d]; } lam = expf(s0) - expf(s1) + lambda_init; }
    const float slope2 = exp2f(-2.0f * (float)(h + 1)) * LOG2E;
    float q[64];
    { const v4u* qp = (const v4u*)(z + (rowbase + t) * AB_N + h * 128 + mm * 64);
#pragma unroll
        for (int c = 0; c < 8; ++c) { const v4u u = qp[c]; q[8 * c] = bf_lo(u.x); q[8 * c + 1] = bf_hi(u.x); q[8 * c + 2] = bf_lo(u.y); q[8 * c + 3] = bf_hi(u.y); q[8 * c + 4] = bf_lo(u.z); q[8 * c + 5] = bf_hi(u.z); q[8 * c + 6] = bf_lo(u.w); q[8 * c + 7] = bf_hi(u.w); } }
    float o[64];
#pragma unroll
    for (int d = 0; d < 64; ++d) o[d] = 0.f;
    float m = -INFINITY, l = 0.f;
    const int smax = (qb * 128 + wave * 16) / 64 * 64 + 63;
    for (int s = 0; s <= smax; ++s) {
        const v4u* kp = (const v4u*)(z + (rowbase + s) * AB_N + 512 + h * 128 + mm * 64);
        float dot = 0.f;
#pragma unroll
        for (int c = 0; c < 8; ++c) { const v4u u = kp[c];
            dot += q[8 * c] * bf_lo(u.x) + q[8 * c + 1] * bf_hi(u.x) + q[8 * c + 2] * bf_lo(u.y) + q[8 * c + 3] * bf_hi(u.y) + q[8 * c + 4] * bf_lo(u.z) + q[8 * c + 5] * bf_hi(u.z) + q[8 * c + 6] * bf_lo(u.w) + q[8 * c + 7] * bf_hi(u.w); }
        const float lg = dot - slope2 * fabsf((float)(t - s));
        const float mn = fmaxf(m, lg), alpha = ex2(m - mn), p = ex2(lg - mn);
        l = l * alpha + p; m = mn;
        const v4u* vp = (const v4u*)(z + (rowbase + s) * AB_N + 1024 + h * 128 + vh * 64);
#pragma unroll
        for (int c = 0; c < 8; ++c) { const v4u u = vp[c];
            o[8 * c] = o[8 * c] * alpha + p * bf_lo(u.x); o[8 * c + 1] = o[8 * c + 1] * alpha + p * bf_hi(u.x); o[8 * c + 2] = o[8 * c + 2] * alpha + p * bf_lo(u.y); o[8 * c + 3] = o[8 * c + 3] * alpha + p * bf_hi(u.y);
            o[8 * c + 4] = o[8 * c + 4] * alpha + p * bf_lo(u.z); o[8 * c + 5] = o[8 * c + 5] * alpha + p * bf_hi(u.z); o[8 * c + 6] = o[8 * c + 6] * alpha + p * bf_lo(u.w); o[8 * c + 7] = o[8 * c + 7] * alpha + p * bf_hi(u.w); }
    }
    const float il = 1.0f / l; float ss = 0.f;
#pragma unroll
    for (int d = 0; d < 64; ++d) { const float mine = o[d] * il, other = __shfl_xor(mine, 16); o[d] = mine - lam * other; ss += o[d] * o[d]; }
    ss += __shfl_xor(ss, 32);
    const float rn = (1.0f - lambda_init) / sqrtf(ss * (1.0f / 128.0f) + EPS);
    if (mm == 0) {
        v4u* yp = (v4u*)(y + (rowbase + t) * D + h * 128 + vh * 64);
#pragma unroll
        for (int c = 0; c < 8; ++c) { float e[8];
#pragma unroll
            for (int i = 0; i < 8; ++i) e[i] = o[8 * c + i] * rn * subln_g[vh * 64 + 8 * c + i];
            v4u w; w.x = pk2(e[0], e[1]); w.y = pk2(e[2], e[3]); w.z = pk2(e[4], e[5]); w.w = pk2(e[6], e[7]); yp[c] = w; }
    }
}

__device__ __forceinline__ void mlstm_naive_unit(int b, int h, const bf16* z, const float* gates, const float* conv_w, const float* conv_b, bf16* y, LAS unsigned char* lds, int tid) {
    LAS float* qs = (LAS float*)lds;
    LAS float* ks = (LAS float*)(lds + 32768);
    LAS float* pn = (LAS float*)(lds + 65536);
    LAS float* pd = (LAS float*)(lds + 65536 + 4096);
    const int dv = tid & 127, eq = tid >> 7; const size_t rowbase = (size_t)b * SEQ;
    const float* gi = gates + ((size_t)b * 4 + h) * SEQ; const float* glf = gates + (size_t)BATCH * 4 * SEQ + ((size_t)b * 4 + h) * SEQ;
    float C[32], n[32];
#pragma unroll
    for (int i = 0; i < 32; ++i) { C[i] = 0.f; n[i] = 0.f; }
    float m = 0.f;
    for (int c = 0; c < SEQ / 64; ++c) {
        for (int it = tid; it < 2048; it += NTHREADS) {
            const int isk = it >> 10, r = (it >> 4) & 63, g = it & 15; const int t = 64 * c + r;
            const int ch = isk * 512 + h * 128 + 8 * g;
            float acc[8];
#pragma unroll
            for (int i = 0; i < 8; ++i) acc[i] = conv_b[ch + i];
#pragma unroll
            for (int j = 0; j < 4; ++j) { const int tt = t - 3 + j;
                if (tt >= 0) { const v4u u = *(const v4u*)(z + (rowbase + tt) * AB_N + 1536 + ch); const float* w = conv_w + j * 1024 + ch;
                    acc[0] += bf_lo(u.x) * w[0]; acc[1] += bf_hi(u.x) * w[1]; acc[2] += bf_lo(u.y) * w[2]; acc[3] += bf_hi(u.y) * w[3];
                    acc[4] += bf_lo(u.z) * w[4]; acc[5] += bf_hi(u.z) * w[5]; acc[6] += bf_lo(u.w) * w[6]; acc[7] += bf_hi(u.w) * w[7]; } }
            LAS float* dst = (isk ? ks : qs) + r * 128 + 8 * g; const float scl = isk ? 0.08838834764831845f : 1.0f;
#pragma unroll
            for (int i = 0; i < 8; ++i) dst[i] = acc[i] / (1.0f + __expf(-acc[i])) * scl;
        }
        __syncthreads();
        for (int r = 0; r < 64; ++r) {
            const int t = 64 * c + r;
            const float lf = glf[t], ig = gi[t];
            const float mn = fmaxf(lf + m, ig), fd = __expf(lf + m - mn), ii = __expf(ig - mn); m = mn;
            const float vv = bf1(z[(rowbase + t) * AB_N + 2560 + h * 128 + dv]) * ii;
            float pnum = 0.f, pden = 0.f;
#pragma unroll
            for (int i = 0; i < 32; ++i) { const float kk = ks[r * 128 + 32 * eq + i], qq = qs[r * 128 + 32 * eq + i];
                C[i] = fd * C[i] + vv * kk; n[i] = fd * n[i] + ii * kk; pnum += C[i] * qq; pden += n[i] * qq; }
            pn[((r & 1) * 4 + eq) * 128 + dv] = pnum; if (dv == 0) pd[(r & 1) * 4 + eq] = pden;
            __syncthreads();
            if (eq == 0) {
                const float num = (pn[((r & 1) * 4 + 0) * 128 + dv] + pn[((r & 1) * 4 + 1) * 128 + dv]) + (pn[((r & 1) * 4 + 2) * 128 + dv] + pn[((r & 1) * 4 + 3) * 128 + dv]);
                const float den = (pd[(r & 1) * 4 + 0] + pd[(r & 1) * 4 + 1]) + (pd[(r & 1) * 4 + 2] + pd[(r & 1) * 4 + 3]);
                const float hh = num / fmaxf(fabsf(den), __expf(-m));
                const float og = bf1(z[(rowbase + t) * AB_N + 3072 + h * 128 + dv]);
                y[(rowbase + t) * D + 512 + h * 128 + dv] = (bf16)f2bf(hh / (1.0f + __expf(-og)));
            }
        }
        __syncthreads();
    }
}

typedef float f32x16 __attribute__((ext_vector_type(16)));
__device__ __forceinline__ int crow(int r, int hi) { return (r & 3) + 8 * (r >> 2) + 4 * hi; }
#define MFMA32(a, b, c) __builtin_amdgcn_mfma_f32_32x32x16_bf16((a), (b), (c), 0, 0, 0)
#define SCHED_FENCE() __builtin_amdgcn_sched_barrier(0)
template <int CTRL, int ROWMASK> __device__ __forceinline__ float dpp_f(float oldv, float x) {
    return __builtin_bit_cast(float, __builtin_amdgcn_update_dpp(__builtin_bit_cast(int, oldv), __builtin_bit_cast(int, x), CTRL, ROWMASK, 0xf, false)); }
__device__ __forceinline__ float scan_add(float v, int) {
    v += dpp_f<0x111, 0xf>(0.f, v); v += dpp_f<0x112, 0xf>(0.f, v); v += dpp_f<0x114, 0xf>(0.f, v); v += dpp_f<0x118, 0xf>(0.f, v);
    v += dpp_f<0x142, 0xa>(0.f, v); v += dpp_f<0x143, 0xc>(0.f, v); return v; }
__device__ __forceinline__ float scan_max(float v, int) {
    const float ninf = -INFINITY;
    v = fmaxf(v, dpp_f<0x111, 0xf>(ninf, v)); v = fmaxf(v, dpp_f<0x112, 0xf>(ninf, v)); v = fmaxf(v, dpp_f<0x114, 0xf>(ninf, v)); v = fmaxf(v, dpp_f<0x118, 0xf>(ninf, v));
    v = fmaxf(v, dpp_f<0x142, 0xa>(ninf, v)); v = fmaxf(v, dpp_f<0x143, 0xc>(ninf, v)); return v; }
__device__ __forceinline__ void swap32(unsigned& a, unsigned& b) { asm volatile("s_nop 1\n\tv_permlane32_swap_b32 %0, %1\n\ts_nop 1" : "+v"(a), "+v"(b)); }
__device__ __forceinline__ void swap16(unsigned& a, unsigned& b) { asm volatile("s_nop 1\n\tv_permlane16_swap_b32 %0, %1\n\ts_nop 1" : "+v"(a), "+v"(b)); }
__device__ __forceinline__ float xsum32(float v) { unsigned a = __builtin_bit_cast(unsigned, v), b = a; swap32(a, b); return __builtin_bit_cast(float, a) + __builtin_bit_cast(float, b); }
__device__ __forceinline__ float xsum16(float v) { unsigned a = __builtin_bit_cast(unsigned, v), b = a; swap16(a, b); return __builtin_bit_cast(float, a) + __builtin_bit_cast(float, b); }
__device__ __forceinline__ float xmax32(float v) { unsigned a = __builtin_bit_cast(unsigned, v), b = a; swap32(a, b); return fmaxf(__builtin_bit_cast(float, a), __builtin_bit_cast(float, b)); }

constexpr int FX_KSTR = 144, FX_F_OFF = 0, FX_K_OFF = 16384, FX_KBUF = 64 * FX_KSTR, FX_V_OFF = FX_K_OFF + 4 * FX_KBUF, FX_VBUF = 8192, FX_WT_OFF = FX_V_OFF + 6 * FX_VBUF;
__device__ __forceinline__ void fox_unit(int b, int h, int qb, const bf16* z, const float* lf, bf16* y, bool bounded, float skipT, LAS unsigned char* lds, int tid, int lane, int wave) {
    const int q0 = qb * 256; const size_t rowbase = (size_t)b * SEQ;
    const int r32 = lane & 31, hi = lane >> 5;
    LAS float* F2 = (LAS float*)(lds + FX_F_OFF);
    const unsigned lds0 = (unsigned)(uintptr_t)lds;
    const int qrow = q0 + 32 * wave + r32;
    bf16x8 qf[4];
    { const bf16* qp = z + (rowbase + qrow) * FX_N + h * 64 + 8 * hi;
#pragma unroll
        for (int ks = 0; ks < 4; ++ks) qf[ks] = *(const bf16x8*)(qp + 16 * ks); }
    const int srow = tid >> 3, sch = tid & 7;
    const bf16* kg = z + (rowbase + srow) * FX_N + 1024 + h * 64 + 8 * sch;
    const bf16* vg = kg + 1024;
    const unsigned kdst = lds0 + FX_K_OFF + srow * FX_KSTR + sch * 16;
    const unsigned vdst = lds0 + FX_V_OFF + (sch >> 2) * 4096 + srow * 64 + (sch & 3) * 16;
    const int NT = 4 * (qb + 1), tmax = 4 * qb + (wave >> 1);
    v4u kA, vA, kB, vB;
    {
        const int n = q0 + 256; float v[8];
        if (tid * 8 < n) { const float* p = lf + ((size_t)b * 16 + h) * SEQ + tid * 8; const f32x4 a = *(const f32x4*)p, c = *(const f32x4*)(p + 4);
            v[0] = a.x; v[1] = v[0] + a.y; v[2] = v[1] + a.z; v[3] = v[2] + a.w; v[4] = v[3] + c.x; v[5] = v[4] + c.y; v[6] = v[5] + c.z; v[7] = v[6] + c.w; }
        else {
#pragma unroll
            for (int i = 0; i < 8; ++i) v[i] = 0.f; }
        const float inc = scan_add(v[7], lane);
        LAS float* wt = (LAS float*)(lds + FX_WT_OFF);
        if (lane == 63) wt[wave] = inc;
        __syncthreads();
        float base = inc - v[7];
        for (int w = 0; w < wave; ++w) base += wt[w];
        if (tid * 8 < n) { f32x4 a, c; a.x = (base + v[0]) * LOG2E; a.y = (base + v[1]) * LOG2E; a.z = (base + v[2]) * LOG2E; a.w = (base + v[3]) * LOG2E;
            c.x = (base + v[4]) * LOG2E; c.y = (base + v[5]) * LOG2E; c.z = (base + v[6]) * LOG2E; c.w = (base + v[7]) * LOG2E;
            *(LAS f32x4*)(F2 + tid * 8) = a; *(LAS f32x4*)(F2 + tid * 8 + 4) = c; }
    }
    __syncthreads();
    int t0 = 0, tw = 0;
    if (bounded) { const float FX_SKIP = skipT;
        { const float lim = F2[q0] + FX_SKIP; int lo = 0, hi2 = NT - 1;
            while (lo < hi2) { const int mid = (lo + hi2) >> 1; if (F2[64 * mid + 63] <= lim) hi2 = mid; else lo = mid + 1; }
            t0 = lo & ~1; }
        { const float lim = F2[q0 + 32 * wave] + FX_SKIP; int lo = t0, hi2 = tmax;
            while (lo < hi2) { const int mid = (lo + hi2) >> 1; if (F2[64 * mid + 63] <= lim) hi2 = mid; else lo = mid + 1; }
            tw = lo; } }
#if PROBE_CNT
    if (tid == 0) { volatile LAS unsigned* mc_ = (volatile LAS unsigned*)(lds + MISC_OFF); mc_[16] += (unsigned)(NT - t0); mc_[17] += (unsigned)NT; }
#endif
#define FX_KSLOT(tt) ((unsigned)((((tt) >> 1) & 1) * 2 + ((tt) & 1)) * FX_KBUF)
#define FX_VSLOT(tt) ((unsigned)((((tt) >> 1) % 3) * 2 + ((tt) & 1)) * FX_VBUF)
    { const v4u k0 = *(const v4u*)(kg + (size_t)t0 * 64 * FX_N), v0 = *(const v4u*)(vg + (size_t)t0 * 64 * FX_N);
        const v4u k1 = *(const v4u*)(kg + (size_t)(t0 + 1) * 64 * FX_N), v1 = *(const v4u*)(vg + (size_t)(t0 + 1) * 64 * FX_N);
        *(LAS v4u*)(uintptr_t)(kdst + FX_KSLOT(t0)) = k0; *(LAS v4u*)(uintptr_t)(vdst + FX_VSLOT(t0)) = v0; *(LAS v4u*)(uintptr_t)(kdst + FX_KSLOT(t0 + 1)) = k1; *(LAS v4u*)(uintptr_t)(vdst + FX_VSLOT(t0 + 1)) = v1; }
    __syncthreads();
    const float Fq = F2[qrow];
    f32x16 o[2];
#pragma unroll
    for (int i = 0; i < 16; ++i) { o[0][i] = 0.f; o[1][i] = 0.f; }
    float lsum = 0.f, mref = 0.f;
    const unsigned ka = lds0 + FX_K_OFF + r32 * FX_KSTR + hi * 16;
    const unsigned va = lds0 + FX_V_OFF + (4 * hi + ((lane & 15) >> 2)) * 64 + (16 * ((lane >> 4) & 1) + 4 * (lane & 3)) * 2;
#define FX_QK(P, tt) do { const LAS float* fk_ = F2 + 64 * (tt) + 4 * hi; const float bq_ = Fq - mref; const unsigned kb_ = ka + FX_KSLOT(tt); \
        bf16x8 kf_[4][2]; f32x4 ff_[2][4]; \
        _Pragma("unroll") for (int ks = 0; ks < 4; ++ks) _Pragma("unroll") for (int hf = 0; hf < 2; ++hf) kf_[ks][hf] = *(const LAS bf16x8*)(uintptr_t)(kb_ + hf * 32 * FX_KSTR + ks * 32); \
        _Pragma("unroll") for (int hf = 0; hf < 2; ++hf) _Pragma("unroll") for (int g = 0; g < 4; ++g) ff_[hf][g] = *(const LAS f32x4*)(fk_ + 32 * hf + 8 * g); \
        SCHED_FENCE(); \
        _Pragma("unroll") for (int hf = 0; hf < 2; ++hf) _Pragma("unroll") for (int g = 0; g < 4; ++g) { const f32x4 f_ = ff_[hf][g]; \
            P[hf][4 * g] = bq_ - f_.x; P[hf][4 * g + 1] = bq_ - f_.y; P[hf][4 * g + 2] = bq_ - f_.z; P[hf][4 * g + 3] = bq_ - f_.w; } \
        _Pragma("unroll") for (int ks = 0; ks < 4; ++ks) _Pragma("unroll") for (int hf = 0; hf < 2; ++hf) P[hf] = MFMA32(kf_[ks][hf], qf[ks], P[hf]); } while (0)
#define FX_SM(P, NOMAX, tt) do { \
        if (64 * (tt) + 63 > q0 + 32 * wave) { _Pragma("unroll") for (int hf = 0; hf < 2; ++hf) _Pragma("unroll") for (int r = 0; r < 16; ++r) { const int kv_ = 64 * (tt) + 32 * hf + crow(r, hi); if (kv_ > qrow) P[hf][r] = -INFINITY; } } \
        if (!(NOMAX)) { float mx_ = fmaxf(P[0][0], P[1][0]); \
            _Pragma("unroll") for (int r = 1; r < 16; ++r) mx_ = fmaxf(mx_, fmaxf(P[0][r], P[1][r])); \
            mx_ = xmax32(mx_); \
            if (__any(mx_ > 8.0f)) { const float dl_ = fmaxf(mx_, 0.f), alpha_ = ex2(-dl_); mref += dl_; lsum *= alpha_; \
                _Pragma("unroll") for (int r = 0; r < 16; ++r) { P[0][r] -= dl_; P[1][r] -= dl_; o[0][r] *= alpha_; o[1][r] *= alpha_; } } } \
        _Pragma("unroll") for (int hf = 0; hf < 2; ++hf) { \
            _Pragma("unroll") for (int r = 0; r < 16; ++r) { P[hf][r] = ex2(P[hf][r]); lsum += P[hf][r]; } \
            _Pragma("unroll") for (int k2 = 0; k2 < 2; ++k2) { v4u w_; w_.x = cvtpk(P[hf][8 * k2], P[hf][8 * k2 + 1]); w_.y = cvtpk(P[hf][8 * k2 + 2], P[hf][8 * k2 + 3]); w_.z = cvtpk(P[hf][8 * k2 + 4], P[hf][8 * k2 + 5]); w_.w = cvtpk(P[hf][8 * k2 + 6], P[hf][8 * k2 + 7]); \
                pf[hf][k2] = __builtin_bit_cast(bf16x8, w_); } } } while (0)
#define FX_PV(tt) do { const unsigned vs_ = va + FX_VSLOT(tt); s16x4 lo_[2][2][2], hh_[2][2][2]; \
        _Pragma("unroll") for (int hf = 0; hf < 2; ++hf) _Pragma("unroll") for (int k2 = 0; k2 < 2; ++k2) _Pragma("unroll") for (int db = 0; db < 2; ++db) { const unsigned ad_ = vs_ + db * 4096 + (32 * hf + 16 * k2) * 64; \
            lo_[hf][k2][db] = ds_tr16(ad_); hh_[hf][k2][db] = ds_tr16(ad_ + 8 * 64); } \
        SCHED_FENCE(); \
        _Pragma("unroll") for (int hf = 0; hf < 2; ++hf) _Pragma("unroll") for (int k2 = 0; k2 < 2; ++k2) _Pragma("unroll") for (int db = 0; db < 2; ++db) { const s16x4 l_ = lo_[hf][k2][db], h_ = hh_[hf][k2][db]; \
            const bf16x8 a_ = {l_[0], l_[1], l_[2], l_[3], h_[0], h_[1], h_[2], h_[3]}; \
            o[db] = MFMA32(a_, pf[hf][k2], o[db]); } } while (0)
#define FX_TILE(t, NOMAX, LAG) do { \
        if (LAG) { if ((t) - 1 >= tw && (t) - 1 <= tmax) FX_PV((t) - 1); if ((t) >= tw && (t) <= tmax) { FX_QK(pc, (t)); FX_SM(pc, NOMAX, (t)); } } \
        else { if ((t) >= tw && (t) <= tmax) { FX_QK(pc, (t)); FX_SM(pc, NOMAX, (t)); FX_PV((t)); } } } while (0)
#define FX_ITER(t, NOMAX, LAG) do { \
        if ((t) + 2 < NT) { kA = *(const v4u*)(kg + (size_t)((t) + 2) * 64 * FX_N); vA = *(const v4u*)(vg + (size_t)((t) + 2) * 64 * FX_N); \
                            kB = *(const v4u*)(kg + (size_t)((t) + 3) * 64 * FX_N); vB = *(const v4u*)(vg + (size_t)((t) + 3) * 64 * FX_N); } \
        FX_TILE((t), NOMAX, LAG); FX_TILE((t) + 1, NOMAX, LAG); \
        if ((t) + 2 < NT) { *(LAS v4u*)(uintptr_t)(kdst + FX_KSLOT((t) + 2)) = kA; *(LAS v4u*)(uintptr_t)(vdst + FX_VSLOT((t) + 2)) = vA; \
                            *(LAS v4u*)(uintptr_t)(kdst + FX_KSLOT((t) + 3)) = kB; *(LAS v4u*)(uintptr_t)(vdst + FX_VSLOT((t) + 3)) = vB; } \
        __syncthreads(); } while (0)
    f32x16 pc[2]; bf16x8 pf[2][2];
    if (wave < 4) {
        if (bounded) { for (int t = t0; t < NT; t += 2) FX_ITER(t, true, false); }
        else { for (int t = t0; t < NT; t += 2) FX_ITER(t, false, false); }
    } else {
        if (bounded) { for (int t = t0; t < NT; t += 2) FX_ITER(t, true, true); }
        else { for (int t = t0; t < NT; t += 2) FX_ITER(t, false, true); }
        if (tmax == NT - 1) FX_PV(NT - 1);
    }
#undef FX_ITER
#undef FX_TILE
#undef FX_KSLOT
#undef FX_VSLOT
#undef FX_QK
#undef FX_SM
#undef FX_PV
    lsum = xsum32(lsum);
    const float il = 1.0f / lsum;
    bf16* yp = y + (rowbase + qrow) * D + h * 64 + 4 * hi;
#pragma unroll
    for (int db = 0; db < 2; ++db)
#pragma unroll
        for (int g = 0; g < 4; ++g) { const unsigned long long w = (unsigned long long)cvtpk(o[db][4 * g] * il, o[db][4 * g + 1] * il) | ((unsigned long long)cvtpk(o[db][4 * g + 2] * il, o[db][4 * g + 3] * il) << 32);
            *(unsigned long long*)(yp + 32 * db + 8 * g) = w; }
}

constexpr int DA_KSTR = 272, DA_K_OFF = 0, DA_KBUF = 64 * DA_KSTR, DA_V_OFF = 2 * DA_KBUF, DA_VBUF = 16384;
static_assert(DA_V_OFF + 2 * DA_VBUF >= 65536 && DA_V_OFF + 2 * DA_VBUF <= RING_BYTES, "DA LDS map (the exchange reuses the K/V region)");
__device__ __forceinline__ void da_unit(int b, int h, int qb, const bf16* z, bf16* y, volatile LAS unsigned* MISC, bool bounded, const float* subln_g, LAS unsigned char* lds, int tid, int lane, int wave) {
    const int q0 = qb * 128, qs = wave & 3, mm = wave >> 2; const size_t rowbase = (size_t)b * SEQ;
    const int r32 = lane & 31, hi = lane >> 5;
    const unsigned lds0 = (unsigned)(uintptr_t)lds;
    const float slope2 = exp2f(-2.0f * (float)(h + 1)) * LOG2E;
    const int qrow = q0 + 32 * qs + r32;
    float cr[16];
#pragma unroll
    for (int r = 0; r < 16; ++r) cr[r] = slope2 * (float)crow(r, hi);
#ifdef DBG_DA_SYNC
    for (int i = tid; i < 69632 / 4; i += NTHREADS) ((LAS unsigned*)lds)[i] = 0u;
    __syncthreads();
#endif
    bf16x8 qf[4];
    { const bf16* qp = z + (rowbase + qrow) * AB_N + h * 128 + mm * 64 + 8 * hi;
#pragma unroll
        for (int ks = 0; ks < 4; ++ks) qf[ks] = *(const bf16x8*)(qp + 16 * ks); }
    const bf16* kg[2]; unsigned kdst[2], vdst[2];
#pragma unroll
    for (int i = 0; i < 2; ++i) { const int c = tid + 512 * i, row = c >> 4, ch = c & 15;
        kg[i] = z + (rowbase + row) * AB_N + 512 + h * 128 + 8 * ch;
        kdst[i] = lds0 + DA_K_OFF + row * DA_KSTR + ch * 16; vdst[i] = lds0 + DA_V_OFF + (ch >> 2) * 4096 + row * 64 + (ch & 3) * 16; }
    int t0 = 0, tw = 0;
    if (bounded) { const float DA_SKIP = __builtin_bit_cast(float, (unsigned)MISC[5]); const float dist = DA_SKIP / slope2;
        const int f0 = (int)floorf(((float)(q0 - 63) - dist) * (1.0f / 64.0f)) + 1, fw = (int)floorf(((float)(q0 + 32 * qs - 63) - dist) * (1.0f / 64.0f)) + 1;
        t0 = f0 > 0 ? f0 : 0; tw = fw > 0 ? fw : 0; }
    v4u kreg[2], vreg[2];
#pragma unroll
    for (int i = 0; i < 2; ++i) { kreg[i] = *(const v4u*)(kg[i] + (size_t)t0 * 64 * AB_N); vreg[i] = *(const v4u*)(kg[i] + 512 + (size_t)t0 * 64 * AB_N); }
#pragma unroll
    for (int i = 0; i < 2; ++i) { *(LAS v4u*)(uintptr_t)(kdst[i] + (t0 & 1) * DA_KBUF) = kreg[i]; *(LAS v4u*)(uintptr_t)(vdst[i] + (t0 & 1) * DA_VBUF) = vreg[i]; }
    __syncthreads();
    f32x16 o[4];
#pragma unroll
    for (int d = 0; d < 4; ++d)
#pragma unroll
        for (int i = 0; i < 16; ++i) o[d][i] = 0.f;
    float lsum = 0.f, mref = 0.f;
    const int NT = (q0 + 128) / 64, tmax = (q0 + 32 * qs) / 64;
    const unsigned ka = lds0 + DA_K_OFF + r32 * DA_KSTR + mm * 128 + hi * 16;
    const unsigned va = lds0 + DA_V_OFF + (4 * hi + ((lane & 15) >> 2)) * 64 + (16 * ((lane >> 4) & 1) + 4 * (lane & 3)) * 2;
    auto da_loop = [&](auto nomax_tag) { constexpr bool NOMAX = decltype(nomax_tag)::value;
    for (int t = t0; t < NT; ++t) {
        const int buf = t & 1;
        if (t + 1 < NT) {
#pragma unroll
            for (int i = 0; i < 2; ++i) { kreg[i] = *(const v4u*)(kg[i] + (size_t)(t + 1) * 64 * AB_N); vreg[i] = *(const v4u*)(kg[i] + 512 + (size_t)(t + 1) * 64 * AB_N); } }
        if (t >= tw && t <= tmax) {
            f32x16 p[2];
            if (t < tmax) {
                const float b0 = -slope2 * (float)(qrow - 64 * t) - mref, b1 = b0 + 32.0f * slope2;
#pragma unroll
                for (int r = 0; r < 16; ++r) { p[0][r] = b0 + cr[r]; p[1][r] = b1 + cr[r]; }
            } else {
#pragma unroll
                for (int hf = 0; hf < 2; ++hf)
#pragma unroll
                    for (int r = 0; r < 16; ++r) p[hf][r] = -slope2 * fabsf((float)(qrow - (64 * t + 32 * hf + crow(r, hi)))) - mref;
            }
#pragma unroll
            for (int hf = 0; hf < 2; ++hf)
#pragma unroll
                for (int ks = 0; ks < 4; ++ks) { const bf16x8 a = *(const LAS bf16x8*)(uintptr_t)(ka + buf * DA_KBUF + hf * 32 * DA_KSTR + ks * 32); p[hf] = MFMA32(a, qf[ks], p[hf]); }
            if (!NOMAX) {
            float mx = fmaxf(p[0][0], p[1][0]);
#pragma unroll
            for (int r = 1; r < 16; ++r) mx = fmaxf(mx, fmaxf(p[0][r], p[1][r]));
            mx = xmax32(mx);
            if (__any(mx > 8.0f)) { const float dl = fmaxf(mx, 0.f), alpha = ex2(-dl); mref += dl; lsum *= alpha;
#pragma unroll
                for (int r = 0; r < 16; ++r) { p[0][r] -= dl; p[1][r] -= dl; }
#pragma unroll
                for (int d = 0; d < 4; ++d)
#pragma unroll
                    for (int r = 0; r < 16; ++r) o[d][r] *= alpha; }
            }
            bf16x8 pf[2][2];
#pragma unroll
            for (int hf = 0; hf < 2; ++hf) {
#pragma unroll
                for (int r = 0; r < 16; ++r) { p[hf][r] = ex2(p[hf][r]); lsum += p[hf][r]; }
#pragma unroll
                for (int k2 = 0; k2 < 2; ++k2) { v4u w; w.x = cvtpk(p[hf][8 * k2], p[hf][8 * k2 + 1]); w.y = cvtpk(p[hf][8 * k2 + 2], p[hf][8 * k2 + 3]); w.z = cvtpk(p[hf][8 * k2 + 4], p[hf][8 * k2 + 5]); w.w = cvtpk(p[hf][8 * k2 + 6], p[hf][8 * k2 + 7]);
                    pf[hf][k2] = __builtin_bit_cast(bf16x8, w); } }
#pragma unroll
            for (int db = 0; db < 4; ++db)
#pragma unroll
                for (int hf = 0; hf < 2; ++hf)
#pragma unroll
                    for (int k2 = 0; k2 < 2; ++k2) { const unsigned ad = va + buf * DA_VBUF + db * 4096 + (32 * hf + 16 * k2) * 64;
                        const s16x4 lo = ds_tr16(ad), hh = ds_tr16(ad + 8 * 64);
                        const bf16x8 a = {lo[0], lo[1], lo[2], lo[3], hh[0], hh[1], hh[2], hh[3]};
                        o[db] = MFMA32(a, pf[hf][k2], o[db]); }
        }
        if (t + 1 < NT) {
#pragma unroll
            for (int i = 0; i < 2; ++i) { *(LAS v4u*)(uintptr_t)(kdst[i] + (buf ^ 1) * DA_KBUF) = kreg[i]; *(LAS v4u*)(uintptr_t)(vdst[i] + (buf ^ 1) * DA_VBUF) = vreg[i]; } }
        __syncthreads();
    }
    };
    if (bounded) da_loop(std::true_type{}); else da_loop(std::false_type{});
    lsum = xsum32(lsum);
    const float il = 1.0f / lsum;
    LAS float* xb = (LAS float*)lds + qs * 4096 + lane;
    if (mm == 1) {
#pragma unroll
        for (int db = 0; db < 4; ++db)
#pragma unroll
            for (int r = 0; r < 16; ++r) xb[(db * 16 + r) * 64] = o[db][r] * il;
    }
    __syncthreads();
    if (mm == 0) {
        const float lam = __builtin_bit_cast(float, (unsigned)MISC[2]), lambda_init = __builtin_bit_cast(float, (unsigned)MISC[3]);
        float ss = 0.f;
#pragma unroll
        for (int db = 0; db < 4; ++db)
#pragma unroll
            for (int r = 0; r < 16; ++r) { const float dv = o[db][r] * il - lam * xb[(db * 16 + r) * 64]; o[db][r] = dv; ss += dv * dv; }
        ss += __shfl_xor(ss, 32);
        const float rn = (1.0f - lambda_init) / sqrtf(ss * (1.0f / 128.0f) + EPS);
        bf16* yp = y + (rowbase + qrow) * D + h * 128 + 4 * hi; const float* gp = subln_g + 4 * hi;
#pragma unroll
        for (int db = 0; db < 4; ++db)
#pragma unroll
            for (int g = 0; g < 4; ++g) { const f32x4 gg = *(const f32x4*)(gp + 32 * db + 8 * g);
                const unsigned long long w = (unsigned long long)cvtpk(o[db][4 * g] * rn * gg.x, o[db][4 * g + 1] * rn * gg.y) | ((unsigned long long)cvtpk(o[db][4 * g + 2] * rn * gg.z, o[db][4 * g + 3] * rn * gg.w) << 32);
                *(unsigned long long*)(yp + 32 * db + 8 * g) = w; }
    }
    __syncthreads();
}

__device__ __forceinline__ void phase_mlconv(const bf16* z, const float* conv_w, const float* conv_b, bf16* qkc, int tid, int G) {
    const int cg = tid & 127, rs = tid >> 7, ch = 8 * cg;
    const float scl = (ch >= 512) ? 0.08838834764831845f : 1.0f;
    for (int item = blockIdx.x; item < M / 16; item += G) {
        const int row0 = item * 16 + 4 * rs, t0 = row0 % SEQ;
        v4u xr[7];
#pragma unroll
        for (int j = 0; j < 7; ++j) { const int tt = t0 - 3 + j; xr[j] = (tt >= 0) ? *(const v4u*)(z + (size_t)(row0 - 3 + j) * AB_N + 1536 + ch) : (v4u){0u, 0u, 0u, 0u}; }
        float a4[4][8];
        { const f32x4 b0 = *(const f32x4*)(conv_b + ch), b1 = *(const f32x4*)(conv_b + ch + 4);
#pragma unroll
            for (int r = 0; r < 4; ++r) { a4[r][0] = b0.x; a4[r][1] = b0.y; a4[r][2] = b0.z; a4[r][3] = b0.w; a4[r][4] = b1.x; a4[r][5] = b1.y; a4[r][6] = b1.z; a4[r][7] = b1.w; } }
#pragma unroll
        for (int j = 0; j < 4; ++j) { const f32x4 w0 = *(const f32x4*)(conv_w + j * 1024 + ch), w1 = *(const f32x4*)(conv_w + j * 1024 + ch + 4);
#pragma unroll
            for (int r = 0; r < 4; ++r) { const v4u u = xr[r + j];
                a4[r][0] += bf_lo(u.x) * w0.x; a4[r][1] += bf_hi(u.x) * w0.y; a4[r][2] += bf_lo(u.y) * w0.z; a4[r][3] += bf_hi(u.y) * w0.w;
                a4[r][4] += bf_lo(u.z) * w1.x; a4[r][5] += bf_hi(u.z) * w1.y; a4[r][6] += bf_lo(u.w) * w1.z; a4[r][7] += bf_hi(u.w) * w1.w; } }
#pragma unroll
        for (int r = 0; r < 4; ++r) { float a[8];
#pragma unroll
            for (int i = 0; i < 8; ++i) a[i] = a4[r][i] * fast_sig(a4[r][i]) * scl;
            v4u w; w.x = cvtpk(a[0], a[1]); w.y = cvtpk(a[2], a[3]); w.z = cvtpk(a[4], a[5]); w.w = cvtpk(a[6], a[7]);
            *(v4u*)(qkc + (size_t)(row0 + r) * 1024 + ch) = w; }
    }
}

typedef float f32x4v __attribute__((ext_vector_type(4)));
#define MFMA16(a, b, c) __builtin_amdgcn_mfma_f32_16x16x32_bf16((a), (b), (c), 0, 0, 0)
constexpr int ML_STR = 272, ML_VSTR = 144, ML_Q = 0, ML_K = 17408, ML_KBUF = 80 * ML_STR, ML_V = ML_K + 2 * ML_KBUF, ML_VW = ML_V + 64 * ML_VSTR, ML_P = ML_VW + 64 * ML_VSTR, ML_PSTR = 144,
              ML_H = ML_P + 64 * ML_PSTR, ML_T = ML_H + 64 * ML_VSTR, ML_TPAR = 2048, ML_DENP = ML_T + 2 * ML_TPAR, ML_DN = ML_DENP + 1024, ML_DUMMY = ML_DN + 256, ML_XCH = ML_DUMMY + 512, ML_END = ML_XCH + 16384;
constexpr int ML_RS = RING_BYTES + 1024;
static_assert(ML_END <= RING_BYTES && ML_RS + 4096 <= LDS_BYTES && MISC_OFF + 128 <= RING_BYTES + 1024, "mLSTM LDS map");
__device__ __forceinline__ float bcast63(float v) { return __builtin_bit_cast(float, __builtin_amdgcn_readlane(__builtin_bit_cast(int, v), 63)); }
__device__ __forceinline__ void ml_gate_tables(float lfv, float igv, LAS float* tp, float& mprev, int lane) {
    lfv *= LOG2E; igv *= LOG2E;
    const float a = scan_add(lfv, lane), b = igv - a, cm = scan_max(b, lane);
    const float alast = bcast63(a), bmax = bcast63(cm);
    const float mnew = fmaxf(alast + mprev, alast + bmax), Mv = fmaxf(mprev, cm);
    tp[lane] = b; tp[64 + lane] = Mv; tp[128 + lane] = ex2(mprev - Mv); tp[192 + lane] = ex2(-(a + Mv)); tp[256 + lane] = ex2(alast + b - mnew);
    if (lane == 0) tp[320] = ex2(alast + mprev - mnew);
    mprev = mnew;
}
template <int STRIDE> __device__ __forceinline__ bf16x8 tr_frag(unsigned addr) {
    const s16x4 lo = ds_tr16(addr), hh = ds_tr16(addr + 4 * STRIDE);
    return (bf16x8){lo[0], lo[1], lo[2], lo[3], hh[0], hh[1], hh[2], hh[3]}; }
__device__ __forceinline__ void mlstm_unit(int b, int h, int dh, const bf16* z, const bf16* qkc, const float* gates, bf16* y, LAS unsigned char* lds, int tid, int lane, int wave) {
    const size_t rowbase = (size_t)b * SEQ;
    const unsigned lds0 = (unsigned)(uintptr_t)lds;
    const float* gi = gates + ((size_t)b * 4 + h) * SEQ; const float* glf = gates + (size_t)BATCH * 4 * SEQ + ((size_t)b * 4 + h) * SEQ;
    const int c15 = lane & 15, kq = lane >> 4;
    const int sl = wave >> 1, rr = wave & 1;
    const bf16* gq = qkc + rowbase * 1024 + h * 128;
    const bf16* zv = z + rowbase * AB_N + 2560 + h * 128 + 64 * dh + 8 * (tid & 7);
    const int vrow = tid >> 3;
    v4u qr[2], kr[2], vr;
#define ML_LOADS(cn) do { _Pragma("unroll") for (int i = 0; i < 2; ++i) { const int c_ = tid + 512 * i; const size_t r_ = (size_t)(64 * (cn) + (c_ >> 4)); \
            qr[i] = *(const v4u*)(gq + r_ * 1024 + 8 * (c_ & 15)); kr[i] = *(const v4u*)(gq + r_ * 1024 + 512 + 8 * (c_ & 15)); } \
        vr = *(const v4u*)(zv + (size_t)(64 * (cn) + vrow) * AB_N); } while (0)
#define ML_CONV_STORE(kb) do { _Pragma("unroll") for (int i = 0; i < 2; ++i) { const int c_ = tid + 512 * i; const unsigned o_ = (c_ >> 4) * ML_STR + 16 * (c_ & 15); \
            *(LAS v4u*)(uintptr_t)(lds0 + ML_Q + o_) = qr[i]; *(LAS v4u*)(uintptr_t)(lds0 + ML_K + (kb) * ML_KBUF + o_) = kr[i]; } } while (0)
#define ML_V_STORE(tp) do { const float w_ = (tp)[256 + vrow]; const v4u u = vr; const unsigned o_ = vrow * ML_VSTR + 16 * (tid & 7); \
            *(LAS v4u*)(uintptr_t)(lds0 + ML_V + o_) = u; \
            v4u x_; x_.x = cvtpk(bf_lo(u.x) * w_, bf_hi(u.x) * w_); x_.y = cvtpk(bf_lo(u.y) * w_, bf_hi(u.y) * w_); x_.z = cvtpk(bf_lo(u.z) * w_, bf_hi(u.z) * w_); x_.w = cvtpk(bf_lo(u.w) * w_, bf_hi(u.w) * w_); \
            *(LAS v4u*)(uintptr_t)(lds0 + ML_VW + o_) = x_; } while (0)
    LAS float* T0 = (LAS float*)(lds + ML_T);
    LAS float* denp = (LAS float*)(lds + ML_DENP);
    LAS float* dnr = (LAS float*)(lds + ML_DN);
    LAS float* xch = (LAS float*)(lds + ML_XCH);
    float mprev = 0.f;
    float g_lf = 0.f, g_ig = 0.f;
    if (wave == 7) { ml_gate_tables(glf[lane], gi[lane], T0, mprev, lane); g_lf = glf[64 + lane]; g_ig = gi[64 + lane]; }
    ML_LOADS(0);
    ML_CONV_STORE(0);
    if (tid < 32) *(LAS unsigned long long*)(uintptr_t)(lds0 + ML_K + 64 * ML_STR + 8 * tid) = (unsigned long long)(tid >> 20);
    __syncthreads();
    ML_V_STORE(T0);
    f32x4v C[4], nacc = {0.f, 0.f, 0.f, 0.f};
#pragma unroll
    for (int T = 0; T < 4; ++T) C[T] = (f32x4v){0.f, 0.f, 0.f, 0.f};
    const int lt_s = wave >> 1, half_s = wave & 1;
#define ML_PHASE_C(cc, OG) do { const v4u hv = *(const LAS v4u*)(uintptr_t)(lds0 + ML_H + vrow * ML_VSTR + 16 * (tid & 7)); const v4u og = OG; \
        v4u o_; o_.x = cvtpk(bf_lo(hv.x) * fast_sig(bf_lo(og.x)), bf_hi(hv.x) * fast_sig(bf_hi(og.x))); o_.y = cvtpk(bf_lo(hv.y) * fast_sig(bf_lo(og.y)), bf_hi(hv.y) * fast_sig(bf_hi(og.y))); \
        o_.z = cvtpk(bf_lo(hv.z) * fast_sig(bf_lo(og.z)), bf_hi(hv.z) * fast_sig(bf_hi(og.z))); o_.w = cvtpk(bf_lo(hv.w) * fast_sig(bf_lo(og.w)), bf_hi(hv.w) * fast_sig(bf_hi(og.w))); \
        *(v4u*)(y + (rowbase + 64 * (cc) + vrow) * D + 512 + h * 128 + 64 * dh + 8 * (tid & 7)) = o_; } while (0)
    v4u ogp = (v4u){0u, 0u, 0u, 0u};
    __syncthreads();
    for (int c = 0; c < SEQ / 64; ++c) {
        const int par = c & 1, kb = c & 1; LAS float* tp = T0 + par * (ML_TPAR / 4);
        const unsigned Kb = lds0 + ML_K + kb * ML_KBUF;
        const bool more = (c + 1 < SEQ / 64);
        const v4u vcur = vr;
        float gn_lf = 0.f, gn_ig = 0.f;
        if (more) { ML_LOADS(c + 1); if (wave == 7 && c + 2 < SEQ / 64) { gn_lf = glf[64 * (c + 2) + lane]; gn_ig = gi[64 * (c + 2) + lane]; } }
        const v4u ogr = *(const v4u*)(zv + (size_t)(64 * c + vrow) * AB_N + 512);
        {
            bf16x8 qb[4], kf[2][4], nf[4];
            const int l = 16 * lt_s + c15;
#pragma unroll
            for (int ks = 0; ks < 4; ++ks) qb[ks] = *(const LAS bf16x8*)(uintptr_t)(lds0 + ML_Q + l * ML_STR + (32 * ks + 8 * kq) * 2);
#pragma unroll
            for (int jj = 0; jj < 2; ++jj)
#pragma unroll
                for (int ks = 0; ks < 4; ++ks) kf[jj][ks] = *(const LAS bf16x8*)(uintptr_t)(Kb + (16 * (2 * half_s + jj) + c15) * ML_STR + (32 * ks + 8 * kq) * 2);
#pragma unroll
            for (int ks = 0; ks < 4; ++ks) nf[ks] = *(const LAS bf16x8*)(uintptr_t)(Kb + (64 + c15) * ML_STR + (32 * ks + 8 * kq) * 2);
            const float Ml = tp[64 + l];
            const f32x4v bs0 = *(const LAS f32x4v*)(tp + 16 * (2 * half_s) + 4 * kq), bs1 = *(const LAS f32x4v*)(tp + 16 * (2 * half_s + 1) + 4 * kq);
            if (c > 0) { ML_PHASE_C(c - 1, ogp);
                { const float w_ = tp[256 + vrow]; const v4u u = vcur; const unsigned o_ = vrow * ML_VSTR + 16 * (tid & 7);
                    *(LAS v4u*)(uintptr_t)(lds0 + ML_V + o_) = u;
                    v4u x_; x_.x = cvtpk(bf_lo(u.x) * w_, bf_hi(u.x) * w_); x_.y = cvtpk(bf_lo(u.y) * w_, bf_hi(u.y) * w_); x_.z = cvtpk(bf_lo(u.z) * w_, bf_hi(u.z) * w_); x_.w = cvtpk(bf_lo(u.w) * w_, bf_hi(u.w) * w_);
                    *(LAS v4u*)(uintptr_t)(lds0 + ML_VW + o_) = x_; } }
            if (more && wave == 7) { ml_gate_tables(g_lf, g_ig, T0 + (par ^ 1) * (ML_TPAR / 4), mprev, lane); g_lf = gn_lf; g_ig = gn_ig; }
            ogp = ogr;
            SCHED_FENCE();
            f32x4v acc[2] = {{0.f, 0.f, 0.f, 0.f}, {0.f, 0.f, 0.f, 0.f}}, accn = {0.f, 0.f, 0.f, 0.f};
#pragma unroll
            for (int ks = 0; ks < 4; ++ks) { acc[0] = MFMA16(kf[0][ks], qb[ks], acc[0]); acc[1] = MFMA16(kf[1][ks], qb[ks], acc[1]); if (half_s == 0) accn = MFMA16(nf[ks], qb[ks], accn); }
#pragma unroll
            for (int jj = 0; jj < 2; ++jj) { const int st = 2 * half_s + jj; const f32x4v bs = jj ? bs1 : bs0;
                float p[4], sum = 0.f;
#pragma unroll
                for (int r = 0; r < 4; ++r) { const int sidx = 16 * st + 4 * kq + r; p[r] = (sidx <= l) ? acc[jj][r] * ex2(bs[r] - Ml) : 0.f; sum += p[r]; }
                sum = xsum32(xsum16(sum));
                denp[st * 64 + l] = sum;
                *(LAS unsigned long long*)(uintptr_t)(lds0 + ML_P + l * ML_PSTR + (16 * st + 4 * kq) * 2) = (unsigned long long)cvtpk(p[0], p[1]) | ((unsigned long long)cvtpk(p[2], p[3]) << 32);
            }
            if (half_s == 0) *(LAS float*)(uintptr_t)(kq == 0 ? lds0 + ML_DN + 4 * l : lds0 + ML_DUMMY + 8 * lane) = accn[0];
        }
        f32x4v hp[4];
        {
            bf16x8 cbf[2];
#pragma unroll
            for (int j = 0; j < 2; ++j) { v4u w_; w_.x = cvtpk(C[2 * j][0], C[2 * j][1]); w_.y = cvtpk(C[2 * j][2], C[2 * j][3]); w_.z = cvtpk(C[2 * j + 1][0], C[2 * j + 1][1]); w_.w = cvtpk(C[2 * j + 1][2], C[2 * j + 1][3]);
                cbf[j] = __builtin_bit_cast(bf16x8, w_); }
            unsigned long long qlo[4][2], qhi[4][2];
#pragma unroll
            for (int lt = 0; lt < 4; ++lt)
#pragma unroll
                for (int j = 0; j < 2; ++j) { const unsigned qa = lds0 + ML_Q + (16 * lt + c15) * ML_STR + (32 * (2 * rr + j) + 4 * kq) * 2;
                    qlo[lt][j] = *(const LAS unsigned long long*)(uintptr_t)qa; qhi[lt][j] = *(const LAS unsigned long long*)(uintptr_t)(qa + 32); }
            SCHED_FENCE();
#pragma unroll
            for (int lt = 0; lt < 4; ++lt) { hp[lt] = (f32x4v){0.f, 0.f, 0.f, 0.f};
#pragma unroll
                for (int j = 0; j < 2; ++j) { v4u w_; w_.x = (unsigned)qlo[lt][j]; w_.y = (unsigned)(qlo[lt][j] >> 32); w_.z = (unsigned)qhi[lt][j]; w_.w = (unsigned)(qhi[lt][j] >> 32);
                    hp[lt] = MFMA16(__builtin_bit_cast(bf16x8, w_), cbf[j], hp[lt]); } }
#pragma unroll
            for (int i = 0; i < 2; ++i)
#pragma unroll
                for (int r = 0; r < 4; ++r) xch[((wave * 2 + i) * 4 + r) * 64 + lane] = rr ? hp[i][r] : hp[2 + i][r];
        }
        __syncthreads();
        const float decay = tp[320];
        bf16x8 vb[2], pfr[2][2], vwb[2], wb[2], an[2], af[4][2]; float xp[2][4];
#pragma unroll
        for (int k2 = 0; k2 < 2; ++k2) { vb[k2] = tr_frag<ML_VSTR>(lds0 + ML_V + (32 * k2 + 8 * kq + ((lane & 15) >> 2)) * ML_VSTR + (16 * sl + 4 * (lane & 3)) * 2);
            vwb[k2] = tr_frag<ML_VSTR>(lds0 + ML_VW + (32 * k2 + 8 * kq + ((lane & 15) >> 2)) * ML_VSTR + (16 * sl + 4 * (lane & 3)) * 2);
            an[k2] = tr_frag<ML_STR>(Kb + (32 * k2 + 8 * kq + ((lane & 15) >> 2)) * ML_STR + (16 * wave + 4 * (lane & 3)) * 2);
            const f32x4v w0 = *(const LAS f32x4v*)(tp + 256 + 32 * k2 + 8 * kq), w1 = *(const LAS f32x4v*)(tp + 256 + 32 * k2 + 8 * kq + 4);
            v4u w_; w_.x = cvtpk(w0[0], w0[1]); w_.y = cvtpk(w0[2], w0[3]); w_.z = cvtpk(w1[0], w1[1]); w_.w = cvtpk(w1[2], w1[3]);
            if (c15 != 0) w_ = (v4u){0u, 0u, 0u, 0u};
            wb[k2] = __builtin_bit_cast(bf16x8, w_); }
#pragma unroll
        for (int i = 0; i < 2; ++i) {
#pragma unroll
            for (int r = 0; r < 4; ++r) xp[i][r] = xch[(((wave ^ 1) * 2 + i) * 4 + r) * 64 + lane];
#pragma unroll
            for (int k2 = 0; k2 < 2; ++k2) pfr[i][k2] = *(const LAS bf16x8*)(uintptr_t)(lds0 + ML_P + (16 * (2 * rr + i) + c15) * ML_PSTR + (32 * k2 + 8 * kq) * 2); }
#pragma unroll
        for (int Ti = 0; Ti < 4; ++Ti)
#pragma unroll
            for (int k2 = 0; k2 < 2; ++k2) af[Ti][k2] = tr_frag<ML_STR>(Kb + (32 * k2 + 8 * kq + ((lane & 15) >> 2)) * ML_STR + (16 * (4 * rr + Ti) + 4 * (lane & 3)) * 2);
        LAS float* rsw = (LAS float*)(lds + ML_RS) + wave * 128;
        { const float iwl = tp[128 + lane], fll = tp[192 + lane];
            const float den = iwl * dnr[lane] + ((denp[lane] + denp[64 + lane]) + (denp[128 + lane] + denp[192 + lane]));
            rsw[lane] = iwl; rsw[64 + lane] = __builtin_amdgcn_rcpf(fmaxf(fabsf(den), fll)); }
        f32x4v iw4[2], rs4[2];
#pragma unroll
        for (int i = 0; i < 2; ++i) { iw4[i] = *(const LAS f32x4v*)(rsw + 16 * (2 * rr + i) + 4 * kq); rs4[i] = *(const LAS f32x4v*)(rsw + 64 + 16 * (2 * rr + i) + 4 * kq); }
        SCHED_FENCE();
        {
            f32x4v hacc[2];
#pragma unroll
            for (int i = 0; i < 2; ++i) {
#pragma unroll
                for (int r = 0; r < 4; ++r) hacc[i][r] = ((rr ? hp[2 + i][r] : hp[i][r]) + xp[i][r]) * iw4[i][r];
#pragma unroll
                for (int k2 = 0; k2 < 2; ++k2) hacc[i] = MFMA16(pfr[i][k2], vb[k2], hacc[i]); }
#pragma unroll
            for (int i = 0; i < 2; ++i)
#pragma unroll
                for (int r = 0; r < 4; ++r) { const float hv = hacc[i][r] * rs4[i][r];
                    *(LAS bf16*)(uintptr_t)(lds0 + ML_H + (16 * (2 * rr + i) + 4 * kq + r) * ML_VSTR + (16 * sl + c15) * 2) = (bf16)(cvtpk(hv, 0.f) & 0xffffu); }
        }
        {
#pragma unroll
            for (int r = 0; r < 4; ++r) nacc[r] *= decay;
#pragma unroll
            for (int Ti = 0; Ti < 4; ++Ti) {
#pragma unroll
                for (int r = 0; r < 4; ++r) C[Ti][r] *= decay;
#pragma unroll
                for (int k2 = 0; k2 < 2; ++k2) C[Ti] = MFMA16(af[Ti][k2], vwb[k2], C[Ti]); }
#pragma unroll
            for (int k2 = 0; k2 < 2; ++k2) nacc = MFMA16(an[k2], wb[k2], nacc);
            *(LAS unsigned long long*)(uintptr_t)(c15 == 0 ? lds0 + ML_K + (kb ^ 1) * ML_KBUF + 64 * ML_STR + (16 * wave + 4 * kq) * 2 : lds0 + ML_DUMMY + 8 * lane) = (unsigned long long)cvtpk(nacc[0], nacc[1]) | ((unsigned long long)cvtpk(nacc[2], nacc[3]) << 32);
        }
        if (more) ML_CONV_STORE(kb ^ 1);
        __syncthreads();
    }
    ML_PHASE_C(SEQ / 64 - 1, ogp);
    __syncthreads();
#undef ML_PHASE_C
#undef ML_LOADS
#undef ML_CONV_STORE
#undef ML_V_STORE
}

constexpr int N_PHASES = 1 + 7 * DEPTH;
__global__ void __launch_bounds__(NTHREADS, 2) fwd_kernel(Args args) {
    extern __shared__ __attribute__((aligned(16))) unsigned char lds_raw[];
    LAS unsigned char* lds = (LAS unsigned char*)lds_raw;
    volatile LAS unsigned* MISC = (volatile LAS unsigned*)(lds + MISC_OFF);
    const int tid0 = threadIdx.x;
    const int G = gridDim.x;
    unsigned char* ws = args.ws;
    gu32* ctl = (gu32*)(ws + WS_CTL);
    for (int u = tid0; u < (LDS_BYTES - LDSCTL_OFF) / 4; u += NTHREADS) ((LAS unsigned*)(lds + LDSCTL_OFF))[u] = 0u;
    __syncthreads();
    XcdBarrier bar; bar.bar = (unsigned*)(ctl + CW_BAR); bar.x = 0; bar.st = nullptr;
    const int lo = args.ph_lo, hi = args.ph_hi;
    if (hi - lo > 1) bar = xcd_barrier_post((unsigned*)(ctl + CW_BAR), MISC + 8);
#define IN(k) (lo <= (k) && (k) < hi)
#define FRESH_TID() int tid = tid0; asm volatile("" : "+v"(tid)); const int lane = tid & 63, wave = __builtin_amdgcn_readfirstlane(tid >> 6); (void)lane; (void)wave
#define SEAM(k) do { if (IN(k) && IN((k) + 1)) xcd_barrier(bar); } while (0)
#if PROBE_PH >= 0
#define PROBE_ME ((MISC[10] ? (int)MISC[10] - 1 : (int)blockIdx.x) == PROBE_BLK)
#define PH_HIT(k, l) ((k) == PROBE_PH && ((PROBE_LMASK >> (l)) & 1) && PROBE_ME && tid0 == 0)
#define PH_B(k, l) do { if (PH_HIT(k, l)) { MISC[13] = (unsigned)rt(); MISC[15] = (unsigned)__builtin_amdgcn_s_memtime(); } } while (0)
#define PH_E(k, l, incl) do { if ((incl) == PROBE_INCL && PH_HIT(k, l)) { MISC[12] += (unsigned)rt() - MISC[13]; MISC[14] += (unsigned)__builtin_amdgcn_s_memtime() - MISC[15]; } } while (0)
#else
#define PH_B(k, l) do { } while (0)
#define PH_E(k, l, incl) do { } while (0)
#endif

    float* mod = (float*)(ws + WS_MOD);
    float* gates = (float*)(ws + WS_GATE);
    bf16* A1 = (bf16*)(ws + WS_A1);
    bf16* Z = (bf16*)(ws + WS_Z);

    PH_B(7, 0);
    if (IN(0)) for (int rp = 0; rp < REP_PRO; ++rp) { const int tid = tid0, lane = tid & 63, wave = __builtin_amdgcn_readfirstlane(tid >> 6); if (rp) xcd_barrier(bar); phase_prologue(args, lds, tid, lane, wave, G); }
    PH_E(7, 0, 0); SEAM(0); PH_E(7, 0, 1);
    if (IN(0) && IN(1)) { if (tid0 == 0) { unsigned xi = 0, nxp = 0, ok = 1; const unsigned per = (unsigned)G / 8u;
#pragma unroll
            for (unsigned jx = 0; jx < 16; ++jx) { const unsigned cc = xb_ld(&bar.bar[XB_XCNT(jx)]); if (cc) { ++nxp; if (jx < bar.x) ++xi; if (cc != per) ok = 0; } }
            if (ok && nxp == 8u && per * 8u == (unsigned)G && MISC[11] < per) MISC[10] = 1u + xi + 8u * MISC[11]; }
        __syncthreads(); }
#define GEMM_C() ({ const unsigned cv_ = (unsigned)__builtin_amdgcn_readfirstlane((int)MISC[10]); cv_ ? (int)cv_ - 1 : (int)blockIdx.x; })

    for (int l = 0; l < DEPTH; ++l) {
        const int base = 1 + 7 * l, j = l >> 1; const bool odd = (l & 1) != 0;
        bf16* XB = (bf16*)args.out;
        bf16* XB2 = (bf16*)(ws + WS_XB2);
        const float* modl = mod + (size_t)l * BATCH * MODW;
        PH_B(0, l);
        if (IN(base + 0)) for (int rp = 0; rp < REP_NORM; ++rp) { FRESH_TID(); if (rp) xcd_barrier(bar);
            if (l == 0) phase_norm<8, false>(args.in[0], args.in[4] + l * D, modl + 0 * D, modl + 1 * D, A1, args.in[6] + (size_t)j * D * AB_LD, AB_LD, AB_N, args.in[7] + j * 4, args.in[8] + j * 4, gates, lds, tid, lane, wave, G);
            else if (!odd) phase_norm<8, true>(XB, args.in[4] + l * D, modl + 0 * D, modl + 1 * D, A1, args.in[6] + (size_t)j * D * AB_LD, AB_LD, AB_N, args.in[7] + j * 4, args.in[8] + j * 4, gates, lds, tid, lane, wave, G);
            else phase_norm<16, true>(XB, args.in[4] + l * D, modl + 0 * D, modl + 1 * D, A1, args.in[16] + (size_t)j * D * FX_LD, FX_LD, FX_N, nullptr, args.in[17] + j * 16, gates, lds, tid, lane, wave, G);
        }
        PH_E(0, l, 0); SEAM(base + 0); PH_E(0, l, 1);
        PH_B(1, l);
        if (IN(base + 1)) for (int rp = 0; rp < REP_GIN; ++rp) { if (rp) xcd_barrier(bar);
            const int N = odd ? FX_N : AB_N;
            pg8::Gemm g{A1, odd ? (const bf16*)(ws + WS_WIN_O) + (size_t)j * FX_N * D : (const bf16*)(ws + WS_WIN_E) + (size_t)j * AB_N * D, M, N, D};
            pg8::StaticOrder S; S.init(M, N, G, GEMM_C());
            pg8::EpiIn E{Z, N, odd ? 1024 : 512, odd ? 2048 : 1024, odd ? args.in[18] + j * 64 : args.in[11] + j * 64, odd ? args.in[19] + j * 64 : args.in[12] + j * 64, 0.125f * LOG2E};
            pg8::gemm_phase<pg8::EpiIn, pg8::StaticOrder, true, true>(lds + RING_OFF, g, S, E);
        }
        PH_E(1, l, 0); SEAM(base + 1); PH_E(1, l, 1);
        PH_B(2, l);
        if (IN(base + 2)) for (int rp = 0; rp < (odd ? REP_MIX_O : REP_MIX_E); ++rp) { FRESH_TID(); if (rp) xcd_barrier(bar);
            gu32* head = ctl + CW_QUEUE + 64 * (l + 4 * rp);
            if (!odd) {
#if USE_ML_MFMA
                phase_mlconv(Z, args.in[9] + (size_t)j * 4 * 1024, args.in[10] + (size_t)j * 1024, (bf16*)(ws + WS_QKC), tid, G);
                if (hi - lo > 1) xcd_barrier(bar);
#endif
                if (tid0 == 0) { const float lambda_init = 0.8f - 0.6f * expf(-0.3f * (float)l);
                    const float* lp = args.in[13] + j * 256; float s0 = 0.f, s1 = 0.f; for (int d = 0; d < 64; ++d) { s0 += lp[d] * lp[64 + d]; s1 += lp[128 + d] * lp[192 + d]; }
                    MISC[2] = __builtin_bit_cast(unsigned, expf(s0) - expf(s1) + lambda_init); MISC[3] = __builtin_bit_cast(unsigned, lambda_init);
                    const float* gq = args.in[11] + j * 64; const float* gk = args.in[12] + j * 64; float gm = 0.f; for (int d = 0; d < 64; ++d) gm = fmaxf(gm, fabsf(gq[d] * gk[d]));
                    MISC[4] = (8.0f * LOG2E * gm < 64.0f) ? 1u : 0u;
                    MISC[5] = __builtin_bit_cast(unsigned, 54.0f + 16.0f * LOG2E * gm); }
                for (;;) { int idx = queue_next(head, MISC, tid0); if (idx >= 64 * REP_ML + 1024 * REP_DA) break;
                    if (idx < 64 * REP_ML) idx &= 63; else idx = 64 + ((idx - 64 * REP_ML) & 1023);
                    int tid = tid0; asm volatile("" : "+v"(tid)); const int lane = tid & 63, wave = __builtin_amdgcn_readfirstlane(tid >> 6);
#if USE_ML_MFMA
                    if (idx < 64) mlstm_unit(idx >> 3, (idx >> 1) & 3, idx & 1, Z, (const bf16*)(ws + WS_QKC), gates, A1, lds, tid, lane, wave);
#else
                    if (idx < 32) mlstm_naive_unit(idx >> 2, idx & 3, Z, gates, args.in[9] + (size_t)j * 4 * 1024, args.in[10] + (size_t)j * 1024, A1, lds, tid);
#endif
                    else { const int u = idx - 64, qb = 31 - u / 32, bh = u % 32;
#if USE_DA_MFMA
                        da_unit(bh >> 2, bh & 3, qb, Z, A1, MISC, MISC[4] != 0u, args.in[14] + j * 128, lds, tid, lane, wave);
#ifdef DBG_DA_BOTH
                        da_naive_unit(bh >> 2, bh & 3, qb, Z, A1, args.in[13] + j * 256, args.in[14] + j * 128, l, lane, wave);
#endif
#else
                        da_naive_unit(bh >> 2, bh & 3, qb, Z, A1, args.in[13] + j * 256, args.in[14] + j * 128, l, lane, wave);
#endif
                    } }
            } else {
#if USE_FOX_MFMA
                if (tid0 == 0) { const float* gq = args.in[18] + j * 64; const float* gk = args.in[19] + j * 64; float gm = 0.f; for (int d = 0; d < 64; ++d) gm = fmaxf(gm, fabsf(gq[d] * gk[d]));
                    MISC[4] = (8.0f * LOG2E * gm < 64.0f) ? 1u : 0u;
                    MISC[5] = __builtin_bit_cast(unsigned, 54.0f + 16.0f * LOG2E * gm); }
                for (;;) { const int idx = queue_next(head, MISC, tid0); if (idx >= 2048) break;
                    int tid = tid0; asm volatile("" : "+v"(tid)); const int lane = tid & 63, wave = __builtin_amdgcn_readfirstlane(tid >> 6);
                    const int qb = 15 - idx / 128, bh = idx % 128; fox_unit(bh >> 4, bh & 15, qb, Z, gates, A1, MISC[4] != 0u, __builtin_bit_cast(float, (unsigned)MISC[5]), lds, tid, lane, wave); }
#else
                for (;;) { const int idx = queue_next(head, MISC, tid); if (idx >= 1024) break;
                    const int qb = 7 - idx / 128, bh = idx % 128; fox_naive_unit(bh >> 4, bh & 15, qb, Z, gates, A1, lds, tid, lane, wave); }
#endif
            }
        }
        PH_E(2, l, 0); SEAM(base + 2); PH_E(2, l, 1);
        PH_B(3, l);
        if (IN(base + 3)) for (int rp = 0; rp < REP_GOUT; ++rp) { if (rp) xcd_barrier(bar);
            pg8::Gemm g{A1, (const bf16*)(ws + WS_WOUT) + (size_t)l * D * D, M, D, D};
            pg8::StaticOrder S; S.init(M, D, G, GEMM_C());
            const bool dry = (rp + 1 < REP_GOUT);
            const bool last = (l == DEPTH - 1); bf16* xo = last ? XB2 : XB;
            pg8::EpiRes E{args.in[0], (l == 0 && !dry) ? nullptr : (dry ? xo : XB), nullptr, xo, dry ? (const float*)(ws + WS_CTL + 512 * 1024) : modl + 2 * D, dry ? 0 : MODW};
            pg8::gemm_phase<pg8::EpiRes, pg8::StaticOrder, true, true>(lds + RING_OFF, g, S, E);
        }
        PH_E(3, l, 0); SEAM(base + 3); PH_E(3, l, 1);
        PH_B(4, l);
        if (IN(base + 4)) for (int rp = 0; rp < REP_NORM; ++rp) { FRESH_TID(); if (rp) xcd_barrier(bar); phase_norm<0, true>((l == DEPTH - 1) ? XB2 : XB, args.in[5] + l * D, modl + 3 * D, modl + 4 * D, A1, nullptr, 0, 0, nullptr, nullptr, nullptr, lds, tid, lane, wave, G); }
        PH_E(4, l, 0); SEAM(base + 4); PH_E(4, l, 1);
#if PROBE_REST > 0
        { if (tid0 == 0) { const unsigned long long w0 = rt(); while (rt() - w0 < (unsigned long long)PROBE_REST * 100ull) __builtin_amdgcn_s_sleep(32); } __syncthreads(); }
#endif
        PH_B(5, l);
        if (IN(base + 5)) for (int rp = 0; rp < REP_GUP; ++rp) { if (rp) xcd_barrier(bar);
            pg8::Gemm g{A1, (const bf16*)(ws + WS_WUP) + (size_t)l * NUP * D, M, NUP, D};
            pg8::StaticOrder S; S.init(M, NUP, G, GEMM_C());
            pg8::EpiSwiglu E{Z, FFH};
#if PROBE_GMODE
            if (rp + 1 < REP_GUP) pg8::gemm_phase<pg8::EpiSwiglu, pg8::StaticOrder, true, true, PROBE_GMODE>(lds + RING_OFF, g, S, E); else
#endif
            pg8::gemm_phase<pg8::EpiSwiglu, pg8::StaticOrder, true, true>(lds + RING_OFF, g, S, E);
        }
        PH_E(5, l, 0); SEAM(base + 5); PH_E(5, l, 1);
        PH_B(6, l);
        if (IN(base + 6)) for (int rp = 0; rp < REP_GDN; ++rp) { if (rp) xcd_barrier(bar);
            pg8::Gemm g{Z, (const bf16*)(ws + WS_WDN) + (size_t)l * D * FFH, M, D, FFH};
            pg8::StaticOrder S; S.init(M, D, G, GEMM_C());
            const bool dry = (rp + 1 < REP_GDN);
            const bool last = (l == DEPTH - 1);
            pg8::EpiRes E{nullptr, last ? XB2 : XB, (last && !dry) ? args.out : nullptr, (last && !dry) ? nullptr : (last ? XB2 : XB), dry ? (const float*)(ws + WS_CTL + 512 * 1024) : modl + 5 * D, dry ? 0 : MODW};
            pg8::gemm_phase<pg8::EpiRes, pg8::StaticOrder, true, true>(lds + RING_OFF, g, S, E);
        }
        PH_E(6, l, 0); SEAM(base + 6); PH_E(6, l, 1);
    }
    for (int rp = 0; rp < REP_BAR; ++rp) xcd_barrier(bar);
#if PROBE_PH >= 0
    if (PROBE_ME && tid0 == 0) { const unsigned long long w0 = rt(); unsigned long long wt = PROBE_CNT ? (unsigned long long)MISC[15 + PROBE_CNT] * 100ull : PROBE_CLK ? (unsigned long long)((float)MISC[14] / (float)MISC[12] * 10000.0f) : (unsigned long long)MISC[12] * PROBE_SCALE;     if (wt > 800000ull) wt = 800000ull;
        while (rt() - w0 < wt) __builtin_amdgcn_s_sleep(32); }
#endif
#undef IN
#undef SEAM
}

extern "C" void kernel_launch(void* const* d_in, const int* in_sizes, int n_in, void* d_out, int out_size, void* d_ws, size_t ws_size, hipStream_t stream) {
    static int grid = 0;
    if (grid == 0) {
        if (n_in != 24 || out_size != M * D || ws_size < WS_END) { fprintf(stderr, "kernel_launch: unexpected shapes (n_in %d, out %d, ws %zu); nothing launched\n", n_in, out_size, ws_size); grid = -1; return; }
        int dev = 0, cus = 0, per_cu = 0;
        if (hipGetDevice(&dev) != hipSuccess || hipDeviceGetAttribute(&cus, hipDeviceAttributeMultiprocessorCount, dev) != hipSuccess) { grid = -1; return; }
        if (hipFuncSetAttribute((const void*)fwd_kernel, hipFuncAttributeMaxDynamicSharedMemorySize, LDS_BYTES) != hipSuccess) { fprintf(stderr, "kernel_launch: hipFuncSetAttribute failed\n"); grid = -1; return; }
        if (hipOccupancyMaxActiveBlocksPerMultiprocessor(&per_cu, (const void*)fwd_kernel, NTHREADS, LDS_BYTES) != hipSuccess || per_cu < 1) { fprintf(stderr, "kernel_launch: occupancy query reports %d blocks per CU\n", per_cu); }
        (void)hipGetLastError();
        grid = cus;
    }
    if (grid < 0) return;
    if (hipMemsetAsync((char*)d_ws + WS_CTL, 0, CTL_ZERO_BYTES, stream) != hipSuccess) return;
    Args a{};
    for (int i = 0; i < 24; ++i) a.in[i] = (const float*)d_in[i];
    a.out = (float*)d_out; a.ws = (unsigned char*)d_ws;
#if MK_SINGLE
    a.ph_lo = 0; a.ph_hi = N_PHASES;
    hipLaunchKernelGGL(fwd_kernel, dim3(grid), dim3(NTHREADS), LDS_BYTES, stream, a);
#else
    for (int p = 0; p < N_PHASES; ++p) { a.ph_lo = p; a.ph_hi = p + 1; hipLaunchKernelGGL(fwd_kernel, dim3(grid), dim3(NTHREADS), LDS_BYTES, stream, a); }
#endif
}
```
